# Optimizing an MI355X kernel written in HIP

```python
import math
import jax
import jax.numpy as jnp
from jax import lax
import numpy as np


D_MODEL = 2048
BATCH = 8
SEQ = 4096
DEPTH = 4

CTX_LEN = 256
GRID_W = 64
MIX_W = D_MODEL
CONV_W = MIX_W // 4
SSM_W = MIX_W // 4
ATTN_W = MIX_W - CONV_W - SSM_W
CONV_K = 3
SSM_GROUP = 16
SSM_GROUPS = SSM_W // SSM_GROUP
SSM_STATE = 64
HEAD_DIM = 128
N_HEADS = ATTN_W // HEAD_DIM
N_KV_HEADS = 2
GQA_GROUP = N_HEADS // N_KV_HEADS
KV_W = N_KV_HEADS * HEAD_DIM
Q_BLOCK = 128
ROPE_THETA = 10000.0
RMS_EPS = 1e-6
FFN_HIDDEN = -(-8 * D_MODEL // (3 * 256)) * 256
N_MOD = 6

CONV_V_OFF = 0
CONV_B_OFF = CONV_W
CONV_C_OFF = 2 * CONV_W
SSM_OFF = 3 * CONV_W
Q_OFF = SSM_OFF + SSM_W
K_OFF = Q_OFF + ATTN_W
V_OFF = K_OFF + KV_W
IN_PROJ_W = V_OFF + KV_W

kernel_name = 'hybrid_conv_s5_gqa_diffusion_trunk'


def rms_norm(x, gain, eps=RMS_EPS):
    xf = x.astype(jnp.float32)
    y = xf * lax.rsqrt(jnp.mean(jnp.square(xf), axis=-1, keepdims=True) + eps)
    return (y * gain.astype(jnp.float32)).astype(x.dtype)


def adaln(h, shift, scale):
    return h * (1 + scale) + shift


def axial_rope_angles(rows):
    row = jnp.broadcast_to(jnp.arange(rows)[:, None], (rows, GRID_W)).reshape(-1)
    col = jnp.broadcast_to(jnp.arange(GRID_W)[None, :], (rows, GRID_W)).reshape(-1)
    half = HEAD_DIM // 2
    inv_freq = ROPE_THETA ** (-jnp.arange(0, half, 2, dtype=jnp.float32) / half)
    ang_row = row.astype(jnp.float32)[:, None] * inv_freq
    ang_col = col.astype(jnp.float32)[:, None] * inv_freq
    return ang_row, ang_col


def rotate_half(x, ang):
    m = ang.shape[-1]
    cos = jnp.cos(ang)[:, None, :].astype(x.dtype)
    sin = jnp.sin(ang)[:, None, :].astype(x.dtype)
    x1, x2 = x[..., :m], x[..., m:]
    return jnp.concatenate([x1 * cos - x2 * sin, x1 * sin + x2 * cos], axis=-1)


def apply_axial_rope(x, ang_row, ang_col):
    half = HEAD_DIM // 2
    return jnp.concatenate([rotate_half(x[..., :half], ang_row),
                            rotate_half(x[..., half:], ang_col)], axis=-1)


def short_conv_mixer(z, w):
    v = z[..., CONV_V_OFF:CONV_V_OFF + CONV_W]
    gate_b = z[..., CONV_B_OFF:CONV_B_OFF + CONV_W]
    gate_c = z[..., CONV_C_OFF:CONV_C_OFF + CONV_W]
    pad = CONV_K // 2
    u = jnp.pad(gate_c * v, ((0, 0), (pad, pad), (0, 0)))
    t = z.shape[1]
    y = sum(w[j] * u[:, j:j + t] for j in range(CONV_K))
    return gate_b * y


def s5_discretize(lam_re, lam_im, log_dt, b_re, b_im):
    f32 = jnp.float32
    lam = lax.complex(lam_re.astype(f32), lam_im.astype(f32))
    dt = jnp.exp(log_dt.astype(f32))[:, None]
    lam_bar = jnp.exp(lam * dt)
    b = lax.complex(b_re.astype(f32), b_im.astype(f32))
    b_bar = ((lam_bar - 1.0) / lam)[..., None] * b
    return lam_bar, b_bar


def s5_drive(u, b_bar):
    bsz, t, _ = u.shape
    ug = u.reshape(bsz, t, SSM_GROUPS, SSM_GROUP).astype(jnp.float32).astype(jnp.complex64)
    return jnp.einsum('btgn,gpn->btgp', ug, b_bar)


def s5_scan(lam_bar, bu, h0, reverse):
    if h0 is not None:
        idx = -1 if reverse else 0
        bu = bu.at[:, idx].add(lam_bar * h0)
    a = jnp.broadcast_to(lam_bar, bu.shape)

    def combine(left, right):
        a_l, b_l = left
        a_r, b_r = right
        return a_r * a_l, a_r * b_l + b_r

    _, h = lax.associative_scan(combine, (a, bu), reverse=reverse, axis=1)
    return h


def s5_readout(h, c_re, c_im):
    bsz, t = h.shape[:2]
    f32 = jnp.float32
    y = (jnp.einsum('btgp,gnp->btgn', jnp.real(h), c_re.astype(f32))
         - jnp.einsum('btgp,gnp->btgn', jnp.imag(h), c_im.astype(f32)))
    return y.reshape(bsz, t, SSM_W)


def s5_mixer(u_x, u_c, lam_re, lam_im, log_dt, b_re, b_im, c_re, c_im, d, w_glu, b_glu, want_ctx):
    f32 = jnp.float32
    lam_f, bbar_f = s5_discretize(lam_re[0], lam_im[0], log_dt[0], b_re[0], b_im[0])
    lam_b, bbar_b = s5_discretize(lam_re[1], lam_im[1], log_dt[1], b_re[1], b_im[1])
    hc_f = s5_scan(lam_f, s5_drive(u_c, bbar_f), None, False)
    hc_b = s5_scan(lam_b, s5_drive(u_c, bbar_b), None, True)
    hx_f = s5_scan(lam_f, s5_drive(u_x, bbar_f), hc_f[:, -1], False)
    hx_b = s5_scan(lam_b, s5_drive(u_x, bbar_b), hc_b[:, 0], True)

    def output(h_f, h_b, u):
        y = (s5_readout(h_f, c_re[0], c_im[0]) + s5_readout(h_b, c_re[1], c_im[1])
             + d.astype(f32) * u.astype(f32))
        g = jax.nn.gelu(y)
        gate = jax.nn.sigmoid(g @ w_glu.astype(f32) + b_glu.astype(f32))
        return (g * gate).astype(u.dtype)

    out_x = output(hx_f, hx_b, u_x)
    out_c = output(hc_f, hc_b, u_c) if want_ctx else None
    return out_x, out_c


def heads_q(z, q_gain):
    bsz, t, _ = z.shape
    q = z[..., Q_OFF:Q_OFF + ATTN_W].reshape(bsz, t, N_HEADS, HEAD_DIM)
    return rms_norm(q, q_gain)


def heads_kv(z, k_gain):
    bsz, t, _ = z.shape
    k = rms_norm(z[..., K_OFF:K_OFF + KV_W].reshape(bsz, t, N_KV_HEADS, HEAD_DIM), k_gain)
    v = z[..., V_OFF:V_OFF + KV_W].reshape(bsz, t, N_KV_HEADS, HEAD_DIM)
    return k, v


def gqa_attend(q, k, v):
    s = jnp.einsum('bqkgd,bskd->bkgqs', q, k, preferred_element_type=jnp.float32) * (HEAD_DIM ** -0.5)
    p = jax.nn.softmax(s, axis=-1).astype(v.dtype)
    return jnp.einsum('bkgqs,bskd->bqkgd', p, v)


def attention_mixer(z_x, z_c, q_gain, k_gain, ang_row, ang_col, want_ctx):
    bsz, t, _ = z_x.shape
    n_ctx = z_c.shape[1]
    q_x = apply_axial_rope(heads_q(z_x, q_gain), ang_row, ang_col)
    k_x, v_x = heads_kv(z_x, k_gain)
    k_x = apply_axial_rope(k_x, ang_row, ang_col)
    k_c, v_c = heads_kv(z_c, k_gain)
    k_all = jnp.concatenate([k_x, k_c], axis=1)
    v_all = jnp.concatenate([v_x, v_c], axis=1)
    n_blk = t // Q_BLOCK
    q_blocks = jnp.moveaxis(q_x.reshape(bsz, n_blk, Q_BLOCK, N_KV_HEADS, GQA_GROUP, HEAD_DIM), 1, 0)
    o = lax.map(lambda qb: gqa_attend(qb, k_all, v_all), q_blocks)
    out_x = jnp.moveaxis(o, 0, 1).reshape(bsz, t, ATTN_W)
    out_c = None
    if want_ctx:
        q_c = heads_q(z_c, q_gain).reshape(bsz, n_ctx, N_KV_HEADS, GQA_GROUP, HEAD_DIM)
        out_c = gqa_attend(q_c, k_c, v_c).reshape(bsz, n_ctx, ATTN_W)
    return out_x, out_c


def swiglu(h, w_gate, w_up, w_down):
    return (jax.nn.silu(h @ w_gate) * (h @ w_up)) @ w_down


def setup_inputs(seed: int = 0) -> dict:
    key = jax.random.key(seed)
    ks = jax.random.split(key, 32)
    f32 = jnp.float32

    def nrm(k, shape, scale):
        return jax.random.normal(k, shape, f32) * scale

    def gain(k, shape):
        return 1.0 + 0.02 * jax.random.normal(k, shape, f32)

    n_idx = jnp.arange(SSM_STATE, dtype=f32)
    ssm_shape = (DEPTH, 2, SSM_GROUPS, SSM_STATE)
    return {
        'x': nrm(ks[0], (BATCH, SEQ, D_MODEL), 1.0),
        'c': nrm(ks[1], (BATCH, D_MODEL), 1.0),
        'ctx': nrm(ks[2], (BATCH, CTX_LEN, D_MODEL), 1.0),
        'c_ctx': nrm(ks[3], (D_MODEL,), 1.0),
        'w_mod': nrm(ks[4], (DEPTH, D_MODEL, N_MOD * D_MODEL), D_MODEL ** -0.5),
        'b_mod': nrm(ks[5], (DEPTH, N_MOD * D_MODEL), 0.02),
        'g_pre_mix': gain(ks[6], (DEPTH, D_MODEL)),
        'g_post_mix': gain(ks[7], (DEPTH, D_MODEL)),
        'g_pre_ffn': gain(ks[8], (DEPTH, D_MODEL)),
        'g_post_ffn': gain(ks[9], (DEPTH, D_MODEL)),
        'w_in': nrm(ks[10], (DEPTH, D_MODEL, IN_PROJ_W), D_MODEL ** -0.5),
        'conv_w': nrm(ks[11], (DEPTH, CONV_K, CONV_W), CONV_K ** -0.5),
        'ssm_lam_re': -0.5 + 0.01 * jax.random.normal(ks[12], ssm_shape, f32),
        'ssm_lam_im': jnp.pi * n_idx + 0.01 * jax.random.normal(ks[13], ssm_shape, f32),
        'ssm_log_dt': jax.random.uniform(ks[14], (DEPTH, 2, SSM_GROUPS), f32,
                                         minval=math.log(0.01), maxval=math.log(0.1)),
        'ssm_b_re': nrm(ks[15], ssm_shape + (SSM_GROUP,), (2 * SSM_GROUP) ** -0.5),
        'ssm_b_im': nrm(ks[16], ssm_shape + (SSM_GROUP,), (2 * SSM_GROUP) ** -0.5),
        'ssm_c_re': nrm(ks[17], (DEPTH, 2, SSM_GROUPS, SSM_GROUP, SSM_STATE), 0.5),
        'ssm_c_im': nrm(ks[18], (DEPTH, 2, SSM_GROUPS, SSM_GROUP, SSM_STATE), 0.5),
        'ssm_d': nrm(ks[19], (DEPTH, SSM_W), 1.0),
        'w_glu': nrm(ks[20], (DEPTH, SSM_W, SSM_W), SSM_W ** -0.5),
        'b_glu': nrm(ks[21], (DEPTH, SSM_W), 0.02),
        'q_norm': gain(ks[22], (DEPTH, HEAD_DIM)),
        'k_norm': gain(ks[23], (DEPTH, HEAD_DIM)),
        'w_out': nrm(ks[24], (DEPTH, MIX_W, D_MODEL), MIX_W ** -0.5),
        'w_gate': nrm(ks[25], (DEPTH, D_MODEL, FFN_HIDDEN), D_MODEL ** -0.5),
        'w_up': nrm(ks[26], (DEPTH, D_MODEL, FFN_HIDDEN), D_MODEL ** -0.5),
        'w_down': nrm(ks[27], (DEPTH, FFN_HIDDEN, D_MODEL), FFN_HIDDEN ** -0.5),
    }


def reference(x, c, ctx, c_ctx, w_mod, b_mod, g_pre_mix, g_post_mix, g_pre_ffn, g_post_ffn,
              w_in, conv_w, ssm_lam_re, ssm_lam_im, ssm_log_dt, ssm_b_re, ssm_b_im,
              ssm_c_re, ssm_c_im, ssm_d, w_glu, b_glu, q_norm, k_norm, w_out,
              w_gate, w_up, w_down):
    bsz, n_tok, _ = x.shape
    rows = n_tok // GRID_W
    ang_row, ang_col = axial_rope_angles(rows)
    silu_c = jax.nn.silu(c)
    silu_cc = jax.nn.silu(c_ctx)
    xc = ctx
    for l in range(DEPTH):
        want_ctx = l < DEPTH - 1
        mod_x = (silu_c @ w_mod[l] + b_mod[l]).reshape(bsz, N_MOD, 1, D_MODEL)
        mod_c = (silu_cc @ w_mod[l] + b_mod[l]).reshape(N_MOD, D_MODEL)

        hx = adaln(rms_norm(x, g_pre_mix[l]), mod_x[:, 0], mod_x[:, 1])
        hc = adaln(rms_norm(xc, g_pre_mix[l]), mod_c[0], mod_c[1])
        zx = hx @ w_in[l]
        zc = hc @ w_in[l]
        conv_x = short_conv_mixer(zx, conv_w[l])
        ssm_x, ssm_c = s5_mixer(zx[..., SSM_OFF:SSM_OFF + SSM_W], zc[..., SSM_OFF:SSM_OFF + SSM_W],
                                ssm_lam_re[l], ssm_lam_im[l], ssm_log_dt[l], ssm_b_re[l], ssm_b_im[l],
                                ssm_c_re[l], ssm_c_im[l], ssm_d[l], w_glu[l], b_glu[l], want_ctx)
        attn_x, attn_c = attention_mixer(zx, zc, q_norm[l], k_norm[l], ang_row, ang_col, want_ctx)
        mix_x = jnp.concatenate([conv_x, ssm_x, attn_x], axis=-1) @ w_out[l]
        x = x + mod_x[:, 2] * rms_norm(mix_x, g_post_mix[l])
        if want_ctx:
            conv_c = short_conv_mixer(zc, conv_w[l])
            mix_c = jnp.concatenate([conv_c, ssm_c, attn_c], axis=-1) @ w_out[l]
            xc = xc + mod_c[2] * rms_norm(mix_c, g_post_mix[l])

        hx = adaln(rms_norm(x, g_pre_ffn[l]), mod_x[:, 3], mod_x[:, 4])
        x = x + mod_x[:, 5] * rms_norm(swiglu(hx, w_gate[l], w_up[l], w_down[l]), g_post_ffn[l])
        if want_ctx:
            hc = adaln(rms_norm(xc, g_pre_ffn[l]), mod_c[3], mod_c[4])
            xc = xc + mod_c[5] * rms_norm(swiglu(hc, w_gate[l], w_up[l], w_down[l]), g_post_ffn[l])
    return x
```

```cpp
#include <hip/hip_runtime.h>
#include <cstdio>
#include <cstdint>
#include <cmath>

#ifndef MK_ONE_LAUNCH
#define MK_ONE_LAUNCH 1
#endif

constexpr int SSM_L = 32, SSM_CPB = 136, SSM_RPG = 1280, UH_LD = 768;
__host__ __device__ __forceinline__ int ssm_rg(int b, int c) { return c >= 8 ? b * 128 + (c - 8) : 1024 + b * 8 + c; }

#ifndef REP_MASK
#define REP_MASK 0
#endif
#define NREP(b) (1 + ((REP_MASK >> (b)) & 1))
__device__ __forceinline__ int lane_id() { int l; asm volatile("v_mbcnt_lo_u32_b32 %0, -1, 0\n\tv_mbcnt_hi_u32_b32 %0, -1, %0" : "=v"(l)); return l; }
namespace pg8 {
#define PG8_LAS __attribute__((address_space(3)))
typedef unsigned short bf16_t;
typedef short bf16x8 __attribute__((ext_vector_type(8)));
typedef float f32x4 __attribute__((ext_vector_type(4)));
typedef unsigned u32x4 __attribute__((ext_vector_type(4)));
constexpr int BM = 256, BK = 64, HALF = 128, HTB = HALF * BK * 2  , STAGE_BYTES = 8 * HTB, NXCD = 8, WGM = 8;

__host__ __device__ __forceinline__ int lds_byte(int r, int c) { const int st = (r >> 4) * 2 + (c >> 5), rr = r & 15, cc = c & 31, ob = rr * 64 + cc * 2; return st * 1024 + (ob ^ (((ob >> 9) & 1) << 5)); }
__host__ __device__ __forceinline__ void stage_rc(int b, int& R, int& C) { const int st = b / 1024, sb = b % 1024, swz = sb ^ (((sb >> 9) & 1) << 5); R = (st >> 1) * 16 + swz / 64; C = (st & 1) * 32 + (swz % 64) / 2; }
__host__ __device__ __forceinline__ int perm32(int rho) { const int n = rho >> 4, i = rho & 15; return 8 * (i >> 2) + 4 * n + (i & 3); }

struct Unit { int pm, pn, ko, nt; };
struct Gemm { const bf16_t* A; const bf16_t* Bt; int M, N, K, lda, ldb; };

struct StaticOrder {
    int nM, nN, nwg, G, c;
    __host__ __device__ void init(int M, int N, int G_, int c_) { nM = M / BM; nN = N / BM; nwg = nM * nN; G = G_; c = c_; }
    __host__ __device__ bool next(int i, Unit& u) const {
        const long L = (long)i * G + c; if (L >= nwg) return false;
        int wgid = (int)L; { const int q = nwg / NXCD, r = nwg % NXCD, xcd = wgid % NXCD, off = wgid / NXCD; wgid = (xcd < r ? xcd * (q + 1) : r * (q + 1) + (xcd - r) * q) + off; }
        const int nig = WGM * nN, gid = wgid / nig, fm = gid * WGM, gsz = (nM - fm) < WGM ? (nM - fm) : WGM;
        u.pm = fm + ((wgid % nig) % gsz); u.pn = (wgid % nig) / gsz; return true;
    }
    __device__ __forceinline__ void a_ready(const Unit&) const {}
    __device__ __forceinline__ void done(const Unit&) const {}
};

__device__ __forceinline__ unsigned cvt_pk_bf16(float lo, float hi) { unsigned r; asm volatile("v_cvt_pk_bf16_f32 %0, %1, %2" : "=v"(r) : "v"(lo), "v"(hi)); return r; }
typedef float f32x2 __attribute__((ext_vector_type(2)));
struct EpiBf16 {
    static constexpr bool PERM = true, AFTER_DRAIN = false; static constexpr int NST = 0;
    bf16_t* O; int ldc; float* YP; int nt_full;
    __device__ __forceinline__ void operator()(const f32x4 (&acc)[2][2][4][2], const Unit& u, int wr, int wc, int fr, int fq) const {
        const int col0 = u.pn * BM + wc * 32 + 8 * fq;
        if (u.nt != nt_full) {
            const int q = u.ko / (u.nt * BK), b = u.pm / 17; float* base = YP + ((size_t)q * 2048 + b * 256 + wr * 64 + fr) * ldc + col0;
#pragma unroll
            for (int ai = 0; ai < 2; ++ai)
#pragma unroll
                for (int m = 0; m < 4; ++m) { float* rowp = base + (size_t)(ai * HALF + m * 16) * ldc;
#pragma unroll
                    for (int bj = 0; bj < 2; ++bj) { *(f32x4*)(rowp + bj * HALF) = acc[ai][bj][m][0]; *(f32x4*)(rowp + bj * HALF + 4) = acc[ai][bj][m][1]; } }
            return;
        }
        const int row0 = u.pm * BM + wr * 64 + fr;
#pragma unroll
        for (int ai = 0; ai < 2; ++ai)
#pragma unroll
            for (int m = 0; m < 4; ++m) { bf16_t* rowp = O + (size_t)(row0 + ai * HALF + m * 16) * ldc + col0;
#pragma unroll
                for (int bj = 0; bj < 2; ++bj) { const f32x4 v0 = acc[ai][bj][m][0], v1 = acc[ai][bj][m][1];
                    u32x4 w; w.x = cvt_pk_bf16(v0[0], v0[1]); w.y = cvt_pk_bf16(v0[2], v0[3]); w.z = cvt_pk_bf16(v1[0], v1[1]); w.w = cvt_pk_bf16(v1[2], v1[3]);
                    *(u32x4*)(rowp + bj * HALF) = w; } }
    }
};
struct RowOrder {
    int nN, G, c, ctx, ntq;
    __device__ bool next(int i, Unit& u) const {
        const int nlat = 128 * nN, L = i * G + c;
        if (L < nlat) {
            const int q = nlat / NXCD, wgid = (L % NXCD) * q + L / NXCD;
            const int nig = WGM * nN, gid = wgid / nig, rem = wgid - gid * nig, pml = gid * WGM + (rem % WGM);
            u.pn = rem / WGM; u.pm = (pml >> 4) * 17 + 1 + (pml & 15); return true;
        }
        const int Lc = L - nlat;
        if (ctx == 1) { if (Lc >= 8 * nN) return false; u.pm = (Lc / nN) * 17; u.pn = Lc % nN; return true; }
        if (ctx == 2) { if (Lc >= 32 * nN) return false; const int t = Lc >> 2; u.pm = (t / nN) * 17; u.pn = t % nN; u.ko = (Lc & 3) * ntq * BK; u.nt = ntq; return true; }
        return false;
    }
    __device__ __forceinline__ void a_ready(const Unit&) const {}
    __device__ __forceinline__ void done(const Unit&) const {}
};
__device__ __forceinline__ float bflo(unsigned w) { return __uint_as_float(w << 16); }
__device__ __forceinline__ float bfhi(unsigned w) { return __uint_as_float(w & 0xffff0000u); }
__device__ __forceinline__ float sigmoidf_(float x) { return __builtin_amdgcn_rcpf(1.0f + __expf(-x)); }
struct EpiGlu {
    static constexpr bool PERM = true, AFTER_DRAIN = false; static constexpr int NST = 0;
    const bf16_t* G; int ldg; bf16_t* O; int ldo; const float* bias;
    __device__ __forceinline__ void operator()(const f32x4 (&acc)[2][2][4][2], const Unit& u, int wr, int wc, int fr, int fq) const {
        const int row0 = u.pm * BM + wr * 64 + fr; const int col0 = u.pn * BM + wc * 32 + 8 * fq;
        f32x4 bv[2][2];
#pragma unroll
        for (int bj = 0; bj < 2; ++bj)
#pragma unroll
            for (int n = 0; n < 2; ++n) bv[bj][n] = *(const f32x4*)(bias + col0 + bj * HALF + 4 * n);
#pragma unroll
        for (int ai = 0; ai < 2; ++ai) {
            u32x4 gv[4][2];
#pragma unroll
            for (int m = 0; m < 4; ++m)
#pragma unroll
                for (int bj = 0; bj < 2; ++bj) gv[m][bj] = *(const u32x4*)(G + (size_t)(row0 + ai * HALF + m * 16) * ldg + col0 + bj * HALF);
            asm volatile("" ::: "memory");
#pragma unroll
            for (int m = 0; m < 4; ++m) { const size_t row = (size_t)(row0 + ai * HALF + m * 16);
#pragma unroll
                for (int bj = 0; bj < 2; ++bj) { const f32x4 v0 = acc[ai][bj][m][0] + bv[bj][0], v1 = acc[ai][bj][m][1] + bv[bj][1];
                    const u32x4 g = gv[m][bj];
                    const float o0 = bflo(g.x) * sigmoidf_(v0[0]), o1 = bfhi(g.x) * sigmoidf_(v0[1]), o2 = bflo(g.y) * sigmoidf_(v0[2]), o3 = bfhi(g.y) * sigmoidf_(v0[3]);
                    const float o4 = bflo(g.z) * sigmoidf_(v1[0]), o5 = bfhi(g.z) * sigmoidf_(v1[1]), o6 = bflo(g.w) * sigmoidf_(v1[2]), o7 = bfhi(g.w) * sigmoidf_(v1[3]);
                    u32x4 w; w.x = cvt_pk_bf16(o0, o1); w.y = cvt_pk_bf16(o2, o3); w.z = cvt_pk_bf16(o4, o5); w.w = cvt_pk_bf16(o6, o7);
                    *(u32x4*)(O + row * ldo + col0 + bj * HALF) = w; } }
            asm volatile("" ::: "memory");
        }
    }
};
struct EpiSwiGlu {
    static constexpr bool PERM = true, AFTER_DRAIN = false; static constexpr int NST = 8;
    bf16_t* O; int ldo;
    __device__ __forceinline__ void operator()(const f32x4 (&acc)[2][2][4][2], const Unit& u, int wr, int wc, int fr, int fq) const {
        const int row0 = u.pm * BM + wr * 64 + fr; const int col0 = u.pn * HALF + wc * 32 + 8 * fq;
#pragma unroll
        for (int ai = 0; ai < 2; ++ai)
#pragma unroll
            for (int m = 0; m < 4; ++m) { const size_t row = (size_t)(row0 + ai * HALF + m * 16);
                float o[8];
#pragma unroll
                for (int n = 0; n < 2; ++n)
#pragma unroll
                    for (int j = 0; j < 4; ++j) { const float g = acc[ai][0][m][n][j], up = acc[ai][1][m][n][j]; o[n * 4 + j] = g * sigmoidf_(g) * up; }
                u32x4 w; w.x = cvt_pk_bf16(o[0], o[1]); w.y = cvt_pk_bf16(o[2], o[3]); w.z = cvt_pk_bf16(o[4], o[5]); w.w = cvt_pk_bf16(o[6], o[7]);
                *(u32x4*)(O + row * ldo + col0) = w; }
    }
};
struct EpiInProj {
    static constexpr bool PERM = true, AFTER_DRAIN = false; static constexpr int NST = 0;
    bf16_t* Z; bf16_t* UH;
    __device__ __forceinline__ void operator()(const f32x4 (&acc)[2][2][4][2], const Unit& u, int wr, int wc, int fr, int fq) const {
        const int row0 = u.pm * BM + wr * 64 + fr; const int col0 = u.pn * BM + wc * 32 + 8 * fq;
        const bool ssm = (u.pn == 6 || u.pn == 7);
#pragma unroll
        for (int ai = 0; ai < 2; ++ai)
#pragma unroll
            for (int m = 0; m < 4; ++m) { const int row = row0 + ai * HALF + m * 16;
                int b = 0, pos = 0; if (ssm) { b = row / 4352; pos = row - b * 4352; }
#pragma unroll
                for (int bj = 0; bj < 2; ++bj) { const f32x4 v0 = acc[ai][bj][m][0], v1 = acc[ai][bj][m][1];
                    u32x4 w; w.x = cvt_pk_bf16(v0[0], v0[1]); w.y = cvt_pk_bf16(v0[2], v0[3]); w.z = cvt_pk_bf16(v1[0], v1[1]); w.w = cvt_pk_bf16(v1[2], v1[3]);
                    const int col = col0 + bj * HALF;
                    if (ssm) { const int sc = col - 1536, g = sc >> 4, n0 = sc & 15; *(u32x4*)(UH + ((size_t)(g * SSM_RPG + ssm_rg(b, pos >> 5)) * UH_LD + (pos & 31) * 16 + n0)) = w; }
                    else *(u32x4*)(Z + (size_t)row * 3584 + col) = w; } }
    }
};
struct EpiS5State {
    static constexpr bool PERM = true, AFTER_DRAIN = false; static constexpr int NST = 0;
    float* S;
    __device__ __forceinline__ void operator()(const f32x4 (&acc)[2][2][4][2], const Unit& u, int wr, int wc, int fr, int fq) const {
        const int row0 = u.pm * BM + wr * 64 + fr; const int col0 = wc * 32 + 8 * fq;
#pragma unroll
        for (int ai = 0; ai < 2; ++ai)
#pragma unroll
            for (int m = 0; m < 4; ++m) { float* rowp = S + (size_t)(row0 + ai * HALF + m * 16) * 256 + col0;
#pragma unroll
                for (int bj = 0; bj < 2; ++bj) { *(f32x4*)(rowp + bj * HALF) = acc[ai][bj][m][0]; *(f32x4*)(rowp + bj * HALF + 4) = acc[ai][bj][m][1]; } }
    }
};
__device__ __forceinline__ float gelu_tanh_(float y) {
    const float z = 0.7978845608028654f * (y + 0.044715f * y * y * y);
    const float t = 1.0f - 2.0f * __builtin_amdgcn_rcpf(__expf(2.0f * z) + 1.0f);
    return 0.5f * y * (1.0f + t);
}
struct EpiS5Out {
    static constexpr bool PERM = true, AFTER_DRAIN = false; static constexpr int NST = 0;
    bf16_t* G;
    __device__ __forceinline__ void operator()(const f32x4 (&acc)[2][2][4][2], const Unit& u, int wr, int wc, int fr, int fq) const {
        const int g = u.pn >> 1, j = u.pn & 1, i = u.pm - 5 * g;
        const int rg0 = i * BM + wr * 64 + fr; const int col0 = j * BM + wc * 32 + 8 * fq;
#pragma unroll
        for (int ai = 0; ai < 2; ++ai)
#pragma unroll
            for (int m = 0; m < 4; ++m) { const int rg = rg0 + ai * HALF + m * 16;
                if (rg < 1088) {
                    int b, c; if (rg < 1024) { b = rg >> 7; c = 8 + (rg & 127); } else { b = (rg - 1024) >> 3; c = (rg - 1024) & 7; }
                    const size_t grow0 = (size_t)b * 4352 + c * 32;
#pragma unroll
                    for (int bj = 0; bj < 2; ++bj) { const f32x4 v0 = acc[ai][bj][m][0], v1 = acc[ai][bj][m][1];
                        const int col = col0 + bj * HALF, t = col >> 4, n0 = col & 15;
                        u32x4 w; w.x = cvt_pk_bf16(gelu_tanh_(v0[0]), gelu_tanh_(v0[1])); w.y = cvt_pk_bf16(gelu_tanh_(v0[2]), gelu_tanh_(v0[3]));
                        w.z = cvt_pk_bf16(gelu_tanh_(v1[0]), gelu_tanh_(v1[1])); w.w = cvt_pk_bf16(gelu_tanh_(v1[2]), gelu_tanh_(v1[3]));
                        *(u32x4*)(G + (grow0 + t) * 512 + g * 16 + n0) = w; } } }
    }
};
struct S5Order1 { int G, c;
    __device__ bool next(int i, Unit& u) const { const int L = i * G + c; if (L >= 160) return false; u.pm = L; u.pn = L / 5; return true; }
    __device__ __forceinline__ void a_ready(const Unit&) const {}
    __device__ __forceinline__ void done(const Unit&) const {} };
struct S5Order2 { int G, c, nt;
    __device__ bool next(int i, Unit& u) const { const int L = i * G + c; if (L >= 32 * nt * 2) return false; const int g = L / (2 * nt), r = L - g * 2 * nt; u.pm = g * 5 + (r >> 1); u.pn = g * 2 + (r & 1); return true; }
    __device__ __forceinline__ void a_ready(const Unit&) const {}
    __device__ __forceinline__ void done(const Unit&) const {} };
template <class Epi, class Sched, bool ALIGN_EPI = false, bool SP2 = false>
__device__ __forceinline__ void gemm_phase(PG8_LAS unsigned char* lds, const Gemm g, const Sched& S, const Epi& E, int wave_s) {
    int tid_ = wave_s * 64 + lane_id(); asm volatile("" : "+v"(tid_));
    const int tid = tid_, wid = __builtin_amdgcn_readfirstlane(tid >> 6), lane = tid & 63, wr = wid >> 2, wc = wid & 3, fr = lane & 15, fq = lane >> 4;
    const int K = g.K, lda = g.lda ? g.lda : K, ldb = g.ldb ? g.ldb : K;
    unsigned voffA[2], voffB[2];
#pragma unroll
    for (int i = 0; i < 2; ++i) { int R, C; stage_rc(tid * 16 + i * 8192, R, C); const int Rb = Epi::PERM ? ((R & ~31) + perm32(R & 31)) : R;
        voffA[i] = (unsigned)(R * lda + C) * 2u; voffB[i] = (unsigned)(Rb * ldb + C) * 2u; }
    const size_t kstep = (size_t)(BK * 2);
    const size_t hstepA = (size_t)HALF * lda * 2, hstepB = (size_t)HALF * ldb * 2;
    const size_t tstepA = 2 * hstepA, tstepB = 2 * hstepB;
    const unsigned ldsw = (unsigned)wid * 1024u;
    const int aoff = lds_byte(wr * 64 + fr, fq * 8), boff = lds_byte(wc * 32 + fr, fq * 8);
#define PG8_SA(b, h) (((b) * 2 + (h)) * HTB)
#define PG8_SB(b, h) ((4 + (b) * 2 + (h)) * HTB)
#define PG8_STAGE(bufoff, gbase, voff) do { _Pragma("unroll") for (int _i = 0; _i < 2; ++_i) \
        __builtin_amdgcn_global_load_lds((const unsigned*)((const char*)(gbase) + (voff)[_i]), (PG8_LAS unsigned*)(lds + (bufoff) + ldsw + _i * 8192), 16, 0, 0); } while (0)
#define PG8_LDA(dst, b, h) do { _Pragma("unroll") for (int m = 0; m < 4; ++m) _Pragma("unroll") for (int k = 0; k < 2; ++k) dst[m][k] = *(const PG8_LAS bf16x8*)(lds + PG8_SA(b, h) + aoff + m * 2048 + k * 1024); } while (0)
#define PG8_LDB(dst, b, h) do { _Pragma("unroll") for (int n = 0; n < 2; ++n) _Pragma("unroll") for (int k = 0; k < 2; ++k) dst[n][k] = *(const PG8_LAS bf16x8*)(lds + PG8_SB(b, h) + boff + n * 2048 + k * 1024); } while (0)
#define PG8_MMA(ai, bj, At, Bt) do { __builtin_amdgcn_s_setprio(1); _Pragma("unroll") for (int m = 0; m < 4; ++m) _Pragma("unroll") for (int n = 0; n < 2; ++n) _Pragma("unroll") for (int k = 0; k < 2; ++k) \
        acc[ai][bj][m][n] = __builtin_amdgcn_mfma_f32_16x16x32_bf16(Bt[n][k], At[m][k], acc[ai][bj][m][n], 0, 0, 0); __builtin_amdgcn_s_setprio(0); } while (0)
#define PG8_WAIT_V(n) asm volatile("s_waitcnt vmcnt(" #n ")" ::: "memory")
#define PG8_WAIT_L(n) asm volatile("s_waitcnt lgkmcnt(" #n ")" ::: "memory")
#define PG8_BAR __builtin_amdgcn_s_barrier()
#define PG8_SCHED __builtin_amdgcn_sched_barrier(0)
    Unit cur, nxt; int ui = 0;
    cur.ko = 0; cur.nt = K / BK; nxt.ko = 0; nxt.nt = K / BK;
    if (!S.next(0, cur)) return;
    f32x4 acc[2][2][4][2];
#pragma unroll
    for (int a = 0; a < 2; ++a)
#pragma unroll
        for (int b = 0; b < 2; ++b)
#pragma unroll
            for (int m = 0; m < 4; ++m)
#pragma unroll
                for (int n = 0; n < 2; ++n) acc[a][b][m][n] = (f32x4){0.f, 0.f, 0.f, 0.f};
    bf16x8 At[4][2], B0[2][2], B1[2][2];
    const char* cA = (const char*)g.A + (size_t)cur.pm * tstepA + (size_t)cur.ko * 2; const char* cB = (const char*)g.Bt + (size_t)cur.pn * tstepB + (size_t)cur.ko * 2;
    S.a_ready(cur);
    if constexpr (SP2) {
        PG8_STAGE(PG8_SB(0, 0), cB, voffB); PG8_STAGE(PG8_SB(0, 1), cB + hstepB, voffB); PG8_STAGE(PG8_SA(0, 0), cA, voffA); PG8_STAGE(PG8_SA(0, 1), cA + hstepA, voffA);
        if (wr == 1) PG8_BAR;
        PG8_WAIT_V(2); PG8_BAR;
        PG8_STAGE(PG8_SB(1, 0), cB + kstep, voffB); PG8_STAGE(PG8_SA(1, 0), cA + kstep, voffA); PG8_STAGE(PG8_SB(1, 1), cB + hstepB + kstep, voffB);
        PG8_WAIT_V(6); PG8_BAR;
    } else {
        PG8_STAGE(PG8_SB(0, 0), cB, voffB); PG8_STAGE(PG8_SA(0, 0), cA, voffA); PG8_STAGE(PG8_SB(0, 1), cB + hstepB, voffB); PG8_STAGE(PG8_SA(0, 1), cA + hstepA, voffA);
        if (wr == 1) PG8_BAR;
        PG8_WAIT_V(4); PG8_BAR;
        PG8_STAGE(PG8_SB(1, 0), cB + kstep, voffB); PG8_STAGE(PG8_SA(1, 0), cA + kstep, voffA); PG8_STAGE(PG8_SB(1, 1), cB + hstepB + kstep, voffB);
        PG8_WAIT_V(6); PG8_BAR;
    }
    for (;;) {
        nxt.ko = 0; nxt.nt = K / BK;
        const bool has_next = S.next(ui + 1, nxt);
        const int nt = cur.nt;
        const char* nA = has_next ? (const char*)g.A + (size_t)nxt.pm * tstepA + (size_t)nxt.ko * 2 : cA; const char* nB = has_next ? (const char*)g.Bt + (size_t)nxt.pn * tstepB + (size_t)nxt.ko * 2 : cB;
        static_assert(SP2, "this build keeps only the two-super-phase K-loop");
#define PG8_TRIP(WV12) { \
            const bool last = (t == nt - 2); \
            const char* a1 = cA + (size_t)(t + 1) * kstep; \
            const char* a2 = last ? nA : cA + (size_t)(t + 2) * kstep; const char* b2 = last ? nB : cB + (size_t)(t + 2) * kstep; \
            const char* a3 = a2 + kstep; const char* b3 = b2 + kstep; \
            if (last && has_next) S.a_ready(nxt); \
              \
            PG8_LDB(B0, 0, 0); PG8_LDB(B1, 0, 1); PG8_SCHED; PG8_LDA(At, 0, 0); PG8_STAGE(PG8_SA(1, 1), a1 + hstepA, voffA); \
            WV12; PG8_WAIT_L(0); PG8_BAR; PG8_MMA(0, 0, At, B0); PG8_MMA(0, 1, At, B1); PG8_BAR; PG8_SCHED; \
              \
            PG8_LDA(At, 0, 1); PG8_STAGE(PG8_SB(0, 0), b2, voffB); PG8_STAGE(PG8_SB(0, 1), b2 + hstepB, voffB); PG8_STAGE(PG8_SA(0, 0), a2, voffA); \
            WV12; PG8_WAIT_L(0); PG8_BAR; PG8_MMA(1, 0, At, B0); PG8_MMA(1, 1, At, B1); PG8_BAR; PG8_SCHED; \
              \
            PG8_LDB(B0, 1, 0); PG8_LDB(B1, 1, 1); PG8_SCHED; PG8_LDA(At, 1, 0); PG8_STAGE(PG8_SA(0, 1), a2 + hstepA, voffA); \
            PG8_WAIT_V(8); PG8_WAIT_L(0); PG8_BAR; PG8_MMA(0, 0, At, B0); PG8_MMA(0, 1, At, B1); PG8_BAR; PG8_SCHED; \
              \
            PG8_LDA(At, 1, 1); PG8_STAGE(PG8_SB(1, 0), b3, voffB); PG8_STAGE(PG8_SB(1, 1), b3 + hstepB, voffB); PG8_STAGE(PG8_SA(1, 0), a3, voffA); \
            PG8_WAIT_V(8); PG8_WAIT_L(0); PG8_BAR; PG8_MMA(1, 0, At, B0); PG8_MMA(1, 1, At, B1); PG8_BAR; PG8_SCHED; }
        int t = 0;
        if constexpr (Epi::NST == 16) { if (ui > 0) { PG8_TRIP(PG8_WAIT_V(24)) t = 2; } }
        if constexpr (Epi::NST == 8) { if (ui > 0) { PG8_TRIP(PG8_WAIT_V(16)) t = 2; } }
        for (; t < nt; t += 2) PG8_TRIP(PG8_WAIT_V(8))
#undef PG8_TRIP
        if constexpr (ALIGN_EPI) { if (wr == 0) PG8_BAR; }
        if constexpr (!Epi::AFTER_DRAIN) { E(acc, cur, wr, wc, fr, fq); S.done(cur); }
        if (!has_next) break;
#pragma unroll
        for (int a = 0; a < 2; ++a)
#pragma unroll
            for (int b = 0; b < 2; ++b)
#pragma unroll
                for (int m = 0; m < 4; ++m)
#pragma unroll
                    for (int n = 0; n < 2; ++n) acc[a][b][m][n] = (f32x4){0.f, 0.f, 0.f, 0.f};
        cur = nxt; cA = nA; cB = nB; ++ui;
        if constexpr (ALIGN_EPI) { if (wr == 1) PG8_BAR; }
    }
    PG8_WAIT_V(0);
    if constexpr (!ALIGN_EPI) { if (wr == 0) PG8_BAR; }
    PG8_BAR;
    if constexpr (Epi::AFTER_DRAIN) { E.fused(acc, cur, wr, wc, fr, fq, lds, wid, lane); S.done(cur); }
#undef PG8_SA
#undef PG8_SB
#undef PG8_STAGE
#undef PG8_LDA
#undef PG8_LDB
#undef PG8_MMA
#undef PG8_WAIT_V
#undef PG8_WAIT_L
#undef PG8_BAR
#undef PG8_SCHED
}
}
namespace attn {
typedef unsigned short bf16;
using bf16x8 = __attribute__((ext_vector_type(8))) short;
using s16x4  = __attribute__((ext_vector_type(4))) short;
using f32x16 = __attribute__((ext_vector_type(16))) float;
using u32x4  = __attribute__((ext_vector_type(4))) unsigned;
constexpr int   D = 128, NW = 8, QBLK = 32, KVBLK = 64;
constexpr float SCALE = 0.088388347648318440f;
constexpr float THR = 8.f;
constexpr int LDQ = 3584, LDK = 3584, LDO = 2048;
constexpr size_t SHM_V = KVBLK * D * 2, SHM_K = KVBLK * D * 2, SHM_ATTN = 2 * SHM_V + 2 * SHM_K + NW * 64 * 4;
#define KSWZ(row, colB) ((row) * 256 + ((colB) ^ (((row) & 7) << 4)))
#define SBAR() __builtin_amdgcn_sched_barrier(0)
__device__ __forceinline__ int crow(int r, int hi) { return (r & 3) + 8 * (r >> 2) + 4 * hi; }
__device__ __forceinline__ unsigned cvtpk(float lo, float hi) { unsigned r; asm volatile("v_cvt_pk_bf16_f32 %0, %1, %2" : "=v"(r) : "v"(lo), "v"(hi)); return r; }
__device__ __forceinline__ bf16x8 ld8(const bf16* p) { return *reinterpret_cast<const bf16x8*>(p); }
__device__ __forceinline__ void partialSM(f32x16& p0, f32x16& p1, float& m_reg, float& mn, float& alpha) {
  constexpr float C = SCALE * 1.4426950408889634f;
  float pmax = p0[0]; for (int r = 1; r < 16; ++r) pmax = fmaxf(pmax, p0[r]); for (int r = 0; r < 16; ++r) pmax = fmaxf(pmax, p1[r]);
  { auto rr = __builtin_amdgcn_permlane32_swap(__float_as_uint(pmax), __float_as_uint(pmax), false, false);
    pmax = fmaxf(__uint_as_float(rr[0]), __uint_as_float(rr[1])); }
  if (__builtin_expect(__all(pmax - m_reg <= THR / SCALE), 1)) { mn = m_reg; alpha = 1.f; }
  else { mn = fmaxf(m_reg, pmax); alpha = __builtin_amdgcn_exp2f((m_reg - mn) * C); m_reg = mn; }
  float mnC = -mn * C;
  for (int r = 0; r < 16; ++r) p0[r] = fmaf(p0[r], C, mnC); for (int r = 0; r < 16; ++r) p1[r] = fmaf(p1[r], C, mnC);
  for (int r = 0; r < 16; ++r) p0[r] = __builtin_amdgcn_exp2f(p0[r]);
}
__device__ __forceinline__ void finishSM(f32x16& p0, f32x16& p1, float alpha, float& l_reg, bf16x8& pa0, bf16x8& pa1, bf16x8& pa2, bf16x8& pa3) {
  for (int r = 0; r < 16; ++r) p1[r] = __builtin_amdgcn_exp2f(p1[r]);
  float ps = 0; for (int r = 0; r < 16; ++r) ps += p0[r]; for (int r = 0; r < 16; ++r) ps += p1[r];
  { auto rr = __builtin_amdgcn_permlane32_swap(__float_as_uint(ps), __float_as_uint(ps), false, false);
    ps = __uint_as_float(rr[0]) + __uint_as_float(rr[1]); }
  l_reg = l_reg * alpha + ps;
#define PK4(P, BASE, OUT) do { unsigned a0 = cvtpk(P[BASE + 0], P[BASE + 1]), a1 = cvtpk(P[BASE + 2], P[BASE + 3]);   \
    unsigned b0 = cvtpk(P[BASE + 4], P[BASE + 5]), b1 = cvtpk(P[BASE + 6], P[BASE + 7]);                              \
    auto r0 = __builtin_amdgcn_permlane32_swap(a0, b0, false, false); auto r1 = __builtin_amdgcn_permlane32_swap(a1, b1, false, false); \
    u32x4 w = {r0[0], r1[0], r0[1], r1[1]}; OUT = *reinterpret_cast<bf16x8*>(&w); } while (0)
  PK4(p0, 0, pa0); PK4(p0, 8, pa1); PK4(p1, 0, pa2); PK4(p1, 8, pa3);
#undef PK4
}
__device__ __forceinline__ void qkt(f32x16& p0, f32x16& p1, const bf16* Ks, const bf16x8* qr, int r32, int hi) {
  p0 = f32x16{}; p1 = f32x16{};
  for (int d0 = 0; d0 < 8; ++d0) { int cb = (d0 * 16 + hi * 8) * 2;
    bf16x8 b0 = *reinterpret_cast<const bf16x8*>((const char*)Ks + KSWZ(r32, cb));
    bf16x8 b1 = *reinterpret_cast<const bf16x8*>((const char*)Ks + KSWZ(32 + r32, cb));
    p0 = __builtin_amdgcn_mfma_f32_32x32x16_bf16(b0, qr[d0], p0, 0, 0, 0);
    p1 = __builtin_amdgcn_mfma_f32_32x32x16_bf16(b1, qr[d0], p1, 0, 0, 0); }
}
__device__ __forceinline__ int v_st(int k, int c) { const int kk = (k & ~0xC) | ((k & 4) << 1) | ((k & 8) >> 1); return ((kk >> 3) * 4 + (c >> 5)) * 512 + ((kk & 7) * 32 + (c & 31)) * 2; }
__device__ __forceinline__ int v_rd_base(int lane) { return ((lane & 3) << 3) | (((lane >> 2) & 3) << 6) | (((lane >> 4) & 1) << 5) | (((lane >> 5) & 1) << 8); }
constexpr int v_rd_off(int d0, int ks, int half) { return d0 * 512 + ks * 4096 + half * 2048; }
template <int OFF> __device__ __forceinline__ s16x4 tr_read(int vb) {
  s16x4 r; asm volatile("ds_read_b64_tr_b16 %0, %1 offset:%2" : "=&v"(r) : "v"(vb), "i"(OFF) : "memory"); return r;
}
template <int D0> __device__ __forceinline__ void pv_one(f32x16& od, int vb, bf16x8 pa0, bf16x8 pa1, bf16x8 pa2, bf16x8 pa3) {
  const s16x4 l0 = tr_read<v_rd_off(D0, 0, 0)>(vb), h0 = tr_read<v_rd_off(D0, 0, 1)>(vb), l1 = tr_read<v_rd_off(D0, 1, 0)>(vb), h1 = tr_read<v_rd_off(D0, 1, 1)>(vb);
  const s16x4 l2 = tr_read<v_rd_off(D0, 2, 0)>(vb), h2 = tr_read<v_rd_off(D0, 2, 1)>(vb), l3 = tr_read<v_rd_off(D0, 3, 0)>(vb), h3 = tr_read<v_rd_off(D0, 3, 1)>(vb);
  asm volatile("s_waitcnt lgkmcnt(0)" ::: "memory"); SBAR();
#define PK(L, H) (bf16x8){L[0], L[1], L[2], L[3], H[0], H[1], H[2], H[3]}
  od = __builtin_amdgcn_mfma_f32_32x32x16_bf16(pa0, PK(l0, h0), od, 0, 0, 0);
  od = __builtin_amdgcn_mfma_f32_32x32x16_bf16(pa1, PK(l1, h1), od, 0, 0, 0);
  od = __builtin_amdgcn_mfma_f32_32x32x16_bf16(pa2, PK(l2, h2), od, 0, 0, 0);
  od = __builtin_amdgcn_mfma_f32_32x32x16_bf16(pa3, PK(l3, h3), od, 0, 0, 0);
#undef PK
}
__device__ __forceinline__ void pv_d0(f32x16* o, int vb, bf16x8 pa0, bf16x8 pa1, bf16x8 pa2, bf16x8 pa3) {
  pv_one<0>(o[0], vb, pa0, pa1, pa2, pa3); pv_one<1>(o[1], vb, pa0, pa1, pa2, pa3); pv_one<2>(o[2], vb, pa0, pa1, pa2, pa3); pv_one<3>(o[3], vb, pa0, pa1, pa2, pa3);
}
__device__ __forceinline__ void attn_unit(const bf16* __restrict__ Qb, const bf16* __restrict__ Kh, const bf16* __restrict__ Vh, bf16* __restrict__ Ob, int seq, char* lds, int wave_s) {
  constexpr int SDEPTH = 2;
  int tid_ = wave_s * 64 + lane_id(); asm volatile("" : "+v"(tid_));
  const int tid = tid_, wid = tid >> 6, lane = tid & 63, r32 = lane & 31, hi = lane >> 5;
  bf16* V_lds = (bf16*)lds; bf16* K_lds = (bf16*)(lds + 2 * SHM_V);
  float* ws = (float*)(lds + 2 * SHM_V + 2 * SHM_K) + wid * 64; float* li_l = ws; float* al_l = ws + 32;
  float m_reg = -1e30f, l_reg = 0; f32x16 o[4] = {}; bf16x8 qr[8];
  const bf16* Qw = Qb + (long)(wid * QBLK + r32) * LDQ + hi * 8;
#pragma unroll
  for (int d0 = 0; d0 < 8; ++d0) qr[d0] = ld8(Qw + d0 * 16);
  const int sr = tid >> 4, sc = (tid & 15) * 8, vst0 = v_st(sr, sc), vst1 = v_st(32 + sr, sc);
  const int vb0 = (int)(uintptr_t)V_lds + v_rd_base(lane);
  struct { bf16x8 vs0, vs1, ks0, ks1; } sr_[SDEPTH];
#define SLOAD(i, k0) do { sr_[i].vs0 = ld8(&Vh[(long)((k0) + sr) * LDK + sc]); sr_[i].vs1 = ld8(&Vh[(long)((k0) + 32 + sr) * LDK + sc]); \
    sr_[i].ks0 = ld8(&Kh[(long)((k0) + sr) * LDK + sc]); sr_[i].ks1 = ld8(&Kh[(long)((k0) + 32 + sr) * LDK + sc]); } while (0)
#define SWRITE(b, i) do { *(bf16x8*)((char*)V_lds + (b) * SHM_V + vst0) = sr_[i].vs0;          \
    *(bf16x8*)((char*)V_lds + (b) * SHM_V + vst1) = sr_[i].vs1; int kc = sc * 2;               \
    *(bf16x8*)((char*)K_lds + (b) * SHM_K + KSWZ(sr, kc)) = sr_[i].ks0;                       \
    *(bf16x8*)((char*)K_lds + (b) * SHM_K + KSWZ(32 + sr, kc)) = sr_[i].ks1; } while (0)
#define SWAIT() asm volatile("s_waitcnt vmcnt(4)" ::: "memory")
#define RESC(a) do { if (__any((a) < 1.f)) { if (hi == 0) al_l[r32] = (a); asm volatile("s_waitcnt lgkmcnt(0)" ::: "memory"); \
    for (int d = 0; d < 4; ++d) for (int r = 0; r < 16; ++r) o[d][r] *= al_l[crow(r, hi)]; } } while (0)
  f32x16 pA0, pA1, pB0, pB1; float mnA, mnB, alA, alB; bf16x8 pa0, pa1, pa2, pa3; const int NT = seq / KVBLK;
  constexpr int SE = 0, SO = SDEPTH - 1;
  SLOAD(SE, 0); asm volatile("s_waitcnt vmcnt(0)" ::: "memory"); SWRITE(0, SE); __syncthreads();
  qkt(pA0, pA1, K_lds, qr, r32, hi); partialSM(pA0, pA1, m_reg, mnA, alA);
  SLOAD(SO, KVBLK); if (2 < NT) SLOAD(SE, 2 * KVBLK);
  SWAIT(); SWRITE(1, SO); __syncthreads();
  for (int j = 1; j + 1 < NT; j += 2) {
    SBAR(); qkt(pB0, pB1, (bf16*)((char*)K_lds + SHM_K), qr, r32, hi);
    finishSM(pA0, pA1, alA, l_reg, pa0, pa1, pa2, pa3); SBAR();
    SLOAD(SO, (j + SDEPTH) * KVBLK); SBAR();
    pv_d0(o, vb0, pa0, pa1, pa2, pa3); partialSM(pB0, pB1, m_reg, mnB, alB);
    __syncthreads(); SWAIT(); SWRITE(0, SE);
    RESC(alB); __syncthreads();
    SBAR(); qkt(pA0, pA1, K_lds, qr, r32, hi);
    finishSM(pB0, pB1, alB, l_reg, pa0, pa1, pa2, pa3); SBAR();
    if (j + 3 < NT) SLOAD(SE, (j + 1 + SDEPTH) * KVBLK); SBAR();
    pv_d0(o, vb0 + (int)SHM_V, pa0, pa1, pa2, pa3); partialSM(pA0, pA1, m_reg, mnA, alA);
    __syncthreads(); SWAIT(); SWRITE(1, SO);
    RESC(alA); __syncthreads();
  }
  SBAR(); qkt(pB0, pB1, (bf16*)((char*)K_lds + SHM_K), qr, r32, hi);
  finishSM(pA0, pA1, alA, l_reg, pa0, pa1, pa2, pa3); SBAR();
  pv_d0(o, vb0, pa0, pa1, pa2, pa3); partialSM(pB0, pB1, m_reg, mnB, alB);
  __syncthreads(); RESC(alB);
  finishSM(pB0, pB1, alB, l_reg, pa0, pa1, pa2, pa3); SBAR();
  pv_d0(o, vb0 + (int)SHM_V, pa0, pa1, pa2, pa3);
  if (hi == 0) li_l[r32] = l_reg; asm volatile("s_waitcnt lgkmcnt(0)" ::: "memory");
  float rli[16];
#pragma unroll
  for (int r = 0; r < 16; ++r) rli[r] = __builtin_amdgcn_rcpf(li_l[crow(r, hi)]);
  bf16* Ow = Ob + (long)(wid * QBLK) * LDO;
#pragma unroll
  for (int r = 0; r < 16; ++r) { int orow = crow(r, hi);
    for (int d0 = 0; d0 < 4; ++d0) { const float v = o[d0][r] * rli[r]; unsigned u = __float_as_uint(v); u = (u + 0x7fffu + ((u >> 16) & 1u)) >> 16;
      Ow[(long)orow * LDO + d0 * 32 + r32] = (bf16)u; } }
  __syncthreads();
#undef SLOAD
#undef SWRITE
#undef SWAIT
#undef RESC
}
#undef KSWZ
#undef SBAR
}
constexpr int DM = 2048, NB = 8, SEQ = 4096, CTXL = 256, DEPTH = 4;
constexpr int TPB = SEQ + CTXL;
constexpr int M = NB * TPB;
constexpr int ZW = 3584, FF = 5632, NMOD = 6 * DM;
constexpr int CONVW = 512, SSMW = 512, ATTW = 1024, NG = 32, NP = 64, NSG = 16;
constexpr int Z_CV = 0, Z_CB = 512, Z_CC = 1024, Z_SSM = 1536, Z_Q = 2048, Z_K = 3072, Z_V = 3328;
constexpr int MIX_CONV = 0, MIX_SSM = 512, MIX_ATT = 1024;
constexpr float RMS_EPS = 1e-6f;
constexpr int NWAVES = 8;
#ifndef REP_MASK
#define REP_MASK 0
#endif
#define NREP(b) (1 + ((REP_MASK >> (b)) & 1))

constexpr size_t MiB = 1u << 20;
constexpr size_t WS_CTL = 0, CTL_ZERO_BYTES = 1 * MiB;
constexpr size_t WS_MODP = 1 * MiB;
constexpr size_t WS_MOD  = 15 * MiB;
constexpr size_t WS_ROPE = 17 * MiB;
constexpr size_t WS_BBAR = 18 * MiB;
constexpr size_t WS_POW  = 20 * MiB;
constexpr size_t WS_KT   = 25 * MiB;
constexpr size_t WS_W    = 33 * MiB, W_LAYER = 89 * MiB;
constexpr size_t W_IN = 0, W_OUT = 14 * MiB, W_GU = 22 * MiB, W_DOWN = 66 * MiB, W_GLU = 88 * MiB;
constexpr size_t WS_TW   = WS_W + 4 * W_LAYER;
constexpr size_t WS_W1   = WS_TW + 96 * MiB;
constexpr size_t WS_X    = WS_W1 + 32 * MiB;
constexpr size_t WS_H    = WS_X + 272 * MiB;
constexpr size_t WS_Y    = WS_H + 136 * MiB;
constexpr size_t WS_UH   = WS_Y, WS_SB = WS_Y + 60 * MiB;
constexpr size_t WS_Z    = WS_Y + 136 * MiB;
constexpr size_t WS_MIX  = WS_Z + 238 * MiB;
constexpr size_t WS_ACT  = WS_Z;
constexpr size_t WS_G    = WS_MIX + 136 * MiB;
constexpr size_t WS_YP   = WS_G + 34 * MiB;
constexpr size_t WS_END  = WS_YP + 64 * MiB;
static_assert((size_t)M * DM * 4 == 272 * MiB && (size_t)M * ZW * 2 == 238 * MiB && (size_t)M * FF * 2 == 374 * MiB && (size_t)32 * SSM_RPG * UH_LD * 2 == 60 * MiB && (size_t)32 * SSM_RPG * 256 * 4 == 40 * MiB, "ws map");
static_assert(WS_END <= 1536 * MiB, "ws budget");
constexpr int CW_BAR = 4096;

constexpr int RING_OFF = 0, RING_BYTES = 131072;
constexpr int LDSCTL_OFF = RING_BYTES, MISC_OFF = LDSCTL_OFF + 320;
constexpr int LDS_BYTES = 147456;

#define GAS __attribute__((address_space(1)))
#define LAS __attribute__((address_space(3)))
typedef unsigned short bf16;
typedef unsigned v4u __attribute__((ext_vector_type(4)));
typedef unsigned v2u __attribute__((ext_vector_type(2)));
typedef float f32x4 __attribute__((ext_vector_type(4)));
typedef float f32x2 __attribute__((ext_vector_type(2)));
#define LDS_WAIT() asm volatile("s_waitcnt lgkmcnt(0)" ::: "memory")
#define VM_WAIT() asm volatile("s_waitcnt vmcnt(0)" ::: "memory")
__device__ __forceinline__ unsigned f2bf(float f) { unsigned u = __builtin_bit_cast(unsigned, f); return (u + 0x7fffu + ((u >> 16) & 1u)) >> 16; }
__device__ __forceinline__ unsigned pk2(float lo, float hi) { return f2bf(lo) | (f2bf(hi) << 16); }
__device__ __forceinline__ float blo(unsigned w) { return __uint_as_float(w << 16); }
__device__ __forceinline__ float bhi(unsigned w) { return __uint_as_float(w & 0xffff0000u); }
__device__ __forceinline__ float wave_sum(float v) {
#pragma unroll
    for (int o = 1; o < 64; o <<= 1) v += __shfl_xor(v, o);
    return v;
}

#define XB_TMO      128
#define XB_XCNT(j)  (256  + 64 * (j))
#define XB_XSUB(j)  (1280 + 64 * (j))
#define XB_XGEN(j)  (2304 + 64 * (j))
#define XB_TOP      3328
#define XB_TOPGEN   3392
#define XCD_BAR_WORDS 3456
#define XB_SPIN_CAP (1u << 18)

__device__ __forceinline__ unsigned xb_ld(unsigned* p)              { return __hip_atomic_load(p, __ATOMIC_RELAXED, __HIP_MEMORY_SCOPE_AGENT); }
__device__ __forceinline__ unsigned xb_add(unsigned* p, unsigned v) { return __hip_atomic_fetch_add(p, v, __ATOMIC_RELAXED, __HIP_MEMORY_SCOPE_AGENT); }
__device__ __forceinline__ unsigned xb_xcc_id() { return (unsigned)__builtin_amdgcn_s_getreg((3 << 11) | 20) & 0xFu; }
#define XB_SPIN(cond, bar) do { unsigned _sp = 0; while (cond) { __builtin_amdgcn_s_sleep(1); \
    if ((++_sp & 255u) == 0u) { if (xb_ld(&(bar)[XB_TMO])) break; if (_sp > XB_SPIN_CAP) { atomicAdd(&(bar)[XB_TMO], 1u); break; } } } } while (0)

struct XcdBarrier {
    unsigned* bar; unsigned x;
    volatile LAS unsigned* st;
};

__device__ __forceinline__ XcdBarrier xcd_barrier_post(unsigned* bar, volatile LAS unsigned* st, bool leader  ) {
    XcdBarrier b; b.bar = bar; b.x = xb_xcc_id(); b.st = st;
    if (leader) (void)xb_add(&bar[XB_XCNT(b.x)], 1u);
    return b;
}
__device__ __forceinline__ void xcd_barrier_complete(unsigned* bar, unsigned x, unsigned& nloc, unsigned& nx) {
    const unsigned G = gridDim.x * gridDim.y * gridDim.z;
    unsigned sum, cnt, mine, sp = 0u;
    for (;;) {
        sum = 0u; cnt = 0u; mine = 0u;
#pragma unroll
        for (unsigned j = 0; j < 16; ++j) { const unsigned c = xb_ld(&bar[XB_XCNT(j)]); sum += c; cnt += (c > 0u) ? 1u : 0u; mine = (j == x) ? c : mine; }
        if (sum == G) break;
        __builtin_amdgcn_s_sleep(1);
        if ((++sp & 255u) == 0u) { if (xb_ld(&bar[XB_TMO])) break; if (sp > XB_SPIN_CAP) { atomicAdd(&bar[XB_TMO], 1u); break; } }
    }
    nloc = mine > 0u ? mine : 1u; nx = cnt > 0u ? cnt : 1u;
}

__device__ __forceinline__ void xcd_barrier(const XcdBarrier& b, bool leader  ) {
    asm volatile("s_waitcnt vmcnt(0)" ::: "memory");
    __syncthreads();
    if (leader) {
        unsigned* bar = b.bar;
        __builtin_amdgcn_s_waitcnt(0);
        unsigned nloc = b.st[0], nx = b.st[1];
        if (nloc == 0u) { xcd_barrier_complete(bar, b.x, nloc, nx); b.st[0] = nloc; b.st[1] = nx; }
        const unsigned old = xb_add(&bar[XB_XSUB(b.x)], 1u);
        const unsigned gen = old / nloc;
        if (old + 1u == (gen + 1u) * nloc) {
            __builtin_amdgcn_fence(__ATOMIC_RELEASE, "agent");
            asm volatile("s_waitcnt vmcnt(0)" ::: "memory");
            const unsigned og = xb_add(&bar[XB_TOP], 1u);
            const unsigned tg = og / nx;
            if (og + 1u == (tg + 1u) * nx) xb_add(&bar[XB_TOPGEN], 1u);
            else XB_SPIN(xb_ld(&bar[XB_TOPGEN]) == tg, bar);
            __builtin_amdgcn_fence(__ATOMIC_ACQUIRE, "agent");
            xb_add(&bar[XB_XGEN(b.x)], 1u);
            asm volatile("s_waitcnt vmcnt(0)" ::: "memory");
        } else {
            XB_SPIN(xb_ld(&bar[XB_XGEN(b.x)]) == gen, bar);
            __builtin_amdgcn_fence(__ATOMIC_ACQUIRE, "agent");
            asm volatile("s_waitcnt vmcnt(0)" ::: "memory");
        }
    }
    __syncthreads();
}

struct Params { const float* in[28]; float* out; unsigned char* ws; int ph_lo, ph_hi; };
typedef const __attribute__((address_space(4))) Params* KP;
__device__ __forceinline__ KP kparams() { KP kp = (KP)__builtin_amdgcn_kernarg_segment_ptr(); asm volatile("" : "+s"(kp)); return kp; }
enum { I_X = 0, I_C, I_CTX, I_CCTX, I_WMOD, I_BMOD, I_GPREMIX, I_GPOSTMIX, I_GPREFFN, I_GPOSTFFN, I_WIN, I_CONVW, I_LAMRE, I_LAMIM, I_LOGDT, I_BRE, I_BIM, I_CRE, I_CIM,
       I_SSMD, I_WGLU, I_BGLU, I_QNORM, I_KNORM, I_WOUT, I_WGATE, I_WUP, I_WDOWN };

__device__ __forceinline__ void transpose_item(const float* __restrict__ W, int K, int N, bf16* WT, int k0, int n0, int dst_row0, LAS float* scr, int lane) {
#pragma unroll 8
    for (int i = 0; i < 32; ++i) { const int kk = 2 * i + (lane >> 5); scr[kk * 33 + (lane & 31)] = W[(size_t)(k0 + kk) * N + n0 + (lane & 31)]; }
    LDS_WAIT(); asm volatile("" ::: "memory");
    const int c = lane & 7;
#pragma unroll
    for (int j = 0; j < 4; ++j) { const int n = (lane >> 3) + 8 * j; const LAS float* s = scr + (8 * c) * 33 + n;
        v4u o; o.x = pk2(s[0 * 33], s[1 * 33]); o.y = pk2(s[2 * 33], s[3 * 33]); o.z = pk2(s[4 * 33], s[5 * 33]); o.w = pk2(s[6 * 33], s[7 * 33]);
        *(GAS v4u*)(WT + (size_t)(dst_row0 + n) * K + k0 + 8 * c) = o; }
    LDS_WAIT(); asm volatile("" ::: "memory");
}
constexpr int IT_MOD = DEPTH * 8 * 48;
constexpr int IT_ROPE = 32, IT_SSM = 256;
constexpr int TPL_IN = 32 * 112, TPL_OUT = 32 * 64, TPL_G = 32 * 176, TPL_D = 88 * 64, TPL_GLU = 8 * 16;
constexpr int TPL = TPL_IN + TPL_OUT + 2 * TPL_G + TPL_D + TPL_GLU;
constexpr int IT_TOTAL = IT_MOD + IT_ROPE + IT_SSM + DEPTH * TPL;

__device__ __forceinline__ void prologue_a(KP P, LAS unsigned char* lds, int wave, int lane) {
    LAS float* scr = (LAS float*)(lds + RING_OFF + wave * 16384);
    const int G = gridDim.x, gw = wave * G + (int)blockIdx.x, NGW = NWAVES * G;
    unsigned char* ws = P->ws;
    for (int it = gw; it < IT_TOTAL; it += NGW) {
        int r = it;
        if (r < IT_MOD) {
            const int l = r / 384, kc = (r % 384) / 48, nc = r % 48;
#pragma unroll
            for (int j = 0; j < 9; ++j)
#pragma unroll
                for (int q = 0; q < 4; ++q) { const int kk = q * 64 + lane, k = kc * 256 + kk;
                    const float cv = (j < 8) ? P->in[I_C][j * DM + k] : P->in[I_CCTX][k];
                    scr[j * 256 + kk] = cv / (1.0f + __expf(-cv)); }
            LDS_WAIT(); asm volatile("" ::: "memory");
            f32x4 acc[9];
#pragma unroll
            for (int j = 0; j < 9; ++j) acc[j] = (f32x4){0.f, 0.f, 0.f, 0.f};
            const float* wp = P->in[I_WMOD] + ((size_t)l * DM + kc * 256) * NMOD + nc * 256 + lane * 4;
#pragma unroll 4
            for (int kk = 0; kk < 256; ++kk) { const f32x4 w = *(const f32x4*)(wp + (size_t)kk * NMOD);
#pragma unroll
                for (int j = 0; j < 9; ++j) { const float s = scr[j * 256 + kk]; acc[j] += w * s; } }
            float* mp = (float*)(ws + WS_MODP) + ((size_t)(kc * DEPTH + l) * 9) * NMOD + nc * 256 + lane * 4;
#pragma unroll
            for (int j = 0; j < 9; ++j) *(f32x4*)(mp + (size_t)j * NMOD) = acc[j];
            LDS_WAIT(); asm volatile("" ::: "memory");
            continue;
        }
        r -= IT_MOD;
        if (r < IT_ROPE) {
            const int e = r * 64 + lane, coord = e >> 5, i = e & 31;
            const double inv = exp(-(double)i * (9.210340371976184 / 32.0));
            const double ang = (double)coord * inv;
            float* rp = (float*)(ws + WS_ROPE);
            rp[e] = (float)cos(ang); rp[2048 + e] = (float)sin(ang);
            continue;
        }
        r -= IT_ROPE;
        if (r < IT_SSM) {
            const int idx = r * 64 + lane;
            const int p = idx & 63, ldg = idx >> 6;
            const double lre = (double)P->in[I_LAMRE][idx], lim = (double)P->in[I_LAMIM][idx];
            const double dt = exp((double)P->in[I_LOGDT][ldg]);
            const double ea = exp(lre * dt), th = lim * dt;
            const double lbre = ea * cos(th), lbim = ea * sin(th);
            const double nr = lbre - 1.0, ni = lbim, dd = lre * lre + lim * lim;
            const double qre = (nr * lre + ni * lim) / dd, qim = (ni * lre - nr * lim) / dd;
            f32x2* bb = (f32x2*)(ws + WS_BBAR) + (size_t)idx * 16;
#pragma unroll
            for (int n = 0; n < 16; ++n) {
                const double bre = (double)P->in[I_BRE][(size_t)idx * 16 + n], bim = (double)P->in[I_BIM][(size_t)idx * 16 + n];
                bb[n] = (f32x2){(float)(qre * bre - qim * bim), (float)(qre * bim + qim * bre)};
            }
            f32x2* pw = (f32x2*)(ws + WS_POW) + (size_t)ldg * 33 * 64 + p;
            for (int e = 0; e <= 32; ++e) { const double m = exp(lre * dt * (double)e), a = th * (double)e; pw[e * 64] = (f32x2){(float)(m * cos(a)), (float)(m * sin(a))}; }
            continue;
        }
        r -= IT_SSM;
        const int l = r / TPL; r -= l * TPL;
        bf16* wl = (bf16*)(ws + WS_W + (size_t)l * W_LAYER);
        if (r < TPL_IN) { const int kb = r / 112, nb = r % 112; transpose_item(P->in[I_WIN] + (size_t)l * DM * ZW, DM, ZW, (bf16*)((unsigned char*)wl + W_IN), 64 * kb, 32 * nb, 32 * nb, scr, lane); continue; }
        r -= TPL_IN;
        if (r < TPL_OUT) { const int kb = r / 64, nb = r % 64; transpose_item(P->in[I_WOUT] + (size_t)l * DM * DM, DM, DM, (bf16*)((unsigned char*)wl + W_OUT), 64 * kb, 32 * nb, 32 * nb, scr, lane); continue; }
        r -= TPL_OUT;
        if (r < 2 * TPL_G) { const int up = r >= TPL_G; if (up) r -= TPL_G; const int kb = r / 176, nb = r % 176, n0 = 32 * nb;
            transpose_item(P->in[up ? I_WUP : I_WGATE] + (size_t)l * DM * FF, DM, FF, (bf16*)((unsigned char*)wl + W_GU), 64 * kb, n0, (n0 >> 7) * 256 + (n0 & 127) + (up ? 128 : 0), scr, lane); continue; }
        r -= 2 * TPL_G;
        if (r < TPL_D) { const int kb = r / 64, nb = r % 64; transpose_item(P->in[I_WDOWN] + (size_t)l * FF * DM, FF, DM, (bf16*)((unsigned char*)wl + W_DOWN), 64 * kb, 32 * nb, 32 * nb, scr, lane); continue; }
        r -= TPL_D;
        { const int kb = r / 16, nb = r % 16; transpose_item(P->in[I_WGLU] + (size_t)l * 512 * 512, 512, 512, (bf16*)((unsigned char*)wl + W_GLU), 64 * kb, 32 * nb, 32 * nb, scr, lane); }
    }
}
__device__ __forceinline__ void prologue_b(KP P, int tid) {
    const int total = DEPTH * 9 * NMOD;
    const float* mp = (const float*)(P->ws + WS_MODP); float* mo = (float*)(P->ws + WS_MOD);
    for (int idx = (int)blockIdx.x * 512 + tid; idx < total; idx += (int)gridDim.x * 512) {
        const int l = idx / (9 * NMOD), n = idx % NMOD;
        float s = P->in[I_BMOD][l * NMOD + n];
#pragma unroll
        for (int kc = 0; kc < 8; ++kc) s += mp[(size_t)kc * total + idx];
        mo[idx] = s;
    }
}

__device__ __forceinline__ void prologue_kt(KP P, int tid) {
    const f32x2* pw = (const f32x2*)(P->ws + WS_POW); const f32x2* bbar = (const f32x2*)(P->ws + WS_BBAR); float* kt = (float*)(P->ws + WS_KT);
    for (int idx = (int)blockIdx.x * 512 + tid; idx < DEPTH * 32 * 2 * 32 * 16; idx += (int)gridDim.x * 512) {
        const int no = idx & 15, tau = (idx >> 4) & 31, dir = (idx >> 9) & 1, g = (idx >> 10) & 31, l = idx >> 15;
        const int ldg = (l * 2 + dir) * 32 + g;
        float acc[16];
#pragma unroll
        for (int n = 0; n < 16; ++n) acc[n] = 0.f;
        for (int p = 0; p < 64; ++p) {
            const float cre = P->in[I_CRE][((size_t)ldg * 16 + no) * 64 + p], cim = P->in[I_CIM][((size_t)ldg * 16 + no) * 64 + p];
            const f32x2 w = pw[((size_t)ldg * 33 + tau) * 64 + p];
            const float are = cre * w[0] - cim * w[1], aim = cre * w[1] + cim * w[0];
            const f32x4* bp = (const f32x4*)(bbar + ((size_t)ldg * 64 + p) * 16);
#pragma unroll
            for (int q = 0; q < 8; ++q) { const f32x4 b2 = bp[q]; acc[2 * q] += are * b2[0] - aim * b2[1]; acc[2 * q + 1] += are * b2[2] - aim * b2[3]; }
        }
#pragma unroll
        for (int q = 0; q < 4; ++q) *(f32x4*)(kt + (size_t)idx * 16 + q * 4) = (f32x4){acc[q * 4], acc[q * 4 + 1], acc[q * 4 + 2], acc[q * 4 + 3]};
    }
}
__device__ __forceinline__ void prologue_s5w(KP P, int tid) {
    const f32x2* pw = (const f32x2*)(P->ws + WS_POW); const f32x2* bbar = (const f32x2*)(P->ws + WS_BBAR); const float* kt = (const float*)(P->ws + WS_KT);
    bf16* TW = (bf16*)(P->ws + WS_TW); bf16* W1 = (bf16*)(P->ws + WS_W1);
    for (int it = (int)blockIdx.x * 512 + tid; it < DEPTH * 32 * 65536; it += (int)gridDim.x * 512) {
        const int lg = it >> 16, l = lg >> 5, g = lg & 31; int r = it & 65535; float v[8];
        if (r < 49152) {
            const int row = r / 96, ch = r - row * 96, t = row >> 4, no = row & 15, k0 = ch * 8;
            if (k0 < 512) {
                const int s = k0 >> 4, ni0 = k0 & 15;
#pragma unroll
                for (int e = 0; e < 8; ++e) v[e] = 0.f;
                if (t >= s) { const float* kp = kt + ((((size_t)(l * 32 + g) * 2 + 0) * 32 + (t - s)) * 16 + no) * 16 + ni0;
#pragma unroll
                    for (int e = 0; e < 8; ++e) v[e] += kp[e]; }
                if (s >= t) { const float* kp = kt + ((((size_t)(l * 32 + g) * 2 + 1) * 32 + (s - t)) * 16 + no) * 16 + ni0;
#pragma unroll
                    for (int e = 0; e < 8; ++e) v[e] += kp[e]; }
                if (t == s) { const float dv = P->in[I_SSMD][l * SSMW + g * NSG + no];
#pragma unroll
                    for (int e = 0; e < 8; ++e) if (ni0 + e == no) v[e] += dv; }
            } else {
                const int kk = k0 - 512, dir = kk >> 7, part = (kk >> 6) & 1, p0 = kk & 63, ep = dir == 0 ? t + 1 : 32 - t, ldg = (l * 2 + dir) * 32 + g;
#pragma unroll
                for (int e = 0; e < 8; ++e) { const int p = p0 + e; const f32x2 w = pw[((size_t)ldg * 33 + ep) * 64 + p];
                    const float cre = P->in[I_CRE][((size_t)ldg * 16 + no) * 64 + p], cim = P->in[I_CIM][((size_t)ldg * 16 + no) * 64 + p];
                    v[e] = part == 0 ? (cre * w[0] - cim * w[1]) : -(cre * w[1] + cim * w[0]); }
            }
            v4u o; o.x = pk2(v[0], v[1]); o.y = pk2(v[2], v[3]); o.z = pk2(v[4], v[5]); o.w = pk2(v[6], v[7]);
            *(v4u*)(TW + ((size_t)lg * 512 + row) * 768 + k0) = o;
        } else {
            r -= 49152;
            const int r1 = r >> 6, ch = r & 63, dir = r1 >> 7, part = (r1 >> 6) & 1, p = r1 & 63, k0 = ch * 8, s = k0 >> 4, n0 = k0 & 15, ep = dir == 0 ? 31 - s : s, ldg = (l * 2 + dir) * 32 + g;
            const f32x2 w = pw[((size_t)ldg * 33 + ep) * 64 + p]; const f32x2* bp = bbar + ((size_t)ldg * 64 + p) * 16 + n0;
#pragma unroll
            for (int e = 0; e < 8; ++e) { const f32x2 b2 = bp[e]; v[e] = part == 0 ? (w[0] * b2[0] - w[1] * b2[1]) : (w[0] * b2[1] + w[1] * b2[0]); }
            v4u o; o.x = pk2(v[0], v[1]); o.y = pk2(v[2], v[3]); o.z = pk2(v[4], v[5]); o.w = pk2(v[6], v[7]);
            *(v4u*)(W1 + ((size_t)lg * 256 + r1) * 512 + k0) = o;
        }
    }
}

struct Thin {
    int init, fin;
    const float* x_lat; const float* x_ctx; const bf16* X; bf16* Xout; const bf16* Y; bf16* H; float* OUT;
    const float* gpost; const float* modg; int gc;
    const float* gpre; const float* mods; int sc;
    const float* YP; int ctx_mode;
};
__device__ __forceinline__ void thin_rows(const Thin& T, int wave, int lane) {
    const int G = gridDim.x;
    for (int r = (int)blockIdx.x * NWAVES + wave; r < M; r += G * NWAVES) {
        const int b = r / TPB, p = r - b * TPB, j = (p < CTXL) ? 8 : b;
        if ((T.fin || T.ctx_mode == 0) && p < CTXL) continue;
        float x[32];
        if (T.init) {
            const float* xsrc = (p < CTXL) ? T.x_ctx + ((size_t)b * CTXL + p) * DM : T.x_lat + ((size_t)b * SEQ + (p - CTXL)) * DM;
#pragma unroll
            for (int c = 0; c < 4; ++c) { const f32x4 a = *(const f32x4*)(xsrc + c * 512 + lane * 8), d = *(const f32x4*)(xsrc + c * 512 + lane * 8 + 4);
                x[c * 8 + 0] = a[0]; x[c * 8 + 1] = a[1]; x[c * 8 + 2] = a[2]; x[c * 8 + 3] = a[3]; x[c * 8 + 4] = d[0]; x[c * 8 + 5] = d[1]; x[c * 8 + 6] = d[2]; x[c * 8 + 7] = d[3]; }
        } else {
#pragma unroll
            for (int c = 0; c < 4; ++c) { const v4u w = *(const v4u*)(T.X + (size_t)r * DM + c * 512 + lane * 8);
                x[c * 8 + 0] = blo(w.x); x[c * 8 + 1] = bhi(w.x); x[c * 8 + 2] = blo(w.y); x[c * 8 + 3] = bhi(w.y); x[c * 8 + 4] = blo(w.z); x[c * 8 + 5] = bhi(w.z); x[c * 8 + 6] = blo(w.w); x[c * 8 + 7] = bhi(w.w); }
        }
        if (!T.init) {
            float y[32]; float ss = 0.f;
            if (p < CTXL && T.ctx_mode == 2) {
#pragma unroll
                for (int e = 0; e < 32; ++e) y[e] = 0.f;
#pragma unroll
                for (int q = 0; q < 4; ++q) { const float* yp = T.YP + ((size_t)q * 2048 + b * CTXL + p) * DM;
#pragma unroll
                    for (int c = 0; c < 4; ++c) { const f32x4 a = *(const f32x4*)(yp + c * 512 + lane * 8), d = *(const f32x4*)(yp + c * 512 + lane * 8 + 4);
                        y[c * 8 + 0] += a[0]; y[c * 8 + 1] += a[1]; y[c * 8 + 2] += a[2]; y[c * 8 + 3] += a[3]; y[c * 8 + 4] += d[0]; y[c * 8 + 5] += d[1]; y[c * 8 + 6] += d[2]; y[c * 8 + 7] += d[3]; } }
            } else {
#pragma unroll
            for (int c = 0; c < 4; ++c) { const v4u w = *(const v4u*)(T.Y + (size_t)r * DM + c * 512 + lane * 8);
                y[c * 8 + 0] = blo(w.x); y[c * 8 + 1] = bhi(w.x); y[c * 8 + 2] = blo(w.y); y[c * 8 + 3] = bhi(w.y); y[c * 8 + 4] = blo(w.z); y[c * 8 + 5] = bhi(w.z); y[c * 8 + 6] = blo(w.w); y[c * 8 + 7] = bhi(w.w); }
            }
#pragma unroll
            for (int e = 0; e < 32; ++e) ss += y[e] * y[e];
            ss = wave_sum(ss);
            const float r1 = 1.0f / sqrtf(ss * (1.0f / DM) + RMS_EPS);
            const float* gate = T.modg + (size_t)(j * 6 + T.gc) * DM;
#pragma unroll
            for (int c = 0; c < 4; ++c)
#pragma unroll
                for (int h = 0; h < 2; ++h) { const int col = c * 512 + lane * 8 + h * 4; const f32x4 gv = *(const f32x4*)(gate + col), pv = *(const f32x4*)(T.gpost + col);
#pragma unroll
                    for (int e = 0; e < 4; ++e) x[c * 8 + h * 4 + e] += gv[e] * (y[c * 8 + h * 4 + e] * r1 * pv[e]); }
        }
        if (T.fin) {
            float* o = T.OUT + ((size_t)b * SEQ + (p - CTXL)) * DM;
#pragma unroll
            for (int c = 0; c < 4; ++c) { *(f32x4*)(o + c * 512 + lane * 8) = (f32x4){x[c * 8 + 0], x[c * 8 + 1], x[c * 8 + 2], x[c * 8 + 3]}; *(f32x4*)(o + c * 512 + lane * 8 + 4) = (f32x4){x[c * 8 + 4], x[c * 8 + 5], x[c * 8 + 6], x[c * 8 + 7]}; }
            continue;
        }
        bf16* xo = T.Xout + (size_t)r * DM; float ss2 = 0.f;
#pragma unroll
        for (int c = 0; c < 4; ++c) { v4u w; w.x = pk2(x[c * 8 + 0], x[c * 8 + 1]); w.y = pk2(x[c * 8 + 2], x[c * 8 + 3]); w.z = pk2(x[c * 8 + 4], x[c * 8 + 5]); w.w = pk2(x[c * 8 + 6], x[c * 8 + 7]); *(v4u*)(xo + c * 512 + lane * 8) = w; }
#pragma unroll
        for (int e = 0; e < 32; ++e) ss2 += x[e] * x[e];
        ss2 = wave_sum(ss2);
        const float r2 = 1.0f / sqrtf(ss2 * (1.0f / DM) + RMS_EPS);
        const float* shift = T.mods + (size_t)(j * 6 + T.sc) * DM; const float* scale = shift + DM;
#pragma unroll
        for (int c = 0; c < 4; ++c) { float hv[8];
#pragma unroll
            for (int h = 0; h < 2; ++h) { const int col = c * 512 + lane * 8 + h * 4; const f32x4 gv = *(const f32x4*)(T.gpre + col), sv = *(const f32x4*)(scale + col), tv = *(const f32x4*)(shift + col);
#pragma unroll
                for (int e = 0; e < 4; ++e) hv[h * 4 + e] = (x[c * 8 + h * 4 + e] * r2 * gv[e]) * (1.0f + sv[e]) + tv[e]; }
            v4u w; w.x = pk2(hv[0], hv[1]); w.y = pk2(hv[2], hv[3]); w.z = pk2(hv[4], hv[5]); w.w = pk2(hv[6], hv[7]);
            *(v4u*)(T.H + (size_t)r * DM + c * 512 + lane * 8) = w; }
    }
}
__device__ __forceinline__ void unpack8(const v4u w, float* f) { f[0] = blo(w.x); f[1] = bhi(w.x); f[2] = blo(w.y); f[3] = bhi(w.y); f[4] = blo(w.z); f[5] = bhi(w.z); f[6] = blo(w.w); f[7] = bhi(w.w); }
__device__ __forceinline__ void prep_row(KP P, int l, int r, int lane) {
    bf16* Z = (bf16*)(P->ws + WS_Z); bf16* MIX = (bf16*)(P->ws + WS_MIX); const float* rope = (const float*)(P->ws + WS_ROPE);
    const int b = r / TPB, p = r - b * TPB; const bool lat = p >= CTXL;
    const int seg_lo = lat ? CTXL : 0, seg_hi = lat ? TPB : CTXL;
    bf16* zr = Z + (size_t)r * ZW;
    {
        const int ch = lane * 8; float v[8], gb[8], gc[8], up[8], un[8], uc[8];
        unpack8(*(const v4u*)(zr + Z_CV + ch), v); unpack8(*(const v4u*)(zr + Z_CB + ch), gb); unpack8(*(const v4u*)(zr + Z_CC + ch), gc);
#pragma unroll
        for (int e = 0; e < 8; ++e) uc[e] = gc[e] * v[e];
        if (p > seg_lo) { float a[8], c[8]; unpack8(*(const v4u*)(zr - ZW + Z_CV + ch), a); unpack8(*(const v4u*)(zr - ZW + Z_CC + ch), c);
#pragma unroll
            for (int e = 0; e < 8; ++e) up[e] = a[e] * c[e]; }
        else {
#pragma unroll
            for (int e = 0; e < 8; ++e) up[e] = 0.f; }
        if (p + 1 < seg_hi) { float a[8], c[8]; unpack8(*(const v4u*)(zr + ZW + Z_CV + ch), a); unpack8(*(const v4u*)(zr + ZW + Z_CC + ch), c);
#pragma unroll
            for (int e = 0; e < 8; ++e) un[e] = a[e] * c[e]; }
        else {
#pragma unroll
            for (int e = 0; e < 8; ++e) un[e] = 0.f; }
        const float* cw = P->in[I_CONVW] + (size_t)l * 3 * CONVW + ch; float o[8];
#pragma unroll
        for (int h = 0; h < 2; ++h) { const f32x4 w0 = *(const f32x4*)(cw + h * 4), w1 = *(const f32x4*)(cw + CONVW + h * 4), w2 = *(const f32x4*)(cw + 2 * CONVW + h * 4);
#pragma unroll
            for (int e = 0; e < 4; ++e) { const int k = h * 4 + e; o[k] = gb[k] * (w0[e] * up[k] + w1[e] * uc[k] + w2[e] * un[k]); } }
        v4u w; w.x = pk2(o[0], o[1]); w.y = pk2(o[2], o[3]); w.z = pk2(o[4], o[5]); w.w = pk2(o[6], o[7]);
        *(v4u*)(MIX + (size_t)r * DM + MIX_CONV + ch) = w;
    }
    const int t = p - CTXL, rowc = t >> 6, colc = t & 63;
    {
        const int j = lane & 7; float q[16]; bf16* qp = zr + Z_Q + lane * 16;
        unpack8(*(const v4u*)qp, q); unpack8(*(const v4u*)(qp + 8), q + 8);
        float ss = 0.f;
#pragma unroll
        for (int e = 0; e < 16; ++e) ss += q[e] * q[e];
        ss += __shfl_xor(ss, 1); ss += __shfl_xor(ss, 2); ss += __shfl_xor(ss, 4);
        const float rr = 1.0f / sqrtf(ss * (1.0f / 128.0f) + RMS_EPS);
        const float* qg = P->in[I_QNORM] + l * 128 + j * 16;
#pragma unroll
        for (int e = 0; e < 16; ++e) q[e] = q[e] * rr * qg[e];
        if (lat) {
            const int coord = (j < 4) ? rowc : colc; const float* cs = rope + coord * 32 + (j & 1) * 16; const float* sn = cs + 2048;
#pragma unroll
            for (int e = 0; e < 16; ++e) { const float other = __shfl_xor(q[e], 2); const float c = cs[e], s = sn[e];
                q[e] = ((j & 2) == 0) ? (q[e] * c - other * s) : (other * s + q[e] * c); }
        }
        v4u w0, w1; w0.x = pk2(q[0], q[1]); w0.y = pk2(q[2], q[3]); w0.z = pk2(q[4], q[5]); w0.w = pk2(q[6], q[7]);
        w1.x = pk2(q[8], q[9]); w1.y = pk2(q[10], q[11]); w1.z = pk2(q[12], q[13]); w1.w = pk2(q[14], q[15]);
        *(v4u*)qp = w0; *(v4u*)(qp + 8) = w1;
    }
    {
        const int sub = lane & 31; float k[4]; bf16* kp = zr + Z_K + lane * 4;
        const v2u kw = *(const v2u*)kp; k[0] = blo(kw.x); k[1] = bhi(kw.x); k[2] = blo(kw.y); k[3] = bhi(kw.y);
        float ss = k[0] * k[0] + k[1] * k[1] + k[2] * k[2] + k[3] * k[3];
        ss += __shfl_xor(ss, 1); ss += __shfl_xor(ss, 2); ss += __shfl_xor(ss, 4); ss += __shfl_xor(ss, 8); ss += __shfl_xor(ss, 16);
        const float rr = 1.0f / sqrtf(ss * (1.0f / 128.0f) + RMS_EPS);
        const float* kg = P->in[I_KNORM] + l * 128 + sub * 4;
#pragma unroll
        for (int e = 0; e < 4; ++e) k[e] = k[e] * rr * kg[e];
        if (lat) {
            const int coord = (sub < 16) ? rowc : colc; const float* cs = rope + coord * 32 + (sub & 7) * 4; const float* sn = cs + 2048;
#pragma unroll
            for (int e = 0; e < 4; ++e) { const float other = __shfl_xor(k[e], 8); const float c = cs[e], s = sn[e];
                k[e] = ((sub & 8) == 0) ? (k[e] * c - other * s) : (other * s + k[e] * c); }
        }
        v2u w; w.x = pk2(k[0], k[1]); w.y = pk2(k[2], k[3]); *(v2u*)kp = w;
    }
}

__device__ __forceinline__ void s5_carry_phase(KP P, int l, int wave, int lane) {
    const int G = gridDim.x;
    bf16* UH = (bf16*)(P->ws + WS_UH); const float* SB = (const float*)(P->ws + WS_SB);
    for (int it = wave * G + (int)blockIdx.x; it < 32 * NB * 2; it += NWAVES * G) {
        const int dir = it & 1, b = (it >> 1) & 7, g = it >> 4;
        const f32x2 l32 = ((const f32x2*)(P->ws + WS_POW))[((size_t)((l * 2 + dir) * 32 + g) * 33 + 32) * 64 + lane];
        float hre = 0.f, him = 0.f;
#pragma unroll 8
        for (int k = 0; k < SSM_CPB; ++k) {
            const int c = dir == 0 ? k : (k < 8 ? 7 - k : 143 - k);
            const size_t rowi = (size_t)g * SSM_RPG + ssm_rg(b, c);
            bf16* up = UH + rowi * UH_LD + 512 + dir * 128 + lane;
            up[0] = (bf16)f2bf(hre); up[64] = (bf16)f2bf(him);
            const float* sp = SB + rowi * 256 + dir * 128 + lane;
            const float sre = sp[0], sim = sp[64];
            const float nre = l32[0] * hre - l32[1] * him + sre, nim = l32[0] * him + l32[1] * hre + sim;
            hre = nre; him = nim;
        }
    }
}

__device__ __forceinline__ void attention_phase(KP P, int l, unsigned char* lds_generic, int wave_s) {
    const bf16* Z = (const bf16*)(P->ws + WS_Z); bf16* MIX = (bf16*)(P->ws + WS_MIX);
    const int G = gridDim.x;
    for (int i = 0; ; ++i) {
        int b, h, qb;
        if (G == 256) { if (i >= 4) break; const int xcd = blockIdx.x & 7, slot = blockIdx.x >> 3; const int pair = 2 * xcd + (i >> 1), uip = (i & 1) * 32 + slot; b = pair >> 1; h = (pair & 1) * 4 + (uip >> 4); qb = uip & 15; }
        else { const int u = i * G + blockIdx.x; if (u >= 1024) break; b = u >> 7; h = (u >> 4) & 7; qb = u & 15; }
        const int kvh = h >> 2; const size_t row0 = (size_t)b * TPB;
        attn::attn_unit(Z + (row0 + CTXL + qb * 256) * ZW + Z_Q + h * 128, Z + row0 * ZW + Z_K + kvh * 128, Z + row0 * ZW + Z_V + kvh * 128,
                        MIX + (row0 + CTXL + qb * 256) * DM + MIX_ATT + h * 128, TPB, (char*)lds_generic, wave_s);
    }
    if (l < DEPTH - 1) {
        for (int u = blockIdx.x; u < NB * 8; u += G) { const int b = u >> 3, h = u & 7, kvh = h >> 2; const size_t row0 = (size_t)b * TPB;
            attn::attn_unit(Z + row0 * ZW + Z_Q + h * 128, Z + row0 * ZW + Z_K + kvh * 128, Z + row0 * ZW + Z_V + kvh * 128, MIX + row0 * DM + MIX_ATT + h * 128, CTXL, (char*)lds_generic, wave_s); }
    }
}
constexpr int PH_PRO = 3, PH_PER_LAYER = 10, PH_TOTAL = PH_PRO + DEPTH * PH_PER_LAYER;
__global__ void __launch_bounds__(NWAVES * 64, 2) trunk_fwd(Params Pval) {
    extern __shared__ __attribute__((aligned(16))) unsigned char lds_raw[];
    LAS unsigned char* lds = (LAS unsigned char*)lds_raw;
    const int wave = __builtin_amdgcn_readfirstlane((int)threadIdx.x >> 6);

    const int G = gridDim.x;
    for (int u = wave * 64 + lane_id(); u < (LDS_BYTES - LDSCTL_OFF) / 4; u += NWAVES * 64) ((LAS unsigned*)(lds + LDSCTL_OFF))[u] = 0u;
    __syncthreads();
    (void)Pval;
    KP P = kparams();
    const int lo = P->ph_lo, hi = P->ph_hi;
    unsigned char* ws = P->ws;
    XcdBarrier bar; bar.bar = (unsigned*)(ws + WS_CTL) + CW_BAR; bar.x = 0; bar.st = nullptr;
    if (hi - lo > 1) bar = xcd_barrier_post((unsigned*)(ws + WS_CTL) + CW_BAR, (volatile LAS unsigned*)(lds + MISC_OFF) + 8, wave == 0 && lane_id() == 0);
#define IN(k) (lo <= (k) && (k) < hi)
#define SEAM(k) do { if (IN((k) + 1)) { const bool ldr_ = (wave == 0) && (lane_id() == 0); xcd_barrier(bar, ldr_); if (NREP(17) > 1) xcd_barrier(bar, ldr_); } } while (0)

    if (IN(0)) { for (int rep = 0; rep < NREP(0); ++rep) prologue_a(P, lds, wave, lane_id()); SEAM(0); }
    if (IN(1)) { for (int rep = 0; rep < NREP(0); ++rep) { prologue_b(P, wave * 64 + lane_id()); prologue_kt(P, wave * 64 + lane_id()); } SEAM(1); }
    if (IN(2)) {
        for (int rep = 0; rep < NREP(0); ++rep) prologue_s5w(P, wave * 64 + lane_id());
        Thin T{}; T.init = 1; T.fin = 0; T.x_lat = P->in[I_X]; T.x_ctx = P->in[I_CTX]; T.X = (const bf16*)(ws + WS_X); T.Xout = (bf16*)(ws + WS_X); T.Y = nullptr; T.H = (bf16*)(ws + WS_H); T.OUT = nullptr;
        T.gpost = nullptr; T.modg = nullptr; T.gc = 0; T.gpre = P->in[I_GPREMIX]; T.mods = (const float*)(ws + WS_MOD); T.sc = 0; T.YP = nullptr; T.ctx_mode = 1;
        for (int rep = 0; rep < NREP(0); ++rep) thin_rows(T, wave, lane_id()); SEAM(2);
    }
    for (int l = 0; l < DEPTH; ++l) {
        const int pb = PH_PRO + l * PH_PER_LAYER;
        if (pb + PH_PER_LAYER <= lo || pb >= hi) continue;
        P = kparams(); ws = P->ws;
        const unsigned char* wl = ws + WS_W + (size_t)l * W_LAYER;
        const float* modl = (const float*)(ws + WS_MOD) + (size_t)l * 9 * NMOD;
        const bool lastl = (l == DEPTH - 1);
        float* YPp = (float*)(ws + WS_YP);
        if (IN(pb + 0)) {
            pg8::Gemm g{(const bf16*)(ws + WS_H), (const bf16*)(wl + W_IN), M, ZW, DM}; pg8::RowOrder S{ZW / 256, G, (int)blockIdx.x, 1, 0};
            pg8::EpiInProj E{(bf16*)(ws + WS_Z), (bf16*)(ws + WS_UH)};
            for (int rep = 0; rep < NREP(3); ++rep) pg8::gemm_phase<pg8::EpiInProj, pg8::RowOrder, true, true>(lds + RING_OFF, g, S, E, wave);
            SEAM(pb + 0);
        }
        if (IN(pb + 1)) {
            for (int r = (int)blockIdx.x * NWAVES + wave; r < M; r += NWAVES * G) prep_row(P, l, r, lane_id());
            pg8::Gemm g{(const bf16*)(ws + WS_UH), (const bf16*)(ws + WS_W1) + (size_t)l * 32 * 256 * 512, 0, 0, 512, UH_LD, 512}; pg8::S5Order1 S{G, (int)blockIdx.x};
            pg8::EpiS5State E{(float*)(ws + WS_SB)};
            for (int rep = 0; rep < NREP(13); ++rep) pg8::gemm_phase<pg8::EpiS5State, pg8::S5Order1, true, true>(lds + RING_OFF, g, S, E, wave);
            SEAM(pb + 1);
        }
        if (IN(pb + 2)) { for (int rep = 0; rep < NREP(14); ++rep) s5_carry_phase(P, l, wave, lane_id()); SEAM(pb + 2); }
        if (IN(pb + 3)) {
            { pg8::Gemm g{(const bf16*)(ws + WS_UH), (const bf16*)(ws + WS_TW) + (size_t)l * 32 * 512 * 768, 0, 0, 768, UH_LD, 768}; pg8::S5Order2 S{G, (int)blockIdx.x, l < DEPTH - 1 ? 5 : 4};
              pg8::EpiS5Out E{(bf16*)(ws + WS_G)};
              for (int rep = 0; rep < NREP(15); ++rep) pg8::gemm_phase<pg8::EpiS5Out, pg8::S5Order2, true, true>(lds + RING_OFF, g, S, E, wave); }
            __syncthreads();
            for (int rep = 0; rep < NREP(12); ++rep) attention_phase(P, l, lds_raw, wave);
            SEAM(pb + 3);
        }
        if (IN(pb + 4)) {
            pg8::Gemm g{(const bf16*)(ws + WS_G), (const bf16*)(wl + W_GLU), M, SSMW, SSMW}; pg8::RowOrder S{SSMW / 256, G, (int)blockIdx.x, lastl ? 0 : 1, 0};
            pg8::EpiGlu E{(const bf16*)(ws + WS_G), SSMW, (bf16*)(ws + WS_MIX) + MIX_SSM, DM, P->in[I_BGLU] + l * SSMW};
            for (int rep = 0; rep < NREP(11); ++rep) pg8::gemm_phase<pg8::EpiGlu, pg8::RowOrder, true, true>(lds + RING_OFF, g, S, E, wave);
            SEAM(pb + 4);
        }
        if (IN(pb + 5)) {
            pg8::Gemm g{(const bf16*)(ws + WS_MIX), (const bf16*)(wl + W_OUT), M, DM, DM}; pg8::RowOrder S{DM / 256, G, (int)blockIdx.x, lastl ? 0 : 2, DM / 256};
            pg8::EpiBf16 E{(bf16*)(ws + WS_Y), DM, YPp, DM / 64};
            for (int rep = 0; rep < NREP(6); ++rep) pg8::gemm_phase<pg8::EpiBf16, pg8::RowOrder, true, true>(lds + RING_OFF, g, S, E, wave);
            SEAM(pb + 5);
        }
        if (IN(pb + 6)) {
            Thin T{}; T.init = 0; T.fin = 0; T.x_lat = nullptr; T.x_ctx = nullptr; T.X = (const bf16*)(ws + WS_X); T.Xout = (bf16*)(ws + WS_X); T.Y = (const bf16*)(ws + WS_Y); T.H = (bf16*)(ws + WS_H); T.OUT = nullptr;
            T.gpost = P->in[I_GPOSTMIX] + l * DM; T.modg = modl; T.gc = 2; T.gpre = P->in[I_GPREFFN] + l * DM; T.mods = modl; T.sc = 3; T.YP = YPp; T.ctx_mode = lastl ? 0 : 2;
            if (NREP(7) > 1) { Thin T2 = T; T2.Xout = (bf16*)(ws + WS_Z); thin_rows(T2, wave, lane_id()); }
            thin_rows(T, wave, lane_id()); SEAM(pb + 6);
        }
        if (IN(pb + 7)) {
            pg8::Gemm g{(const bf16*)(ws + WS_H), (const bf16*)(wl + W_GU), M, 2 * FF, DM}; pg8::RowOrder S{2 * FF / 256, G, (int)blockIdx.x, lastl ? 0 : 1, 0};
            pg8::EpiSwiGlu E{(bf16*)(ws + WS_ACT), FF};
            for (int rep = 0; rep < NREP(8); ++rep) pg8::gemm_phase<pg8::EpiSwiGlu, pg8::RowOrder, true, true>(lds + RING_OFF, g, S, E, wave);
            SEAM(pb + 7);
        }
        if (IN(pb + 8)) {
            pg8::Gemm g{(const bf16*)(ws + WS_ACT), (const bf16*)(wl + W_DOWN), M, DM, FF}; pg8::RowOrder S{DM / 256, G, (int)blockIdx.x, lastl ? 0 : 2, FF / 256};
            pg8::EpiBf16 E{(bf16*)(ws + WS_Y), DM, YPp, FF / 64};
            for (int rep = 0; rep < NREP(9); ++rep) pg8::gemm_phase<pg8::EpiBf16, pg8::RowOrder, true, true>(lds + RING_OFF, g, S, E, wave);
            SEAM(pb + 8);
        }
        if (IN(pb + 9)) {
            const bool last = (l == DEPTH - 1); const int l2 = last ? l : l + 1;
            Thin T{}; T.init = 0; T.fin = last ? 1 : 0; T.x_lat = nullptr; T.x_ctx = nullptr; T.X = (const bf16*)(ws + WS_X); T.Xout = (bf16*)(ws + WS_X); T.Y = (const bf16*)(ws + WS_Y); T.H = (bf16*)(ws + WS_H); T.OUT = P->out;
            T.gpost = P->in[I_GPOSTFFN] + l * DM; T.modg = modl; T.gc = 5; T.gpre = P->in[I_GPREMIX] + l2 * DM; T.mods = (const float*)(ws + WS_MOD) + (size_t)l2 * 9 * NMOD; T.sc = 0; T.YP = YPp; T.ctx_mode = lastl ? 0 : 2;
            if (NREP(7) > 1) { Thin T2 = T; T2.Xout = (bf16*)(ws + WS_Z); thin_rows(T2, wave, lane_id()); }
            thin_rows(T, wave, lane_id()); SEAM(pb + 9);
        }
    }
#undef IN
#undef SEAM
}

extern "C" void kernel_launch(void* const* d_in, const int* in_sizes, int n_in, void* d_out, int out_size, void* d_ws, size_t ws_size, hipStream_t stream) {
    static int grid = 0;
    if (grid == 0) {
        if (n_in != 28 || in_sizes[0] != NB * SEQ * DM || out_size != NB * SEQ * DM || ws_size < WS_END) {
            fprintf(stderr, "kernel_launch: built for 28 inputs, x/out of %d floats, >= %zu bytes of workspace; got n_in %d, in0 %d, out %d, ws %zu; nothing launched\n", NB * SEQ * DM, (size_t)WS_END, n_in, n_in > 0 ? in_sizes[0] : -1, out_size, ws_size);
            grid = -1; return; }
        int dev = 0, cus = 0;
        if (hipGetDevice(&dev) != hipSuccess || hipDeviceGetAttribute(&cus, hipDeviceAttributeMultiprocessorCount, dev) != hipSuccess) { fprintf(stderr, "kernel_launch: device query failed\n"); grid = -1; return; }
        if (hipFuncSetAttribute((const void*)trunk_fwd, hipFuncAttributeMaxDynamicSharedMemorySize, LDS_BYTES) != hipSuccess) { fprintf(stderr, "kernel_launch: hipFuncSetAttribute failed\n"); grid = -1; return; }
        int per_cu = 0;
        if (hipOccupancyMaxActiveBlocksPerMultiprocessor(&per_cu, (const void*)trunk_fwd, NWAVES * 64, LDS_BYTES) != hipSuccess || per_cu < 1)
            fprintf(stderr, "kernel_launch: note: occupancy query reports %d workgroups per CU\n", per_cu);
        (void)hipGetLastError();
        grid = cus;
    }
    if (grid < 0) return;
    if (hipMemsetAsync((char*)d_ws + WS_CTL, 0, CTL_ZERO_BYTES, stream) != hipSuccess) { fprintf(stderr, "kernel_launch: memset failed\n"); return; }
    Params p{};
    for (int i = 0; i < 28; ++i) p.in[i] = (const float*)d_in[i];
    p.out = (float*)d_out; p.ws = (unsigned char*)d_ws;
#if MK_ONE_LAUNCH
    p.ph_lo = 0; p.ph_hi = PH_TOTAL;
    hipLaunchKernelGGL(trunk_fwd, dim3(grid), dim3(NWAVES * 64), LDS_BYTES, stream, p);
#else
    for (int k = 0; k < PH_TOTAL; ++k) { p.ph_lo = k; p.ph_hi = k + 1; hipLaunchKernelGGL(trunk_fwd, dim3(grid), dim3(NWAVES * 64), LDS_BYTES, stream, p); }
#endif
    const hipError_t le = hipPeekAtLastError();
    if (le != hipSuccess) fprintf(stderr, "kernel_launch: launch failed: %s\n", hipGetErrorName(le));
}
```

```cpp
#include <hip/hip_runtime.h>
#include <cstdio>
#include <cstdint>
#include <cmath>

#ifndef MK_ONE_LAUNCH
#define MK_ONE_LAUNCH 1
#endif

constexpr int SSM_L = 32, SSM_CPB = 136, SSM_RPG = 1280, UH_LD = 768;
__host__ __device__ __forceinline__ int ssm_rg(int b, int c) { return c >= 8 ? b * 128 + (c - 8) : 1024 + b * 8 + c; }

#ifndef REP_MASK
#define REP_MASK 0
#endif
#define NREP(b) (1 + ((REP_MASK >> (b)) & 1))
__device__ __forceinline__ int lane_id() { int l; asm volatile("v_mbcnt_lo_u32_b32 %0, -1, 0\n\tv_mbcnt_hi_u32_b32 %0, -1, %0" : "=v"(l)); return l; }
namespace pg8 {
#define PG8_LAS __attribute__((address_space(3)))
typedef unsigned short bf16_t;
typedef short bf16x8 __attribute__((ext_vector_type(8)));
typedef float f32x4 __attribute__((ext_vector_type(4)));
typedef unsigned u32x4 __attribute__((ext_vector_type(4)));
constexpr int BM = 256, BK = 64, HALF = 128, HTB = HALF * BK * 2  , STAGE_BYTES = 8 * HTB, NXCD = 8, WGM = 8;

__host__ __device__ __forceinline__ int lds_byte(int r, int c) { const int st = (r >> 4) * 2 + (c >> 5), rr = r & 15, cc = c & 31, ob = rr * 64 + cc * 2; return st * 1024 + (ob ^ (((ob >> 9) & 1) << 5)); }
__host__ __device__ __forceinline__ void stage_rc(int b, int& R, int& C) { const int st = b / 1024, sb = b % 1024, swz = sb ^ (((sb >> 9) & 1) << 5); R = (st >> 1) * 16 + swz / 64; C = (st & 1) * 32 + (swz % 64) / 2; }
__host__ __device__ __forceinline__ int perm32(int rho) { const int n = rho >> 4, i = rho & 15; return 8 * (i >> 2) + 4 * n + (i & 3); }

struct Unit { int pm, pn, ko, nt; };
struct Gemm { const bf16_t* A; const bf16_t* Bt; int M, N, K, lda, ldb; };

struct StaticOrder {
    int nM, nN, nwg, G, c;
    __host__ __device__ void init(int M, int N, int G_, int c_) { nM = M / BM; nN = N / BM; nwg = nM * nN; G = G_; c = c_; }
    __host__ __device__ bool next(int i, Unit& u) const {
        const long L = (long)i * G + c; if (L >= nwg) return false;
        int wgid = (int)L; { const int q = nwg / NXCD, r = nwg % NXCD, xcd = wgid % NXCD, off = wgid / NXCD; wgid = (xcd < r ? xcd * (q + 1) : r * (q + 1) + (xcd - r) * q) + off; }
        const int nig = WGM * nN, gid = wgid / nig, fm = gid * WGM, gsz = (nM - fm) < WGM ? (nM - fm) : WGM;
        u.pm = fm + ((wgid % nig) % gsz); u.pn = (wgid % nig) / gsz; return true;
    }
    __device__ __forceinline__ void a_ready(const Unit&) const {}
    __device__ __forceinline__ void done(const Unit&) const {}
};

__device__ __forceinline__ unsigned cvt_pk_bf16(float lo, float hi) { unsigned r; asm volatile("v_cvt_pk_bf16_f32 %0, %1, %2" : "=v"(r) : "v"(lo), "v"(hi)); return r; }
typedef float f32x2 __attribute__((ext_vector_type(2)));
struct EpiBf16 {
    static constexpr bool PERM = true, AFTER_DRAIN = false; static constexpr int NST = 0;
    bf16_t* O; int ldc; float* YP; int nt_full;
    __device__ __forceinline__ void operator()(const f32x4 (&acc)[2][2][4][2], const Unit& u, int wr, int wc, int fr, int fq) const {
        const int col0 = u.pn * BM + wc * 32 + 8 * fq;
        if (u.nt != nt_full) {
            const int q = u.ko / (u.nt * BK), b = u.pm / 17; float* base = YP + ((size_t)q * 2048 + b * 256 + wr * 64 + fr) * ldc + col0;
#pragma unroll
            for (int ai = 0; ai < 2; ++ai)
#pragma unroll
                for (int m = 0; m < 4; ++m) { float* rowp = base + (size_t)(ai * HALF + m * 16) * ldc;
#pragma unroll
                    for (int bj = 0; bj < 2; ++bj) { *(f32x4*)(rowp + bj * HALF) = acc[ai][bj][m][0]; *(f32x4*)(rowp + bj * HALF + 4) = acc[ai][bj][m][1]; } }
            return;
        }
        const int row0 = u.pm * BM + wr * 64 + fr;
#pragma unroll
        for (int ai = 0; ai < 2; ++ai)
#pragma unroll
            for (int m = 0; m < 4; ++m) { bf16_t* rowp = O + (size_t)(row0 + ai * HALF + m * 16) * ldc + col0;
#pragma unroll
                for (int bj = 0; bj < 2; ++bj) { const f32x4 v0 = acc[ai][bj][m][0], v1 = acc[ai][bj][m][1];
                    u32x4 w; w.x = cvt_pk_bf16(v0[0], v0[1]); w.y = cvt_pk_bf16(v0[2], v0[3]); w.z = cvt_pk_bf16(v1[0], v1[1]); w.w = cvt_pk_bf16(v1[2], v1[3]);
                    *(u32x4*)(rowp + bj * HALF) = w; } }
    }
};
struct RowOrder {
    int nN, G, c, ctx, ntq;
    __device__ bool next(int i, Unit& u) const {
        const int nlat = 128 * nN, L = i * G + c;
        if (L < nlat) {
            const int q = nlat / NXCD, wgid = (L % NXCD) * q + L / NXCD;
            const int nig = WGM * nN, gid = wgid / nig, rem = wgid - gid * nig, pml = gid * WGM + (rem % WGM);
            u.pn = rem / WGM; u.pm = (pml >> 4) * 17 + 1 + (pml & 15); return true;
        }
        const int Lc = L - nlat;
        if (ctx == 1) { if (Lc >= 8 * nN) return false; u.pm = (Lc / nN) * 17; u.pn = Lc % nN; return true; }
        if (ctx == 2) { if (Lc >= 32 * nN) return false; const int t = Lc >> 2; u.pm = (t / nN) * 17; u.pn = t % nN; u.ko = (Lc & 3) * ntq * BK; u.nt = ntq; return true; }
        return false;
    }
    __device__ __forceinline__ void a_ready(const Unit&) const {}
    __device__ __forceinline__ void done(const Unit&) const {}
};
__device__ __forceinline__ float bflo(unsigned w) { return __uint_as_float(w << 16); }
__device__ __forceinline__ float bfhi(unsigned w) { return __uint_as_float(w & 0xffff0000u); }
__device__ __forceinline__ float sigmoidf_(float x) { return __builtin_amdgcn_rcpf(1.0f + __expf(-x)); }
struct EpiGlu {
    static constexpr bool PERM = true, AFTER_DRAIN = false; static constexpr int NST = 0;
    const bf16_t* G; int ldg; bf16_t* O; int ldo; const float* bias;
    __device__ __forceinline__ void operator()(const f32x4 (&acc)[2][2][4][2], const Unit& u, int wr, int wc, int fr, int fq) const {
        const int row0 = u.pm * BM + wr * 64 + fr; const int col0 = u.pn * BM + wc * 32 + 8 * fq;
        f32x4 bv[2][2];
#pragma unroll
        for (int bj = 0; bj < 2; ++bj)
#pragma unroll
            for (int n = 0; n < 2; ++n) bv[bj][n] = *(const f32x4*)(bias + col0 + bj * HALF + 4 * n);
#pragma unroll
        for (int ai = 0; ai < 2; ++ai) {
            u32x4 gv[4][2];
#pragma unroll
            for (int m = 0; m < 4; ++m)
#pragma unroll
                for (int bj = 0; bj < 2; ++bj) gv[m][bj] = *(const u32x4*)(G + (size_t)(row0 + ai * HALF + m * 16) * ldg + col0 + bj * HALF);
            asm volatile("" ::: "memory");
#pragma unroll
            for (int m = 0; m < 4; ++m) { const size_t row = (size_t)(row0 + ai * HALF + m * 16);
#pragma unroll
                for (int bj = 0; bj < 2; ++bj) { const f32x4 v0 = acc[ai][bj][m][0] + bv[bj][0], v1 = acc[ai][bj][m][1] + bv[bj][1];
                    const u32x4 g = gv[m][bj];
                    const float o0 = bflo(g.x) * sigmoidf_(v0[0]), o1 = bfhi(g.x) * sigmoidf_(v0[1]), o2 = bflo(g.y) * sigmoidf_(v0[2]), o3 = bfhi(g.y) * sigmoidf_(v0[3]);
                    const float o4 = bflo(g.z) * sigmoidf_(v1[0]), o5 = bfhi(g.z) * sigmoidf_(v1[1]), o6 = bflo(g.w) * sigmoidf_(v1[2]), o7 = bfhi(g.w) * sigmoidf_(v1[3]);
                    u32x4 w; w.x = cvt_pk_bf16(o0, o1); w.y = cvt_pk_bf16(o2, o3); w.z = cvt_pk_bf16(o4, o5); w.w = cvt_pk_bf16(o6, o7);
                    *(u32x4*)(O + row * ldo + col0 + bj * HALF) = w; } }
            asm volatile("" ::: "memory");
        }
    }
};
struct EpiSwiGlu {
    static constexpr bool PERM = true, AFTER_DRAIN = false; static constexpr int NST = 8;
    bf16_t* O; int ldo;
    __device__ __forceinline__ void operator()(const f32x4 (&acc)[2][2][4][2], const Unit& u, int wr, int wc, int fr, int fq) const {
        const int row0 = u.pm * BM + wr * 64 + fr; const int col0 = u.pn * HALF + wc * 32 + 8 * fq;
#pragma unroll
        for (int ai = 0; ai < 2; ++ai)
#pragma unroll
            for (int m = 0; m < 4; ++m) { const size_t row = (size_t)(row0 + ai * HALF + m * 16);
                float o[8];
#pragma unroll
                for (int n = 0; n < 2; ++n)
#pragma unroll
                    for (int j = 0; j < 4; ++j) { const float g = acc[ai][0][m][n][j], up = acc[ai][1][m][n][j]; o[n * 4 + j] = g * sigmoidf_(g) * up; }
                u32x4 w; w.x = cvt_pk_bf16(o[0], o[1]); w.y = cvt_pk_bf16(o[2], o[3]); w.z = cvt_pk_bf16(o[4], o[5]); w.w = cvt_pk_bf16(o[6], o[7]);
                *(u32x4*)(O + row * ldo + col0) = w; }
    }
};
struct EpiInProj {
    static constexpr bool PERM = true, AFTER_DRAIN = false; static constexpr int NST = 0;
    bf16_t* Z; bf16_t* UH;
    __device__ __forceinline__ void operator()(const f32x4 (&acc)[2][2][4][2], const Unit& u, int wr, int wc, int fr, int fq) const {
        const int row0 = u.pm * BM + wr * 64 + fr; const int col0 = u.pn * BM + wc * 32 + 8 * fq;
        const bool ssm = (u.pn == 6 || u.pn == 7);
#pragma unroll
        for (int ai = 0; ai < 2; ++ai)
#pragma unroll
            for (int m = 0; m < 4; ++m) { const int row = row0 + ai * HALF + m * 16;
                int b = 0, pos = 0; if (ssm) { b = row / 4352; pos = row - b * 4352; }
#pragma unroll
                for (int bj = 0; bj < 2; ++bj) { const f32x4 v0 = acc[ai][bj][m][0], v1 = acc[ai][bj][m][1];
                    u32x4 w; w.x = cvt_pk_bf16(v0[0], v0[1]); w.y = cvt_pk_bf16(v0[2], v0[3]); w.z = cvt_pk_bf16(v1[0], v1[1]); w.w = cvt_pk_bf16(v1[2], v1[3]);
                    const int col = col0 + bj * HALF;
                    if (ssm) { const int sc = col - 1536, g = sc >> 4, n0 = sc & 15; *(u32x4*)(UH + ((size_t)(g * SSM_RPG + ssm_rg(b, pos >> 5)) * UH_LD + (pos & 31) * 16 + n0)) = w; }
                    else *(u32x4*)(Z + (size_t)row * 3584 + col) = w; } }
    }
};
struct EpiS5State {
    static constexpr bool PERM = true, AFTER_DRAIN = false; static constexpr int NST = 0;
    float* S;
    __device__ __forceinline__ void operator()(const f32x4 (&acc)[2][2][4][2], const Unit& u, int wr, int wc, int fr, int fq) const {
        const int row0 = u.pm * BM + wr * 64 + fr; const int col0 = wc * 32 + 8 * fq;
#pragma unroll
        for (int ai = 0; ai < 2; ++ai)
#pragma unroll
            for (int m = 0; m < 4; ++m) { float* rowp = S + (size_t)(row0 + ai * HALF + m * 16) * 256 + col0;
#pragma unroll
                for (int bj = 0; bj < 2; ++bj) { *(f32x4*)(rowp + bj * HALF) = acc[ai][bj][m][0]; *(f32x4*)(rowp + bj * HALF + 4) = acc[ai][bj][m][1]; } }
    }
};
__device__ __forceinline__ float gelu_tanh_(float y) {
    const float z = 0.7978845608028654f * (y + 0.044715f * y * y * y);
    const float t = 1.0f - 2.0f * __builtin_amdgcn_rcpf(__expf(2.0f * z) + 1.0f);
    return 0.5f * y * (1.0f + t);
}
struct EpiS5Out {
    static constexpr bool PERM = true, AFTER_DRAIN = false; static constexpr int NST = 0;
    bf16_t* G;
    __device__ __forceinline__ void operator()(const f32x4 (&acc)[2][2][4][2], const Unit& u, int wr, int wc, int fr, int fq) const {
        const int g = u.pn >> 1, j = u.pn & 1, i = u.pm - 5 * g;
        const int rg0 = i * BM + wr * 64 + fr; const int col0 = j * BM + wc * 32 + 8 * fq;
#pragma unroll
        for (int ai = 0; ai < 2; ++ai)
#pragma unroll
            for (int m = 0; m < 4; ++m) { const int rg = rg0 + ai * HALF + m * 16;
                if (rg < 1088) {
                    int b, c; if (rg < 1024) { b = rg >> 7; c = 8 + (rg & 127); } else { b = (rg - 1024) >> 3; c = (rg - 1024) & 7; }
                    const size_t grow0 = (size_t)b * 4352 + c * 32;
#pragma unroll
                    for (int bj = 0; bj < 2; ++bj) { const f32x4 v0 = acc[ai][bj][m][0], v1 = acc[ai][bj][m][1];
                        const int col = col0 + bj * HALF, t = col >> 4, n0 = col & 15;
                        u32x4 w; w.x = cvt_pk_bf16(gelu_tanh_(v0[0]), gelu_tanh_(v0[1])); w.y = cvt_pk_bf16(gelu_tanh_(v0[2]), gelu_tanh_(v0[3]));
                        w.z = cvt_pk_bf16(gelu_tanh_(v1[0]), gelu_tanh_(v1[1])); w.w = cvt_pk_bf16(gelu_tanh_(v1[2]), gelu_tanh_(v1[3]));
                        *(u32x4*)(G + (grow0 + t) * 512 + g * 16 + n0) = w; } } }
    }
};
struct S5Order1 { int G, c;
    __device__ bool next(int i, Unit& u) const { const int L = i * G + c; if (L >= 160) return false; u.pm = L; u.pn = L / 5; return true; }
    __device__ __forceinline__ void a_ready(const Unit&) const {}
    __device__ __forceinline__ void done(const Unit&) const {} };
struct S5Order2 { int G, c, nt;
    __device__ bool next(int i, Unit& u) const { const int L = i * G + c; if (L >= 32 * nt * 2) return false; const int g = L / (2 * nt), r = L - g * 2 * nt; u.pm = g * 5 + (r >> 1); u.pn = g * 2 + (r & 1); return true; }
    __device__ __forceinline__ void a_ready(const Unit&) const {}
    __device__ __forceinline__ void done(const Unit&) const {} };
template <class Epi, class Sched, bool ALIGN_EPI = false, bool SP2 = false>
__device__ __forceinline__ void gemm_phase(PG8_LAS unsigned char* lds, const Gemm g, const Sched& S, const Epi& E, int wave_s) {
    int tid_ = wave_s * 64 + lane_id(); asm volatile("" : "+v"(tid_));
    const int tid = tid_, wid = __builtin_amdgcn_readfirstlane(tid >> 6), lane = tid & 63, wr = wid >> 2, wc = wid & 3, fr = lane & 15, fq = lane >> 4;
    const int K = g.K, lda = g.lda ? g.lda : K, ldb = g.ldb ? g.ldb : K;
    unsigned voffA[2], voffB[2];
#pragma unroll
    for (int i = 0; i < 2; ++i) { int R, C; stage_rc(tid * 16 + i * 8192, R, C); const int Rb = Epi::PERM ? ((R & ~31) + perm32(R & 31)) : R;
        voffA[i] = (unsigned)(R * lda + C) * 2u; voffB[i] = (unsigned)(Rb * ldb + C) * 2u; }
    const size_t kstep = (size_t)(BK * 2);
    const size_t hstepA = (size_t)HALF * lda * 2, hstepB = (size_t)HALF * ldb * 2;
    const size_t tstepA = 2 * hstepA, tstepB = 2 * hstepB;
    const unsigned ldsw = (unsigned)wid * 1024u;
    const int aoff = lds_byte(wr * 64 + fr, fq * 8), boff = lds_byte(wc * 32 + fr, fq * 8);
#define PG8_SA(b, h) (((b) * 2 + (h)) * HTB)
#define PG8_SB(b, h) ((4 + (b) * 2 + (h)) * HTB)
#define PG8_STAGE(bufoff, gbase, voff) do { _Pragma("unroll") for (int _i = 0; _i < 2; ++_i) \
        __builtin_amdgcn_global_load_lds((const unsigned*)((const char*)(gbase) + (voff)[_i]), (PG8_LAS unsigned*)(lds + (bufoff) + ldsw + _i * 8192), 16, 0, 0); } while (0)
#define PG8_LDA(dst, b, h) do { _Pragma("unroll") for (int m = 0; m < 4; ++m) _Pragma("unroll") for (int k = 0; k < 2; ++k) dst[m][k] = *(const PG8_LAS bf16x8*)(lds + PG8_SA(b, h) + aoff + m * 2048 + k * 1024); } while (0)
#define PG8_LDB(dst, b, h) do { _Pragma("unroll") for (int n = 0; n < 2; ++n) _Pragma("unroll") for (int k = 0; k < 2; ++k) dst[n][k] = *(const PG8_LAS bf16x8*)(lds + PG8_SB(b, h) + boff + n * 2048 + k * 1024); } while (0)
#define PG8_MMA(ai, bj, At, Bt) do { __builtin_amdgcn_s_setprio(1); _Pragma("unroll") for (int m = 0; m < 4; ++m) _Pragma("unroll") for (int n = 0; n < 2; ++n) _Pragma("unroll") for (int k = 0; k < 2; ++k) \
        acc[ai][bj][m][n] = __builtin_amdgcn_mfma_f32_16x16x32_bf16(Bt[n][k], At[m][k], acc[ai][bj][m][n], 0, 0, 0); __builtin_amdgcn_s_setprio(0); } while (0)
#define PG8_WAIT_V(n) asm volatile("s_waitcnt vmcnt(" #n ")" ::: "memory")
#define PG8_WAIT_L(n) asm volatile("s_waitcnt lgkmcnt(" #n ")" ::: "memory")
#define PG8_BAR __builtin_amdgcn_s_barrier()
#define PG8_SCHED __builtin_amdgcn_sched_barrier(0)
    Unit cur, nxt; int ui = 0;
    cur.ko = 0; cur.nt = K / BK; nxt.ko = 0; nxt.nt = K / BK;
    if (!S.next(0, cur)) return;
    f32x4 acc[2][2][4][2];
#pragma unroll
    for (int a = 0; a < 2; ++a)
#pragma unroll
        for (int b = 0; b < 2; ++b)
#pragma unroll
            for (int m = 0; m < 4; ++m)
#pragma unroll
                for (int n = 0; n < 2; ++n) acc[a][b][m][n] = (f32x4){0.f, 0.f, 0.f, 0.f};
    bf16x8 At[4][2], B0[2][2], B1[2][2];
    const char* cA = (const char*)g.A + (size_t)cur.pm * tstepA + (size_t)cur.ko * 2; const char* cB = (const char*)g.Bt + (size_t)cur.pn * tstepB + (size_t)cur.ko * 2;
    S.a_ready(cur);
    if constexpr (SP2) {
        PG8_STAGE(PG8_SB(0, 0), cB, voffB); PG8_STAGE(PG8_SB(0, 1), cB + hstepB, voffB); PG8_STAGE(PG8_SA(0, 0), cA, voffA); PG8_STAGE(PG8_SA(0, 1), cA + hstepA, voffA);
        if (wr == 1) PG8_BAR;
        PG8_WAIT_V(2); PG8_BAR;
        PG8_STAGE(PG8_SB(1, 0), cB + kstep, voffB); PG8_STAGE(PG8_SA(1, 0), cA + kstep, voffA); PG8_STAGE(PG8_SB(1, 1), cB + hstepB + kstep, voffB);
        PG8_WAIT_V(6); PG8_BAR;
    } else {
        PG8_STAGE(PG8_SB(0, 0), cB, voffB); PG8_STAGE(PG8_SA(0, 0), cA, voffA); PG8_STAGE(PG8_SB(0, 1), cB + hstepB, voffB); PG8_STAGE(PG8_SA(0, 1), cA + hstepA, voffA);
        if (wr == 1) PG8_BAR;
        PG8_WAIT_V(4); PG8_BAR;
        PG8_STAGE(PG8_SB(1, 0), cB + kstep, voffB); PG8_STAGE(PG8_SA(1, 0), cA + kstep, voffA); PG8_STAGE(PG8_SB(1, 1), cB + hstepB + kstep, voffB);
        PG8_WAIT_V(6); PG8_BAR;
    }
    for (;;) {
        nxt.ko = 0; nxt.nt = K / BK;
        const bool has_next = S.next(ui + 1, nxt);
        const int nt = cur.nt;
        const char* nA = has_next ? (const char*)g.A + (size_t)nxt.pm * tstepA + (size_t)nxt.ko * 2 : cA; const char* nB = has_next ? (const char*)g.Bt + (size_t)nxt.pn * tstepB + (size_t)nxt.ko * 2 : cB;
        static_assert(SP2, "this build keeps only the two-super-phase K-loop");
#define PG8_TRIP(WV12) { \
            const bool last = (t == nt - 2); \
            const char* a1 = cA + (size_t)(t + 1) * kstep; \
            const char* a2 = last ? nA : cA + (size_t)(t + 2) * kstep; const char* b2 = last ? nB : cB + (size_t)(t + 2) * kstep; \
            const char* a3 = a2 + kstep; const char* b3 = b2 + kstep; \
            if (last && has_next) S.a_ready(nxt); \
              \
            PG8_LDB(B0, 0, 0); PG8_LDB(B1, 0, 1); PG8_SCHED; PG8_LDA(At, 0, 0); PG8_STAGE(PG8_SA(1, 1), a1 + hstepA, voffA); \
            WV12; PG8_WAIT_L(0); PG8_BAR; PG8_MMA(0, 0, At, B0); PG8_MMA(0, 1, At, B1); PG8_BAR; PG8_SCHED; \
              \
            PG8_LDA(At, 0, 1); PG8_STAGE(PG8_SB(0, 0), b2, voffB); PG8_STAGE(PG8_SB(0, 1), b2 + hstepB, voffB); PG8_STAGE(PG8_SA(0, 0), a2, voffA); \
            WV12; PG8_WAIT_L(0); PG8_BAR; PG8_MMA(1, 0, At, B0); PG8_MMA(1, 1, At, B1); PG8_BAR; PG8_SCHED; \
              \
            PG8_LDB(B0, 1, 0); PG8_LDB(B1, 1, 1); PG8_SCHED; PG8_LDA(At, 1, 0); PG8_STAGE(PG8_SA(0, 1), a2 + hstepA, voffA); \
            PG8_WAIT_V(8); PG8_WAIT_L(0); PG8_BAR; PG8_MMA(0, 0, At, B0); PG8_MMA(0, 1, At, B1); PG8_BAR; PG8_SCHED; \
              \
            PG8_LDA(At, 1, 1); PG8_STAGE(PG8_SB(1, 0), b3, voffB); PG8_STAGE(PG8_SB(1, 1), b3 + hstepB, voffB); PG8_STAGE(PG8_SA(1, 0), a3, voffA); \
            PG8_WAIT_V(8); PG8_WAIT_L(0); PG8_BAR; PG8_MMA(1, 0, At, B0); PG8_MMA(1, 1, At, B1); PG8_BAR; PG8_SCHED; }
        int t = 0;
        if constexpr (Epi::NST == 16) { if (ui > 0) { PG8_TRIP(PG8_WAIT_V(24)) t = 2; } }
        if constexpr (Epi::NST == 8) { if (ui > 0) { PG8_TRIP(PG8_WAIT_V(16)) t = 2; } }
        for (; t < nt; t += 2) PG8_TRIP(PG8_WAIT_V(8))
#undef PG8_TRIP
        if constexpr (ALIGN_EPI) { if (wr == 0) PG8_BAR; }
        if constexpr (!Epi::AFTER_DRAIN) { E(acc, cur, wr, wc, fr, fq); S.done(cur); }
        if (!has_next) break;
#pragma unroll
        for (int a = 0; a < 2; ++a)
#pragma unroll
            for (int b = 0; b < 2; ++b)
#pragma unroll
                for (int m = 0; m < 4; ++m)
#pragma unroll
                    for (int n = 0; n < 2; ++n) acc[a][b][m][n] = (f32x4){0.f, 0.f, 0.f, 0.f};
        cur = nxt; cA = nA; cB = nB; ++ui;
        if constexpr (ALIGN_EPI) { if (wr == 1) PG8_BAR; }
    }
    PG8_WAIT_V(0);
    if constexpr (!ALIGN_EPI) { if (wr == 0) PG8_BAR; }
    PG8_BAR;
    if constexpr (Epi::AFTER_DRAIN) { E.fused(acc, cur, wr, wc, fr, fq, lds, wid, lane); S.done(cur); }
#undef PG8_SA
#undef PG8_SB
#undef PG8_STAGE
#undef PG8_LDA
#undef PG8_LDB
#undef PG8_MMA
#undef PG8_WAIT_V
#undef PG8_WAIT_L
#undef PG8_BAR
#undef PG8_SCHED
}
}
namespace attn {
typedef unsigned short bf16;
using bf16x8 = __attribute__((ext_vector_type(8))) short;
using s16x4  = __attribute__((ext_vector_type(4))) short;
using f32x16 = __attribute__((ext_vector_type(16))) float;
using u32x4  = __attribute__((ext_vector_type(4))) unsigned;
constexpr int   D = 128, NW = 8, QBLK = 32, KVBLK = 64;
constexpr float SCALE = 0.088388347648318440f;
constexpr float THR = 8.f;
constexpr int LDQ = 3584, LDK = 3584, LDO = 2048;
constexpr size_t SHM_V = KVBLK * D * 2, SHM_K = KVBLK * D * 2, SHM_ATTN = 2 * SHM_V + 2 * SHM_K + NW * 64 * 4;
#define KSWZ(row, colB) ((row) * 256 + ((colB) ^ (((row) & 7) << 4)))
#define SBAR() __builtin_amdgcn_sched_barrier(0)
__device__ __forceinline__ int crow(int r, int hi) { return (r & 3) + 8 * (r >> 2) + 4 * hi; }
__device__ __forceinline__ unsigned cvtpk(float lo, float hi) { unsigned r; asm volatile("v_cvt_pk_bf16_f32 %0, %1, %2" : "=v"(r) : "v"(lo), "v"(hi)); return r; }
__device__ __forceinline__ bf16x8 ld8(const bf16* p) { return *reinterpret_cast<const bf16x8*>(p); }
__device__ __forceinline__ void partialSM(f32x16& p0, f32x16& p1, float& m_reg, float& mn, float& alpha) {
  constexpr float C = SCALE * 1.4426950408889634f;
  float pmax = p0[0]; for (int r = 1; r < 16; ++r) pmax = fmaxf(pmax, p0[r]); for (int r = 0; r < 16; ++r) pmax = fmaxf(pmax, p1[r]);
  { auto rr = __builtin_amdgcn_permlane32_swap(__float_as_uint(pmax), __float_as_uint(pmax), false, false);
    pmax = fmaxf(__uint_as_float(rr[0]), __uint_as_float(rr[1])); }
  if (__builtin_expect(__all(pmax - m_reg <= THR / SCALE), 1)) { mn = m_reg; alpha = 1.f; }
  else { mn = fmaxf(m_reg, pmax); alpha = __builtin_amdgcn_exp2f((m_reg - mn) * C); m_reg = mn; }
  float mnC = -mn * C;
  for (int r = 0; r < 16; ++r) p0[r] = fmaf(p0[r], C, mnC); for (int r = 0; r < 16; ++r) p1[r] = fmaf(p1[r], C, mnC);
  for (int r = 0; r < 16; ++r) p0[r] = __builtin_amdgcn_exp2f(p0[r]);
}
__device__ __forceinline__ void finishSM(f32x16& p0, f32x16& p1, float alpha, float& l_reg, bf16x8& pa0, bf16x8& pa1, bf16x8& pa2, bf16x8& pa3) {
  for (int r = 0; r < 16; ++r) p1[r] = __builtin_amdgcn_exp2f(p1[r]);
  float ps = 0; for (int r = 0; r < 16; ++r) ps += p0[r]; for (int r = 0; r < 16; ++r) ps += p1[r];
  { auto rr = __builtin_amdgcn_permlane32_swap(__float_as_uint(ps), __float_as_uint(ps), false, false);
    ps = __uint_as_float(rr[0]) + __uint_as_float(rr[1]); }
  l_reg = l_reg * alpha + ps;
#define PK4(P, BASE, OUT) do { unsigned a0 = cvtpk(P[BASE + 0], P[BASE + 1]), a1 = cvtpk(P[BASE + 2], P[BASE + 3]);   \
    unsigned b0 = cvtpk(P[BASE + 4], P[BASE + 5]), b1 = cvtpk(P[BASE + 6], P[BASE + 7]);                              \
    auto r0 = __builtin_amdgcn_permlane32_swap(a0, b0, false, false); auto r1 = __builtin_amdgcn_permlane32_swap(a1, b1, false, false); \
    u32x4 w = {r0[0], r1[0], r0[1], r1[1]}; OUT = *reinterpret_cast<bf16x8*>(&w); } while (0)
  PK4(p0, 0, pa0); PK4(p0, 8, pa1); PK4(p1, 0, pa2); PK4(p1, 8, pa3);
#undef PK4
}
__device__ __forceinline__ void qkt(f32x16& p0, f32x16& p1, const bf16* Ks, const bf16x8* qr, int r32, int hi) {
  p0 = f32x16{}; p1 = f32x16{};
  for (int d0 = 0; d0 < 8; ++d0) { int cb = (d0 * 16 + hi * 8) * 2;
    bf16x8 b0 = *reinterpret_cast<const bf16x8*>((const char*)Ks + KSWZ(r32, cb));
    bf16x8 b1 = *reinterpret_cast<const bf16x8*>((const char*)Ks + KSWZ(32 + r32, cb));
    p0 = __builtin_amdgcn_mfma_f32_32x32x16_bf16(b0, qr[d0], p0, 0, 0, 0);
    p1 = __builtin_amdgcn_mfma_f32_32x32x16_bf16(b1, qr[d0], p1, 0, 0, 0); }
}
__device__ __forceinline__ int v_st(int k, int c) { const int kk = (k & ~0xC) | ((k & 4) << 1) | ((k & 8) >> 1); return ((kk >> 3) * 4 + (c >> 5)) * 512 + ((kk & 7) * 32 + (c & 31)) * 2; }
__device__ __forceinline__ int v_rd_base(int lane) { return ((lane & 3) << 3) | (((lane >> 2) & 3) << 6) | (((lane >> 4) & 1) << 5) | (((lane >> 5) & 1) << 8); }
constexpr int v_rd_off(int d0, int ks, int half) { return d0 * 512 + ks * 4096 + half * 2048; }
template <int OFF> __device__ __forceinline__ s16x4 tr_read(int vb) {
  s16x4 r; asm volatile("ds_read_b64_tr_b16 %0, %1 offset:%2" : "=&v"(r) : "v"(vb), "i"(OFF) : "memory"); return r;
}
template <int D0> __device__ __forceinline__ void pv_one(f32x16& od, int vb, bf16x8 pa0, bf16x8 pa1, bf16x8 pa2, bf16x8 pa3) {
  const s16x4 l0 = tr_read<v_rd_off(D0, 0, 0)>(vb), h0 = tr_read<v_rd_off(D0, 0, 1)>(vb), l1 = tr_read<v_rd_off(D0, 1, 0)>(vb), h1 = tr_read<v_rd_off(D0, 1, 1)>(vb);
  const s16x4 l2 = tr_read<v_rd_off(D0, 2, 0)>(vb), h2 = tr_read<v_rd_off(D0, 2, 1)>(vb), l3 = tr_read<v_rd_off(D0, 3, 0)>(vb), h3 = tr_read<v_rd_off(D0, 3, 1)>(vb);
  asm volatile("s_waitcnt lgkmcnt(0)" ::: "memory"); SBAR();
#define PK(L, H) (bf16x8){L[0], L[1], L[2], L[3], H[0], H[1], H[2], H[3]}
  od = __builtin_amdgcn_mfma_f32_32x32x16_bf16(pa0, PK(l0, h0), od, 0, 0, 0);
  od = __builtin_amdgcn_mfma_f32_32x32x16_bf16(pa1, PK(l1, h1), od, 0, 0, 0);
  od = __builtin_amdgcn_mfma_f32_32x32x16_bf16(pa2, PK(l2, h2), od, 0, 0, 0);
  od = __builtin_amdgcn_mfma_f32_32x32x16_bf16(pa3, PK(l3, h3), od, 0, 0, 0);
#undef PK
}
__device__ __forceinline__ void pv_d0(f32x16* o, int vb, bf16x8 pa0, bf16x8 pa1, bf16x8 pa2, bf16x8 pa3) {
  pv_one<0>(o[0], vb, pa0, pa1, pa2, pa3); pv_one<1>(o[1], vb, pa0, pa1, pa2, pa3); pv_one<2>(o[2], vb, pa0, pa1, pa2, pa3); pv_one<3>(o[3], vb, pa0, pa1, pa2, pa3);
}
__device__ __forceinline__ void attn_unit(const bf16* __restrict__ Qb, const bf16* __restrict__ Kh, const bf16* __restrict__ Vh, bf16* __restrict__ Ob, int seq, char* lds, int wave_s,
                                          const float* __restrict__ qg, const float* __restrict__ rope, int t0) {
  constexpr int SDEPTH = 2;
  int tid_ = wave_s * 64 + lane_id(); asm volatile("" : "+v"(tid_));
  const int tid = tid_, wid = tid >> 6, lane = tid & 63, r32 = lane & 31, hi = lane >> 5;
  bf16* V_lds = (bf16*)lds; bf16* K_lds = (bf16*)(lds + 2 * SHM_V);
  float* ws = (float*)(lds + 2 * SHM_V + 2 * SHM_K) + wid * 64; float* li_l = ws; float* al_l = ws + 32;
  float m_reg = -1e30f, l_reg = 0; f32x16 o[4] = {}; bf16x8 qr[8];
  const bf16* Qw = Qb + (long)(wid * QBLK + r32) * LDQ + hi * 8;
  {
    float qf[8][8]; float ss = 0.f;
#pragma unroll
    for (int d0 = 0; d0 < 8; ++d0) { const bf16x8 raw = ld8(Qw + d0 * 16);
#pragma unroll
      for (int e = 0; e < 8; ++e) { qf[d0][e] = __uint_as_float(((unsigned)(unsigned short)raw[e]) << 16); ss += qf[d0][e] * qf[d0][e]; } }
    ss += __shfl_xor(ss, 32);
    const float rr = 1.0f / sqrtf(ss * (1.0f / 128.0f) + 1e-6f);
#pragma unroll
    for (int d0 = 0; d0 < 8; ++d0) { const float* gp = qg + d0 * 16 + hi * 8;
#pragma unroll
      for (int e = 0; e < 8; ++e) qf[d0][e] = qf[d0][e] * rr * gp[e]; }
    if (rope != nullptr) {
      const int t = t0 + wid * QBLK + r32, rowc = t >> 6, colc = t & 63;
#pragma unroll
      for (int pr = 0; pr < 4; ++pr) { const int d0 = (pr & 1) + (pr >> 1) * 4;
        const float* cs = rope + ((pr >> 1) ? colc : rowc) * 32 + (d0 & 1) * 16 + hi * 8; const float* sn = cs + 2048;
#pragma unroll
        for (int e = 0; e < 8; ++e) { const float c = cs[e], s = sn[e], x1 = qf[d0][e], x2 = qf[d0 + 2][e]; qf[d0][e] = x1 * c - x2 * s; qf[d0 + 2][e] = x1 * s + x2 * c; } }
    }
#pragma unroll
    for (int d0 = 0; d0 < 8; ++d0) { u32x4 w = {cvtpk(qf[d0][0], qf[d0][1]), cvtpk(qf[d0][2], qf[d0][3]), cvtpk(qf[d0][4], qf[d0][5]), cvtpk(qf[d0][6], qf[d0][7])}; qr[d0] = *reinterpret_cast<bf16x8*>(&w); }
  }
  const int sr = tid >> 4, sc = (tid & 15) * 8, vst0 = v_st(sr, sc), vst1 = v_st(32 + sr, sc);
  const int vb0 = (int)(uintptr_t)V_lds + v_rd_base(lane);
  struct { bf16x8 vs0, vs1, ks0, ks1; } sr_[SDEPTH];
#define SLOAD(i, k0) do { sr_[i].vs0 = ld8(&Vh[(long)((k0) + sr) * LDK + sc]); sr_[i].vs1 = ld8(&Vh[(long)((k0) + 32 + sr) * LDK + sc]); \
    sr_[i].ks0 = ld8(&Kh[(long)((k0) + sr) * LDK + sc]); sr_[i].ks1 = ld8(&Kh[(long)((k0) + 32 + sr) * LDK + sc]); } while (0)
#define SWRITE(b, i) do { *(bf16x8*)((char*)V_lds + (b) * SHM_V + vst0) = sr_[i].vs0;          \
    *(bf16x8*)((char*)V_lds + (b) * SHM_V + vst1) = sr_[i].vs1; int kc = sc * 2;               \
    *(bf16x8*)((char*)K_lds + (b) * SHM_K + KSWZ(sr, kc)) = sr_[i].ks0;                       \
    *(bf16x8*)((char*)K_lds + (b) * SHM_K + KSWZ(32 + sr, kc)) = sr_[i].ks1; } while (0)
#define SWAIT() asm volatile("s_waitcnt vmcnt(4)" ::: "memory")
#define RESC(a) do { if (__any((a) < 1.f)) { if (hi == 0) al_l[r32] = (a); asm volatile("s_waitcnt lgkmcnt(0)" ::: "memory"); \
    for (int d = 0; d < 4; ++d) for (int r = 0; r < 16; ++r) o[d][r] *= al_l[crow(r, hi)]; } } while (0)
  f32x16 pA0, pA1, pB0, pB1; float mnA, mnB, alA, alB; bf16x8 pa0, pa1, pa2, pa3; const int NT = seq / KVBLK;
  constexpr int SE = 0, SO = SDEPTH - 1;
  SLOAD(SE, 0); asm volatile("s_waitcnt vmcnt(0)" ::: "memory"); SWRITE(0, SE); __syncthreads();
  qkt(pA0, pA1, K_lds, qr, r32, hi); partialSM(pA0, pA1, m_reg, mnA, alA);
  SLOAD(SO, KVBLK); if (2 < NT) SLOAD(SE, 2 * KVBLK);
  SWAIT(); SWRITE(1, SO); __syncthreads();
  for (int j = 1; j + 1 < NT; j += 2) {
    SBAR(); qkt(pB0, pB1, (bf16*)((char*)K_lds + SHM_K), qr, r32, hi);
    finishSM(pA0, pA1, alA, l_reg, pa0, pa1, pa2, pa3); SBAR();
    SLOAD(SO, (j + SDEPTH) * KVBLK); SBAR();
    pv_d0(o, vb0, pa0, pa1, pa2, pa3); partialSM(pB0, pB1, m_reg, mnB, alB);
    __syncthreads(); SWAIT(); SWRITE(0, SE);
    RESC(alB); __syncthreads();
    SBAR(); qkt(pA0, pA1, K_lds, qr, r32, hi);
    finishSM(pB0, pB1, alB, l_reg, pa0, pa1, pa2, pa3); SBAR();
    if (j + 3 < NT) SLOAD(SE, (j + 1 + SDEPTH) * KVBLK); SBAR();
    pv_d0(o, vb0 + (int)SHM_V, pa0, pa1, pa2, pa3); partialSM(pA0, pA1, m_reg, mnA, alA);
    __syncthreads(); SWAIT(); SWRITE(1, SO);
    RESC(alA); __syncthreads();
  }
  SBAR(); qkt(pB0, pB1, (bf16*)((char*)K_lds + SHM_K), qr, r32, hi);
  finishSM(pA0, pA1, alA, l_reg, pa0, pa1, pa2, pa3); SBAR();
  pv_d0(o, vb0, pa0, pa1, pa2, pa3); partialSM(pB0, pB1, m_reg, mnB, alB);
  __syncthreads(); RESC(alB);
  finishSM(pB0, pB1, alB, l_reg, pa0, pa1, pa2, pa3); SBAR();
  pv_d0(o, vb0 + (int)SHM_V, pa0, pa1, pa2, pa3);
  if (hi == 0) li_l[r32] = l_reg; asm volatile("s_waitcnt lgkmcnt(0)" ::: "memory");
  float rli[16];
#pragma unroll
  for (int r = 0; r < 16; ++r) rli[r] = __builtin_amdgcn_rcpf(li_l[crow(r, hi)]);
  bf16* Ow = Ob + (long)(wid * QBLK) * LDO;
#pragma unroll
  for (int r = 0; r < 16; ++r) { int orow = crow(r, hi);
    for (int d0 = 0; d0 < 4; ++d0) { const float v = o[d0][r] * rli[r]; unsigned u = __float_as_uint(v); u = (u + 0x7fffu + ((u >> 16) & 1u)) >> 16;
      Ow[(long)orow * LDO + d0 * 32 + r32] = (bf16)u; } }
  __syncthreads();
#undef SLOAD
#undef SWRITE
#undef SWAIT
#undef RESC
}
#undef KSWZ
#undef SBAR
}
constexpr int DM = 2048, NB = 8, SEQ = 4096, CTXL = 256, DEPTH = 4;
constexpr int TPB = SEQ + CTXL;
constexpr int M = NB * TPB;
constexpr int ZW = 3584, FF = 5632, NMOD = 6 * DM;
constexpr int CONVW = 512, SSMW = 512, ATTW = 1024, NG = 32, NP = 64, NSG = 16;
constexpr int Z_CV = 0, Z_CB = 512, Z_CC = 1024, Z_SSM = 1536, Z_Q = 2048, Z_K = 3072, Z_V = 3328;
constexpr int MIX_CONV = 0, MIX_SSM = 512, MIX_ATT = 1024;
constexpr float RMS_EPS = 1e-6f;
constexpr int NWAVES = 8;
#ifndef REP_MASK
#define REP_MASK 0
#endif
#define NREP(b) (1 + ((REP_MASK >> (b)) & 1))

constexpr size_t MiB = 1u << 20;
constexpr size_t WS_CTL = 0, CTL_ZERO_BYTES = 1 * MiB;
constexpr size_t WS_MODP = 1 * MiB;
constexpr size_t WS_MOD  = 15 * MiB;
constexpr size_t WS_ROPE = 17 * MiB;
constexpr size_t WS_BBAR = 18 * MiB;
constexpr size_t WS_POW  = 20 * MiB;
constexpr size_t WS_KT   = 25 * MiB;
constexpr size_t WS_W    = 33 * MiB, W_LAYER = 89 * MiB;
constexpr size_t W_IN = 0, W_OUT = 14 * MiB, W_GU = 22 * MiB, W_DOWN = 66 * MiB, W_GLU = 88 * MiB;
constexpr size_t WS_TW   = WS_W + 4 * W_LAYER;
constexpr size_t WS_W1   = WS_TW + 96 * MiB;
constexpr size_t WS_X    = WS_W1 + 32 * MiB;
constexpr size_t WS_H    = WS_X + 272 * MiB;
constexpr size_t WS_Y    = WS_H + 136 * MiB;
constexpr size_t WS_UH   = WS_Y, WS_SB = WS_Y + 60 * MiB;
constexpr size_t WS_Z    = WS_Y + 136 * MiB;
constexpr size_t WS_MIX  = WS_Z + 238 * MiB;
constexpr size_t WS_ACT  = WS_Z;
constexpr size_t WS_G    = WS_MIX + 136 * MiB;
constexpr size_t WS_YP   = WS_G + 34 * MiB;
constexpr size_t WS_END  = WS_YP + 64 * MiB;
static_assert((size_t)M * DM * 4 == 272 * MiB && (size_t)M * ZW * 2 == 238 * MiB && (size_t)M * FF * 2 == 374 * MiB && (size_t)32 * SSM_RPG * UH_LD * 2 == 60 * MiB && (size_t)32 * SSM_RPG * 256 * 4 == 40 * MiB, "ws map");
static_assert(WS_END <= 1536 * MiB, "ws budget");
constexpr int CW_BAR = 4096;

constexpr int RING_OFF = 0, RING_BYTES = 131072;
constexpr int LDSCTL_OFF = RING_BYTES, MISC_OFF = LDSCTL_OFF + 320;
constexpr int LDS_BYTES = 147456;

#define GAS __attribute__((address_space(1)))
#define LAS __attribute__((address_space(3)))
typedef unsigned short bf16;
typedef unsigned v4u __attribute__((ext_vector_type(4)));
typedef unsigned v2u __attribute__((ext_vector_type(2)));
typedef float f32x4 __attribute__((ext_vector_type(4)));
typedef float f32x2 __attribute__((ext_vector_type(2)));
#define LDS_WAIT() asm volatile("s_waitcnt lgkmcnt(0)" ::: "memory")
#define VM_WAIT() asm volatile("s_waitcnt vmcnt(0)" ::: "memory")
__device__ __forceinline__ unsigned f2bf(float f) { unsigned u = __builtin_bit_cast(unsigned, f); return (u + 0x7fffu + ((u >> 16) & 1u)) >> 16; }
__device__ __forceinline__ unsigned pk2(float lo, float hi) { return f2bf(lo) | (f2bf(hi) << 16); }
__device__ __forceinline__ float blo(unsigned w) { return __uint_as_float(w << 16); }
__device__ __forceinline__ float bhi(unsigned w) { return __uint_as_float(w & 0xffff0000u); }
__device__ __forceinline__ float wave_sum(float v) {
#pragma unroll
    for (int o = 1; o < 64; o <<= 1) v += __shfl_xor(v, o);
    return v;
}

#define XB_TMO      128
#define XB_XCNT(j)  (256  + 64 * (j))
#define XB_XSUB(j)  (1280 + 64 * (j))
#define XB_XGEN(j)  (2304 + 64 * (j))
#define XB_TOP      3328
#define XB_TOPGEN   3392
#define XCD_BAR_WORDS 3456
#define XB_SPIN_CAP (1u << 18)

__device__ __forceinline__ unsigned xb_ld(unsigned* p)              { return __hip_atomic_load(p, __ATOMIC_RELAXED, __HIP_MEMORY_SCOPE_AGENT); }
__device__ __forceinline__ unsigned xb_add(unsigned* p, unsigned v) { return __hip_atomic_fetch_add(p, v, __ATOMIC_RELAXED, __HIP_MEMORY_SCOPE_AGENT); }
__device__ __forceinline__ unsigned xb_xcc_id() { return (unsigned)__builtin_amdgcn_s_getreg((3 << 11) | 20) & 0xFu; }
#define XB_SPIN(cond, bar) do { unsigned _sp = 0; while (cond) { __builtin_amdgcn_s_sleep(1); \
    if ((++_sp & 255u) == 0u) { if (xb_ld(&(bar)[XB_TMO])) break; if (_sp > XB_SPIN_CAP) { atomicAdd(&(bar)[XB_TMO], 1u); break; } } } } while (0)

struct XcdBarrier {
    unsigned* bar; unsigned x;
    volatile LAS unsigned* st;
};

__device__ __forceinline__ XcdBarrier xcd_barrier_post(unsigned* bar, volatile LAS unsigned* st, bool leader  ) {
    XcdBarrier b; b.bar = bar; b.x = xb_xcc_id(); b.st = st;
    if (leader) (void)xb_add(&bar[XB_XCNT(b.x)], 1u);
    return b;
}
__device__ __forceinline__ void xcd_barrier_complete(unsigned* bar, unsigned x, unsigned& nloc, unsigned& nx) {
    const unsigned G = gridDim.x * gridDim.y * gridDim.z;
    unsigned sum, cnt, mine, sp = 0u;
    for (;;) {
        sum = 0u; cnt = 0u; mine = 0u;
#pragma unroll
        for (unsigned j = 0; j < 16; ++j) { const unsigned c = xb_ld(&bar[XB_XCNT(j)]); sum += c; cnt += (c > 0u) ? 1u : 0u; mine = (j == x) ? c : mine; }
        if (sum == G) break;
        __builtin_amdgcn_s_sleep(1);
        if ((++sp & 255u) == 0u) { if (xb_ld(&bar[XB_TMO])) break; if (sp > XB_SPIN_CAP) { atomicAdd(&bar[XB_TMO], 1u); break; } }
    }
    nloc = mine > 0u ? mine : 1u; nx = cnt > 0u ? cnt : 1u;
}

__device__ __forceinline__ void xcd_barrier(const XcdBarrier& b, bool leader  ) {
    asm volatile("s_waitcnt vmcnt(0)" ::: "memory");
    __syncthreads();
    if (leader) {
        unsigned* bar = b.bar;
        __builtin_amdgcn_s_waitcnt(0);
        unsigned nloc = b.st[0], nx = b.st[1];
        if (nloc == 0u) { xcd_barrier_complete(bar, b.x, nloc, nx); b.st[0] = nloc; b.st[1] = nx; }
        const unsigned old = xb_add(&bar[XB_XSUB(b.x)], 1u);
        const unsigned gen = old / nloc;
        if (old + 1u == (gen + 1u) * nloc) {
            __builtin_amdgcn_fence(__ATOMIC_RELEASE, "agent");
            asm volatile("s_waitcnt vmcnt(0)" ::: "memory");
            const unsigned og = xb_add(&bar[XB_TOP], 1u);
            const unsigned tg = og / nx;
            if (og + 1u == (tg + 1u) * nx) xb_add(&bar[XB_TOPGEN], 1u);
            else XB_SPIN(xb_ld(&bar[XB_TOPGEN]) == tg, bar);
            __builtin_amdgcn_fence(__ATOMIC_ACQUIRE, "agent");
            xb_add(&bar[XB_XGEN(b.x)], 1u);
            asm volatile("s_waitcnt vmcnt(0)" ::: "memory");
        } else {
            XB_SPIN(xb_ld(&bar[XB_XGEN(b.x)]) == gen, bar);
            __builtin_amdgcn_fence(__ATOMIC_ACQUIRE, "agent");
            asm volatile("s_waitcnt vmcnt(0)" ::: "memory");
        }
    }
    __syncthreads();
}

struct Params { const float* in[28]; float* out; unsigned char* ws; int ph_lo, ph_hi; };
typedef const __attribute__((address_space(4))) Params* KP;
__device__ __forceinline__ KP kparams() { KP kp = (KP)__builtin_amdgcn_kernarg_segment_ptr(); asm volatile("" : "+s"(kp)); return kp; }
enum { I_X = 0, I_C, I_CTX, I_CCTX, I_WMOD, I_BMOD, I_GPREMIX, I_GPOSTMIX, I_GPREFFN, I_GPOSTFFN, I_WIN, I_CONVW, I_LAMRE, I_LAMIM, I_LOGDT, I_BRE, I_BIM, I_CRE, I_CIM,
       I_SSMD, I_WGLU, I_BGLU, I_QNORM, I_KNORM, I_WOUT, I_WGATE, I_WUP, I_WDOWN };

__device__ __forceinline__ void transpose_item(const float* __restrict__ W, int K, int N, bf16* WT, int k0, int n0, int dst_row0, LAS float* scr, int lane) {
#pragma unroll 8
    for (int i = 0; i < 32; ++i) { const int kk = 2 * i + (lane >> 5); scr[kk * 33 + (lane & 31)] = W[(size_t)(k0 + kk) * N + n0 + (lane & 31)]; }
    LDS_WAIT(); asm volatile("" ::: "memory");
    const int c = lane & 7;
#pragma unroll
    for (int j = 0; j < 4; ++j) { const int n = (lane >> 3) + 8 * j; const LAS float* s = scr + (8 * c) * 33 + n;
        v4u o; o.x = pk2(s[0 * 33], s[1 * 33]); o.y = pk2(s[2 * 33], s[3 * 33]); o.z = pk2(s[4 * 33], s[5 * 33]); o.w = pk2(s[6 * 33], s[7 * 33]);
        *(GAS v4u*)(WT + (size_t)(dst_row0 + n) * K + k0 + 8 * c) = o; }
    LDS_WAIT(); asm volatile("" ::: "memory");
}
constexpr int IT_MOD = DEPTH * 8 * 48;
constexpr int IT_ROPE = 32, IT_SSM = 256;
constexpr int TPL_IN = 32 * 112, TPL_OUT = 32 * 64, TPL_G = 32 * 176, TPL_D = 88 * 64, TPL_GLU = 8 * 16;
constexpr int TPL = TPL_IN + TPL_OUT + 2 * TPL_G + TPL_D + TPL_GLU;
constexpr int IT_TOTAL = IT_MOD + IT_ROPE + IT_SSM + DEPTH * TPL;

__device__ __forceinline__ void prologue_a(KP P, LAS unsigned char* lds, int wave, int lane) {
    LAS float* scr = (LAS float*)(lds + RING_OFF + wave * 16384);
    const int G = gridDim.x, gw = wave * G + (int)blockIdx.x, NGW = NWAVES * G;
    unsigned char* ws = P->ws;
    for (int it = gw; it < IT_TOTAL; it += NGW) {
        int r = it;
        if (r < IT_MOD) {
            const int l = r / 384, kc = (r % 384) / 48, nc = r % 48;
#pragma unroll
            for (int j = 0; j < 9; ++j)
#pragma unroll
                for (int q = 0; q < 4; ++q) { const int kk = q * 64 + lane, k = kc * 256 + kk;
                    const float cv = (j < 8) ? P->in[I_C][j * DM + k] : P->in[I_CCTX][k];
                    scr[j * 256 + kk] = cv / (1.0f + __expf(-cv)); }
            LDS_WAIT(); asm volatile("" ::: "memory");
            f32x4 acc[9];
#pragma unroll
            for (int j = 0; j < 9; ++j) acc[j] = (f32x4){0.f, 0.f, 0.f, 0.f};
            const float* wp = P->in[I_WMOD] + ((size_t)l * DM + kc * 256) * NMOD + nc * 256 + lane * 4;
#pragma unroll 4
            for (int kk = 0; kk < 256; ++kk) { const f32x4 w = *(const f32x4*)(wp + (size_t)kk * NMOD);
#pragma unroll
                for (int j = 0; j < 9; ++j) { const float s = scr[j * 256 + kk]; acc[j] += w * s; } }
            float* mp = (float*)(ws + WS_MODP) + ((size_t)(kc * DEPTH + l) * 9) * NMOD + nc * 256 + lane * 4;
#pragma unroll
            for (int j = 0; j < 9; ++j) *(f32x4*)(mp + (size_t)j * NMOD) = acc[j];
            LDS_WAIT(); asm volatile("" ::: "memory");
            continue;
        }
        r -= IT_MOD;
        if (r < IT_ROPE) {
            const int e = r * 64 + lane, coord = e >> 5, i = e & 31;
            const double inv = exp(-(double)i * (9.210340371976184 / 32.0));
            const double ang = (double)coord * inv;
            float* rp = (float*)(ws + WS_ROPE);
            rp[e] = (float)cos(ang); rp[2048 + e] = (float)sin(ang);
            continue;
        }
        r -= IT_ROPE;
        if (r < IT_SSM) {
            const int idx = r * 64 + lane;
            const int p = idx & 63, ldg = idx >> 6;
            const double lre = (double)P->in[I_LAMRE][idx], lim = (double)P->in[I_LAMIM][idx];
            const double dt = exp((double)P->in[I_LOGDT][ldg]);
            const double ea = exp(lre * dt), th = lim * dt;
            const double lbre = ea * cos(th), lbim = ea * sin(th);
            const double nr = lbre - 1.0, ni = lbim, dd = lre * lre + lim * lim;
            const double qre = (nr * lre + ni * lim) / dd, qim = (ni * lre - nr * lim) / dd;
            f32x2* bb = (f32x2*)(ws + WS_BBAR) + (size_t)idx * 16;
#pragma unroll
            for (int n = 0; n < 16; ++n) {
                const double bre = (double)P->in[I_BRE][(size_t)idx * 16 + n], bim = (double)P->in[I_BIM][(size_t)idx * 16 + n];
                bb[n] = (f32x2){(float)(qre * bre - qim * bim), (float)(qre * bim + qim * bre)};
            }
            f32x2* pw = (f32x2*)(ws + WS_POW) + (size_t)ldg * 33 * 64 + p;
            for (int e = 0; e <= 32; ++e) { const double m = exp(lre * dt * (double)e), a = th * (double)e; pw[e * 64] = (f32x2){(float)(m * cos(a)), (float)(m * sin(a))}; }
            continue;
        }
        r -= IT_SSM;
        const int l = r / TPL; r -= l * TPL;
        bf16* wl = (bf16*)(ws + WS_W + (size_t)l * W_LAYER);
        if (r < TPL_IN) { const int kb = r / 112, nb = r % 112; transpose_item(P->in[I_WIN] + (size_t)l * DM * ZW, DM, ZW, (bf16*)((unsigned char*)wl + W_IN), 64 * kb, 32 * nb, 32 * nb, scr, lane); continue; }
        r -= TPL_IN;
        if (r < TPL_OUT) { const int kb = r / 64, nb = r % 64; transpose_item(P->in[I_WOUT] + (size_t)l * DM * DM, DM, DM, (bf16*)((unsigned char*)wl + W_OUT), 64 * kb, 32 * nb, 32 * nb, scr, lane); continue; }
        r -= TPL_OUT;
        if (r < 2 * TPL_G) { const int up = r >= TPL_G; if (up) r -= TPL_G; const int kb = r / 176, nb = r % 176, n0 = 32 * nb;
            transpose_item(P->in[up ? I_WUP : I_WGATE] + (size_t)l * DM * FF, DM, FF, (bf16*)((unsigned char*)wl + W_GU), 64 * kb, n0, (n0 >> 7) * 256 + (n0 & 127) + (up ? 128 : 0), scr, lane); continue; }
        r -= 2 * TPL_G;
        if (r < TPL_D) { const int kb = r / 64, nb = r % 64; transpose_item(P->in[I_WDOWN] + (size_t)l * FF * DM, FF, DM, (bf16*)((unsigned char*)wl + W_DOWN), 64 * kb, 32 * nb, 32 * nb, scr, lane); continue; }
        r -= TPL_D;
        { const int kb = r / 16, nb = r % 16; transpose_item(P->in[I_WGLU] + (size_t)l * 512 * 512, 512, 512, (bf16*)((unsigned char*)wl + W_GLU), 64 * kb, 32 * nb, 32 * nb, scr, lane); }
    }
}
__device__ __forceinline__ void prologue_b(KP P, int tid) {
    const int total = DEPTH * 9 * NMOD;
    const float* mp = (const float*)(P->ws + WS_MODP); float* mo = (float*)(P->ws + WS_MOD);
    for (int idx = (int)blockIdx.x * 512 + tid; idx < total; idx += (int)gridDim.x * 512) {
        const int l = idx / (9 * NMOD), n = idx % NMOD;
        float s = P->in[I_BMOD][l * NMOD + n];
#pragma unroll
        for (int kc = 0; kc < 8; ++kc) s += mp[(size_t)kc * total + idx];
        mo[idx] = s;
    }
}

__device__ __forceinline__ void prologue_kt(KP P, int tid) {
    const f32x2* pw = (const f32x2*)(P->ws + WS_POW); const f32x2* bbar = (const f32x2*)(P->ws + WS_BBAR); float* kt = (float*)(P->ws + WS_KT);
    for (int idx = (int)blockIdx.x * 512 + tid; idx < DEPTH * 32 * 2 * 32 * 16; idx += (int)gridDim.x * 512) {
        const int no = idx & 15, tau = (idx >> 4) & 31, dir = (idx >> 9) & 1, g = (idx >> 10) & 31, l = idx >> 15;
        const int ldg = (l * 2 + dir) * 32 + g;
        float acc[16];
#pragma unroll
        for (int n = 0; n < 16; ++n) acc[n] = 0.f;
        for (int p = 0; p < 64; ++p) {
            const float cre = P->in[I_CRE][((size_t)ldg * 16 + no) * 64 + p], cim = P->in[I_CIM][((size_t)ldg * 16 + no) * 64 + p];
            const f32x2 w = pw[((size_t)ldg * 33 + tau) * 64 + p];
            const float are = cre * w[0] - cim * w[1], aim = cre * w[1] + cim * w[0];
            const f32x4* bp = (const f32x4*)(bbar + ((size_t)ldg * 64 + p) * 16);
#pragma unroll
            for (int q = 0; q < 8; ++q) { const f32x4 b2 = bp[q]; acc[2 * q] += are * b2[0] - aim * b2[1]; acc[2 * q + 1] += are * b2[2] - aim * b2[3]; }
        }
#pragma unroll
        for (int q = 0; q < 4; ++q) *(f32x4*)(kt + (size_t)idx * 16 + q * 4) = (f32x4){acc[q * 4], acc[q * 4 + 1], acc[q * 4 + 2], acc[q * 4 + 3]};
    }
}
__device__ __forceinline__ void prologue_s5w(KP P, int tid) {
    const f32x2* pw = (const f32x2*)(P->ws + WS_POW); const f32x2* bbar = (const f32x2*)(P->ws + WS_BBAR); const float* kt = (const float*)(P->ws + WS_KT);
    bf16* TW = (bf16*)(P->ws + WS_TW); bf16* W1 = (bf16*)(P->ws + WS_W1);
    for (int it = (int)blockIdx.x * 512 + tid; it < DEPTH * 32 * 65536; it += (int)gridDim.x * 512) {
        const int lg = it >> 16, l = lg >> 5, g = lg & 31; int r = it & 65535; float v[8];
        if (r < 49152) {
            const int row = r / 96, ch = r - row * 96, t = row >> 4, no = row & 15, k0 = ch * 8;
            if (k0 < 512) {
                const int s = k0 >> 4, ni0 = k0 & 15;
#pragma unroll
                for (int e = 0; e < 8; ++e) v[e] = 0.f;
                if (t >= s) { const float* kp = kt + ((((size_t)(l * 32 + g) * 2 + 0) * 32 + (t - s)) * 16 + no) * 16 + ni0;
#pragma unroll
                    for (int e = 0; e < 8; ++e) v[e] += kp[e]; }
                if (s >= t) { const float* kp = kt + ((((size_t)(l * 32 + g) * 2 + 1) * 32 + (s - t)) * 16 + no) * 16 + ni0;
#pragma unroll
                    for (int e = 0; e < 8; ++e) v[e] += kp[e]; }
                if (t == s) { const float dv = P->in[I_SSMD][l * SSMW + g * NSG + no];
#pragma unroll
                    for (int e = 0; e < 8; ++e) if (ni0 + e == no) v[e] += dv; }
            } else {
                const int kk = k0 - 512, dir = kk >> 7, part = (kk >> 6) & 1, p0 = kk & 63, ep = dir == 0 ? t + 1 : 32 - t, ldg = (l * 2 + dir) * 32 + g;
#pragma unroll
                for (int e = 0; e < 8; ++e) { const int p = p0 + e; const f32x2 w = pw[((size_t)ldg * 33 + ep) * 64 + p];
                    const float cre = P->in[I_CRE][((size_t)ldg * 16 + no) * 64 + p], cim = P->in[I_CIM][((size_t)ldg * 16 + no) * 64 + p];
                    v[e] = part == 0 ? (cre * w[0] - cim * w[1]) : -(cre * w[1] + cim * w[0]); }
            }
            v4u o; o.x = pk2(v[0], v[1]); o.y = pk2(v[2], v[3]); o.z = pk2(v[4], v[5]); o.w = pk2(v[6], v[7]);
            *(v4u*)(TW + ((size_t)lg * 512 + row) * 768 + k0) = o;
        } else {
            r -= 49152;
            const int r1 = r >> 6, ch = r & 63, dir = r1 >> 7, part = (r1 >> 6) & 1, p = r1 & 63, k0 = ch * 8, s = k0 >> 4, n0 = k0 & 15, ep = dir == 0 ? 31 - s : s, ldg = (l * 2 + dir) * 32 + g;
            const f32x2 w = pw[((size_t)ldg * 33 + ep) * 64 + p]; const f32x2* bp = bbar + ((size_t)ldg * 64 + p) * 16 + n0;
#pragma unroll
            for (int e = 0; e < 8; ++e) { const f32x2 b2 = bp[e]; v[e] = part == 0 ? (w[0] * b2[0] - w[1] * b2[1]) : (w[0] * b2[1] + w[1] * b2[0]); }
            v4u o; o.x = pk2(v[0], v[1]); o.y = pk2(v[2], v[3]); o.z = pk2(v[4], v[5]); o.w = pk2(v[6], v[7]);
            *(v4u*)(W1 + ((size_t)lg * 256 + r1) * 512 + k0) = o;
        }
    }
}

struct Thin {
    int init, fin;
    const float* x_lat; const float* x_ctx; const bf16* X; bf16* Xout; const bf16* Y; bf16* H; float* OUT;
    const float* gpost; const float* modg; int gc;
    const float* gpre; const float* mods; int sc;
    const float* YP; int ctx_mode;
};
__device__ __forceinline__ void thin_rows(const Thin& T, int wave, int lane) {
    const int G = gridDim.x;
    for (int r = (int)blockIdx.x * NWAVES + wave; r < M; r += G * NWAVES) {
        const int b = r / TPB, p = r - b * TPB, j = (p < CTXL) ? 8 : b;
        if ((T.fin || T.ctx_mode == 0) && p < CTXL) continue;
        float x[32];
        if (T.init) {
            const float* xsrc = (p < CTXL) ? T.x_ctx + ((size_t)b * CTXL + p) * DM : T.x_lat + ((size_t)b * SEQ + (p - CTXL)) * DM;
#pragma unroll
            for (int c = 0; c < 4; ++c) { const f32x4 a = *(const f32x4*)(xsrc + c * 512 + lane * 8), d = *(const f32x4*)(xsrc + c * 512 + lane * 8 + 4);
                x[c * 8 + 0] = a[0]; x[c * 8 + 1] = a[1]; x[c * 8 + 2] = a[2]; x[c * 8 + 3] = a[3]; x[c * 8 + 4] = d[0]; x[c * 8 + 5] = d[1]; x[c * 8 + 6] = d[2]; x[c * 8 + 7] = d[3]; }
        } else {
#pragma unroll
            for (int c = 0; c < 4; ++c) { const v4u w = *(const v4u*)(T.X + (size_t)r * DM + c * 512 + lane * 8);
                x[c * 8 + 0] = blo(w.x); x[c * 8 + 1] = bhi(w.x); x[c * 8 + 2] = blo(w.y); x[c * 8 + 3] = bhi(w.y); x[c * 8 + 4] = blo(w.z); x[c * 8 + 5] = bhi(w.z); x[c * 8 + 6] = blo(w.w); x[c * 8 + 7] = bhi(w.w); }
        }
        if (!T.init) {
            float y[32]; float ss = 0.f;
            if (p < CTXL && T.ctx_mode == 2) {
#pragma unroll
                for (int e = 0; e < 32; ++e) y[e] = 0.f;
#pragma unroll
                for (int q = 0; q < 4; ++q) { const float* yp = T.YP + ((size_t)q * 2048 + b * CTXL + p) * DM;
#pragma unroll
                    for (int c = 0; c < 4; ++c) { const f32x4 a = *(const f32x4*)(yp + c * 512 + lane * 8), d = *(const f32x4*)(yp + c * 512 + lane * 8 + 4);
                        y[c * 8 + 0] += a[0]; y[c * 8 + 1] += a[1]; y[c * 8 + 2] += a[2]; y[c * 8 + 3] += a[3]; y[c * 8 + 4] += d[0]; y[c * 8 + 5] += d[1]; y[c * 8 + 6] += d[2]; y[c * 8 + 7] += d[3]; } }
            } else {
#pragma unroll
            for (int c = 0; c < 4; ++c) { const v4u w = *(const v4u*)(T.Y + (size_t)r * DM + c * 512 + lane * 8);
                y[c * 8 + 0] = blo(w.x); y[c * 8 + 1] = bhi(w.x); y[c * 8 + 2] = blo(w.y); y[c * 8 + 3] = bhi(w.y); y[c * 8 + 4] = blo(w.z); y[c * 8 + 5] = bhi(w.z); y[c * 8 + 6] = blo(w.w); y[c * 8 + 7] = bhi(w.w); }
            }
#pragma unroll
            for (int e = 0; e < 32; ++e) ss += y[e] * y[e];
            ss = wave_sum(ss);
            const float r1 = 1.0f / sqrtf(ss * (1.0f / DM) + RMS_EPS);
            const float* gate = T.modg + (size_t)(j * 6 + T.gc) * DM;
#pragma unroll
            for (int c = 0; c < 4; ++c)
#pragma unroll
                for (int h = 0; h < 2; ++h) { const int col = c * 512 + lane * 8 + h * 4; const f32x4 gv = *(const f32x4*)(gate + col), pv = *(const f32x4*)(T.gpost + col);
#pragma unroll
                    for (int e = 0; e < 4; ++e) x[c * 8 + h * 4 + e] += gv[e] * (y[c * 8 + h * 4 + e] * r1 * pv[e]); }
        }
        if (T.fin) {
            float* o = T.OUT + ((size_t)b * SEQ + (p - CTXL)) * DM;
#pragma unroll
            for (int c = 0; c < 4; ++c) { *(f32x4*)(o + c * 512 + lane * 8) = (f32x4){x[c * 8 + 0], x[c * 8 + 1], x[c * 8 + 2], x[c * 8 + 3]}; *(f32x4*)(o + c * 512 + lane * 8 + 4) = (f32x4){x[c * 8 + 4], x[c * 8 + 5], x[c * 8 + 6], x[c * 8 + 7]}; }
            continue;
        }
        bf16* xo = T.Xout + (size_t)r * DM; float ss2 = 0.f;
#pragma unroll
        for (int c = 0; c < 4; ++c) { v4u w; w.x = pk2(x[c * 8 + 0], x[c * 8 + 1]); w.y = pk2(x[c * 8 + 2], x[c * 8 + 3]); w.z = pk2(x[c * 8 + 4], x[c * 8 + 5]); w.w = pk2(x[c * 8 + 6], x[c * 8 + 7]); *(v4u*)(xo + c * 512 + lane * 8) = w; }
#pragma unroll
        for (int e = 0; e < 32; ++e) ss2 += x[e] * x[e];
        ss2 = wave_sum(ss2);
        const float r2 = 1.0f / sqrtf(ss2 * (1.0f / DM) + RMS_EPS);
        const float* shift = T.mods + (size_t)(j * 6 + T.sc) * DM; const float* scale = shift + DM;
#pragma unroll
        for (int c = 0; c < 4; ++c) { float hv[8];
#pragma unroll
            for (int h = 0; h < 2; ++h) { const int col = c * 512 + lane * 8 + h * 4; const f32x4 gv = *(const f32x4*)(T.gpre + col), sv = *(const f32x4*)(scale + col), tv = *(const f32x4*)(shift + col);
#pragma unroll
                for (int e = 0; e < 4; ++e) hv[h * 4 + e] = (x[c * 8 + h * 4 + e] * r2 * gv[e]) * (1.0f + sv[e]) + tv[e]; }
            v4u w; w.x = pk2(hv[0], hv[1]); w.y = pk2(hv[2], hv[3]); w.z = pk2(hv[4], hv[5]); w.w = pk2(hv[6], hv[7]);
            *(v4u*)(T.H + (size_t)r * DM + c * 512 + lane * 8) = w; }
    }
}
__device__ __forceinline__ void unpack8(const v4u w, float* f) { f[0] = blo(w.x); f[1] = bhi(w.x); f[2] = blo(w.y); f[3] = bhi(w.y); f[4] = blo(w.z); f[5] = bhi(w.z); f[6] = blo(w.w); f[7] = bhi(w.w); }
__device__ __forceinline__ void prep_row(KP P, int l, int r, int lane) {
    bf16* Z = (bf16*)(P->ws + WS_Z); bf16* MIX = (bf16*)(P->ws + WS_MIX); const float* rope = (const float*)(P->ws + WS_ROPE);
    const int b = r / TPB, p = r - b * TPB; const bool lat = p >= CTXL;
    const int seg_lo = lat ? CTXL : 0, seg_hi = lat ? TPB : CTXL;
    bf16* zr = Z + (size_t)r * ZW;
    {
        const int ch = lane * 8; float v[8], gb[8], gc[8], up[8], un[8], uc[8];
        unpack8(*(const v4u*)(zr + Z_CV + ch), v); unpack8(*(const v4u*)(zr + Z_CB + ch), gb); unpack8(*(const v4u*)(zr + Z_CC + ch), gc);
#pragma unroll
        for (int e = 0; e < 8; ++e) uc[e] = gc[e] * v[e];
        if (p > seg_lo) { float a[8], c[8]; unpack8(*(const v4u*)(zr - ZW + Z_CV + ch), a); unpack8(*(const v4u*)(zr - ZW + Z_CC + ch), c);
#pragma unroll
            for (int e = 0; e < 8; ++e) up[e] = a[e] * c[e]; }
        else {
#pragma unroll
            for (int e = 0; e < 8; ++e) up[e] = 0.f; }
        if (p + 1 < seg_hi) { float a[8], c[8]; unpack8(*(const v4u*)(zr + ZW + Z_CV + ch), a); unpack8(*(const v4u*)(zr + ZW + Z_CC + ch), c);
#pragma unroll
            for (int e = 0; e < 8; ++e) un[e] = a[e] * c[e]; }
        else {
#pragma unroll
            for (int e = 0; e < 8; ++e) un[e] = 0.f; }
        const float* cw = P->in[I_CONVW] + (size_t)l * 3 * CONVW + ch; float o[8];
#pragma unroll
        for (int h = 0; h < 2; ++h) { const f32x4 w0 = *(const f32x4*)(cw + h * 4), w1 = *(const f32x4*)(cw + CONVW + h * 4), w2 = *(const f32x4*)(cw + 2 * CONVW + h * 4);
#pragma unroll
            for (int e = 0; e < 4; ++e) { const int k = h * 4 + e; o[k] = gb[k] * (w0[e] * up[k] + w1[e] * uc[k] + w2[e] * un[k]); } }
        v4u w; w.x = pk2(o[0], o[1]); w.y = pk2(o[2], o[3]); w.z = pk2(o[4], o[5]); w.w = pk2(o[6], o[7]);
        *(v4u*)(MIX + (size_t)r * DM + MIX_CONV + ch) = w;
    }
    const int t = p - CTXL, rowc = t >> 6, colc = t & 63;
    {
        const int sub = lane & 31; float k[4]; bf16* kp = zr + Z_K + lane * 4;
        const v2u kw = *(const v2u*)kp; k[0] = blo(kw.x); k[1] = bhi(kw.x); k[2] = blo(kw.y); k[3] = bhi(kw.y);
        float ss = k[0] * k[0] + k[1] * k[1] + k[2] * k[2] + k[3] * k[3];
        ss += __shfl_xor(ss, 1); ss += __shfl_xor(ss, 2); ss += __shfl_xor(ss, 4); ss += __shfl_xor(ss, 8); ss += __shfl_xor(ss, 16);
        const float rr = 1.0f / sqrtf(ss * (1.0f / 128.0f) + RMS_EPS);
        const float* kg = P->in[I_KNORM] + l * 128 + sub * 4;
#pragma unroll
        for (int e = 0; e < 4; ++e) k[e] = k[e] * rr * kg[e];
        if (lat) {
            const int coord = (sub < 16) ? rowc : colc; const float* cs = rope + coord * 32 + (sub & 7) * 4; const float* sn = cs + 2048;
#pragma unroll
            for (int e = 0; e < 4; ++e) { const float other = __shfl_xor(k[e], 8); const float c = cs[e], s = sn[e];
                k[e] = ((sub & 8) == 0) ? (k[e] * c - other * s) : (other * s + k[e] * c); }
        }
        v2u w; w.x = pk2(k[0], k[1]); w.y = pk2(k[2], k[3]); *(v2u*)kp = w;
    }
}

__device__ __forceinline__ void s5_carry_phase(KP P, int l, int wave, int lane) {
    const int G = gridDim.x;
    bf16* UH = (bf16*)(P->ws + WS_UH); const float* SB = (const float*)(P->ws + WS_SB);
    for (int it = wave * G + (int)blockIdx.x; it < 32 * NB * 2; it += NWAVES * G) {
        const int dir = it & 1, b = (it >> 1) & 7, g = it >> 4;
        const f32x2 l32 = ((const f32x2*)(P->ws + WS_POW))[((size_t)((l * 2 + dir) * 32 + g) * 33 + 32) * 64 + lane];
        float hre = 0.f, him = 0.f;
#pragma unroll 8
        for (int k = 0; k < SSM_CPB; ++k) {
            const int c = dir == 0 ? k : (k < 8 ? 7 - k : 143 - k);
            const size_t rowi = (size_t)g * SSM_RPG + ssm_rg(b, c);
            bf16* up = UH + rowi * UH_LD + 512 + dir * 128 + lane;
            up[0] = (bf16)f2bf(hre); up[64] = (bf16)f2bf(him);
            const float* sp = SB + rowi * 256 + dir * 128 + lane;
            const float sre = sp[0], sim = sp[64];
            const float nre = l32[0] * hre - l32[1] * him + sre, nim = l32[0] * him + l32[1] * hre + sim;
            hre = nre; him = nim;
        }
    }
}

__device__ __forceinline__ void attention_phase(KP P, int l, unsigned char* lds_generic, int wave_s) {
    const bf16* Z = (const bf16*)(P->ws + WS_Z); bf16* MIX = (bf16*)(P->ws + WS_MIX);
    const int G = gridDim.x;
    for (int i = 0; ; ++i) {
        int b, h, qb;
        if (G == 256) { if (i >= 4) break; const int xcd = blockIdx.x & 7, slot = blockIdx.x >> 3; const int pair = 2 * xcd + (i >> 1), uip = (i & 1) * 32 + slot; b = pair >> 1; h = (pair & 1) * 4 + (uip >> 4); qb = uip & 15; }
        else { const int u = i * G + blockIdx.x; if (u >= 1024) break; b = u >> 7; h = (u >> 4) & 7; qb = u & 15; }
        const int kvh = h >> 2; const size_t row0 = (size_t)b * TPB;
        attn::attn_unit(Z + (row0 + CTXL + qb * 256) * ZW + Z_Q + h * 128, Z + row0 * ZW + Z_K + kvh * 128, Z + row0 * ZW + Z_V + kvh * 128,
                        MIX + (row0 + CTXL + qb * 256) * DM + MIX_ATT + h * 128, TPB, (char*)lds_generic, wave_s, P->in[I_QNORM] + l * 128, (const float*)(P->ws + WS_ROPE), qb * 256);
    }
    if (l < DEPTH - 1) {
        for (int u = blockIdx.x; u < NB * 8; u += G) { const int b = u >> 3, h = u & 7, kvh = h >> 2; const size_t row0 = (size_t)b * TPB;
            attn::attn_unit(Z + row0 * ZW + Z_Q + h * 128, Z + row0 * ZW + Z_K + kvh * 128, Z + row0 * ZW + Z_V + kvh * 128, MIX + row0 * DM + MIX_ATT + h * 128, CTXL, (char*)lds_generic, wave_s, P->in[I_QNORM] + l * 128, nullptr, 0); }
    }
}
constexpr int PH_PRO = 3, PH_PER_LAYER = 10, PH_TOTAL = PH_PRO + DEPTH * PH_PER_LAYER;
__global__ void __launch_bounds__(NWAVES * 64, 2) trunk_fwd(Params Pval) {
    extern __shared__ __attribute__((aligned(16))) unsigned char lds_raw[];
    LAS unsigned char* lds = (LAS unsigned char*)lds_raw;
    const int wave = __builtin_amdgcn_readfirstlane((int)threadIdx.x >> 6);

    const int G = gridDim.x;
    for (int u = wave * 64 + lane_id(); u < (LDS_BYTES - LDSCTL_OFF) / 4; u += NWAVES * 64) ((LAS unsigned*)(lds + LDSCTL_OFF))[u] = 0u;
    __syncthreads();
    (void)Pval;
    KP P = kparams();
    const int lo = P->ph_lo, hi = P->ph_hi;
    unsigned char* ws = P->ws;
    XcdBarrier bar; bar.bar = (unsigned*)(ws + WS_CTL) + CW_BAR; bar.x = 0; bar.st = nullptr;
    if (hi - lo > 1) bar = xcd_barrier_post((unsigned*)(ws + WS_CTL) + CW_BAR, (volatile LAS unsigned*)(lds + MISC_OFF) + 8, wave == 0 && lane_id() == 0);
#define IN(k) (lo <= (k) && (k) < hi)
#define SEAM(k) do { if (IN((k) + 1)) { const bool ldr_ = (wave == 0) && (lane_id() == 0); xcd_barrier(bar, ldr_); if (NREP(17) > 1) xcd_barrier(bar, ldr_); } } while (0)

    if (IN(0)) { for (int rep = 0; rep < NREP(0); ++rep) prologue_a(P, lds, wave, lane_id()); SEAM(0); }
    if (IN(1)) { for (int rep = 0; rep < NREP(0); ++rep) { prologue_b(P, wave * 64 + lane_id()); prologue_kt(P, wave * 64 + lane_id()); } SEAM(1); }
    if (IN(2)) {
        for (int rep = 0; rep < NREP(0); ++rep) prologue_s5w(P, wave * 64 + lane_id());
        Thin T{}; T.init = 1; T.fin = 0; T.x_lat = P->in[I_X]; T.x_ctx = P->in[I_CTX]; T.X = (const bf16*)(ws + WS_X); T.Xout = (bf16*)(ws + WS_X); T.Y = nullptr; T.H = (bf16*)(ws + WS_H); T.OUT = nullptr;
        T.gpost = nullptr; T.modg = nullptr; T.gc = 0; T.gpre = P->in[I_GPREMIX]; T.mods = (const float*)(ws + WS_MOD); T.sc = 0; T.YP = nullptr; T.ctx_mode = 1;
        for (int rep = 0; rep < NREP(0); ++rep) thin_rows(T, wave, lane_id()); SEAM(2);
    }
    for (int l = 0; l < DEPTH; ++l) {
        const int pb = PH_PRO + l * PH_PER_LAYER;
        if (pb + PH_PER_LAYER <= lo || pb >= hi) continue;
        P = kparams(); ws = P->ws;
        const unsigned char* wl = ws + WS_W + (size_t)l * W_LAYER;
        const float* modl = (const float*)(ws + WS_MOD) + (size_t)l * 9 * NMOD;
        const bool lastl = (l == DEPTH - 1);
        float* YPp = (float*)(ws + WS_YP);
        if (IN(pb + 0)) {
            pg8::Gemm g{(const bf16*)(ws + WS_H), (const bf16*)(wl + W_IN), M, ZW, DM}; pg8::RowOrder S{ZW / 256, G, (int)blockIdx.x, 1, 0};
            pg8::EpiInProj E{(bf16*)(ws + WS_Z), (bf16*)(ws + WS_UH)};
            for (int rep = 0; rep < NREP(3); ++rep) pg8::gemm_phase<pg8::EpiInProj, pg8::RowOrder, true, true>(lds + RING_OFF, g, S, E, wave);
            SEAM(pb + 0);
        }
        if (IN(pb + 1)) {
            for (int r = (int)blockIdx.x * NWAVES + wave; r < M; r += NWAVES * G) prep_row(P, l, r, lane_id());
            pg8::Gemm g{(const bf16*)(ws + WS_UH), (const bf16*)(ws + WS_W1) + (size_t)l * 32 * 256 * 512, 0, 0, 512, UH_LD, 512}; pg8::S5Order1 S{G, (int)blockIdx.x};
            pg8::EpiS5State E{(float*)(ws + WS_SB)};
            for (int rep = 0; rep < NREP(13); ++rep) pg8::gemm_phase<pg8::EpiS5State, pg8::S5Order1, true, true>(lds + RING_OFF, g, S, E, wave);
            SEAM(pb + 1);
        }
        if (IN(pb + 2)) { for (int rep = 0; rep < NREP(14); ++rep) s5_carry_phase(P, l, wave, lane_id()); SEAM(pb + 2); }
        if (IN(pb + 3)) {
            { pg8::Gemm g{(const bf16*)(ws + WS_UH), (const bf16*)(ws + WS_TW) + (size_t)l * 32 * 512 * 768, 0, 0, 768, UH_LD, 768}; pg8::S5Order2 S{G, (int)blockIdx.x, l < DEPTH - 1 ? 5 : 4};
              pg8::EpiS5Out E{(bf16*)(ws + WS_G)};
              for (int rep = 0; rep < NREP(15); ++rep) pg8::gemm_phase<pg8::EpiS5Out, pg8::S5Order2, true, true>(lds + RING_OFF, g, S, E, wave); }
            __syncthreads();
            for (int rep = 0; rep < NREP(12); ++rep) attention_phase(P, l, lds_raw, wave);
            SEAM(pb + 3);
        }
        if (IN(pb + 4)) {
            pg8::Gemm g{(const bf16*)(ws + WS_G), (const bf16*)(wl + W_GLU), M, SSMW, SSMW}; pg8::RowOrder S{SSMW / 256, G, (int)blockIdx.x, lastl ? 0 : 1, 0};
            pg8::EpiGlu E{(const bf16*)(ws + WS_G), SSMW, (bf16*)(ws + WS_MIX) + MIX_SSM, DM, P->in[I_BGLU] + l * SSMW};
            for (int rep = 0; rep < NREP(11); ++rep) pg8::gemm_phase<pg8::EpiGlu, pg8::RowOrder, true, true>(lds + RING_OFF, g, S, E, wave);
            SEAM(pb + 4);
        }
        if (IN(pb + 5)) {
            pg8::Gemm g{(const bf16*)(ws + WS_MIX), (const bf16*)(wl + W_OUT), M, DM, DM}; pg8::RowOrder S{DM / 256, G, (int)blockIdx.x, lastl ? 0 : 2, DM / 256};
            pg8::EpiBf16 E{(bf16*)(ws + WS_Y), DM, YPp, DM / 64};
            for (int rep = 0; rep < NREP(6); ++rep) pg8::gemm_phase<pg8::EpiBf16, pg8::RowOrder, true, true>(lds + RING_OFF, g, S, E, wave);
            SEAM(pb + 5);
        }
        if (IN(pb + 6)) {
            Thin T{}; T.init = 0; T.fin = 0; T.x_lat = nullptr; T.x_ctx = nullptr; T.X = (const bf16*)(ws + WS_X); T.Xout = (bf16*)(ws + WS_X); T.Y = (const bf16*)(ws + WS_Y); T.H = (bf16*)(ws + WS_H); T.OUT = nullptr;
            T.gpost = P->in[I_GPOSTMIX] + l * DM; T.modg = modl; T.gc = 2; T.gpre = P->in[I_GPREFFN] + l * DM; T.mods = modl; T.sc = 3; T.YP = YPp; T.ctx_mode = lastl ? 0 : 2;
            if (NREP(7) > 1) { Thin T2 = T; T2.Xout = (bf16*)(ws + WS_Z); thin_rows(T2, wave, lane_id()); }
            thin_rows(T, wave, lane_id()); SEAM(pb + 6);
        }
        if (IN(pb + 7)) {
            pg8::Gemm g{(const bf16*)(ws + WS_H), (const bf16*)(wl + W_GU), M, 2 * FF, DM}; pg8::RowOrder S{2 * FF / 256, G, (int)blockIdx.x, lastl ? 0 : 1, 0};
            pg8::EpiSwiGlu E{(bf16*)(ws + WS_ACT), FF};
            for (int rep = 0; rep < NREP(8); ++rep) pg8::gemm_phase<pg8::EpiSwiGlu, pg8::RowOrder, true, true>(lds + RING_OFF, g, S, E, wave);
            SEAM(pb + 7);
        }
        if (IN(pb + 8)) {
            pg8::Gemm g{(const bf16*)(ws + WS_ACT), (const bf16*)(wl + W_DOWN), M, DM, FF}; pg8::RowOrder S{DM / 256, G, (int)blockIdx.x, lastl ? 0 : 2, FF / 256};
            pg8::EpiBf16 E{(bf16*)(ws + WS_Y), DM, YPp, FF / 64};
            for (int rep = 0; rep < NREP(9); ++rep) pg8::gemm_phase<pg8::EpiBf16, pg8::RowOrder, true, true>(lds + RING_OFF, g, S, E, wave);
            SEAM(pb + 8);
        }
        if (IN(pb + 9)) {
            const bool last = (l == DEPTH - 1); const int l2 = last ? l : l + 1;
            Thin T{}; T.init = 0; T.fin = last ? 1 : 0; T.x_lat = nullptr; T.x_ctx = nullptr; T.X = (const bf16*)(ws + WS_X); T.Xout = (bf16*)(ws + WS_X); T.Y = (const bf16*)(ws + WS_Y); T.H = (bf16*)(ws + WS_H); T.OUT = P->out;
            T.gpost = P->in[I_GPOSTFFN] + l * DM; T.modg = modl; T.gc = 5; T.gpre = P->in[I_GPREMIX] + l2 * DM; T.mods = (const float*)(ws + WS_MOD) + (size_t)l2 * 9 * NMOD; T.sc = 0; T.YP = YPp; T.ctx_mode = lastl ? 0 : 2;
            if (NREP(7) > 1) { Thin T2 = T; T2.Xout = (bf16*)(ws + WS_Z); thin_rows(T2, wave, lane_id()); }
            thin_rows(T, wave, lane_id()); SEAM(pb + 9);
        }
    }
#undef IN
#undef SEAM
}

extern "C" void kernel_launch(void* const* d_in, const int* in_sizes, int n_in, void* d_out, int out_size, void* d_ws, size_t ws_size, hipStream_t stream) {
    static int grid = 0;
    if (grid == 0) {
        if (n_in != 28 || in_sizes[0] != NB * SEQ * DM || out_size != NB * SEQ * DM || ws_size < WS_END) {
            fprintf(stderr, "kernel_launch: built for 28 inputs, x/out of %d floats, >= %zu bytes of workspace; got n_in %d, in0 %d, out %d, ws %zu; nothing launched\n", NB * SEQ * DM, (size_t)WS_END, n_in, n_in > 0 ? in_sizes[0] : -1, out_size, ws_size);
            grid = -1; return; }
        int dev = 0, cus = 0;
        if (hipGetDevice(&dev) != hipSuccess || hipDeviceGetAttribute(&cus, hipDeviceAttributeMultiprocessorCount, dev) != hipSuccess) { fprintf(stderr, "kernel_launch: device query failed\n"); grid = -1; return; }
        if (hipFuncSetAttribute((const void*)trunk_fwd, hipFuncAttributeMaxDynamicSharedMemorySize, LDS_BYTES) != hipSuccess) { fprintf(stderr, "kernel_launch: hipFuncSetAttribute failed\n"); grid = -1; return; }
        int per_cu = 0;
        if (hipOccupancyMaxActiveBlocksPerMultiprocessor(&per_cu, (const void*)trunk_fwd, NWAVES * 64, LDS_BYTES) != hipSuccess || per_cu < 1)
            fprintf(stderr, "kernel_launch: note: occupancy query reports %d workgroups per CU\n", per_cu);
        (void)hipGetLastError();
        grid = cus;
    }
    if (grid < 0) return;
    if (hipMemsetAsync((char*)d_ws + WS_CTL, 0, CTL_ZERO_BYTES, stream) != hipSuccess) { fprintf(stderr, "kernel_launch: memset failed\n"); return; }
    Params p{};
    for (int i = 0; i < 28; ++i) p.in[i] = (const float*)d_in[i];
    p.out = (float*)d_out; p.ws = (unsigned char*)d_ws;
#if MK_ONE_LAUNCH
    p.ph_lo = 0; p.ph_hi = PH_TOTAL;
    hipLaunchKernelGGL(trunk_fwd, dim3(grid), dim3(NWAVES * 64), LDS_BYTES, stream, p);
#else
    for (int k = 0; k < PH_TOTAL; ++k) { p.ph_lo = k; p.ph_hi = k + 1; hipLaunchKernelGGL(trunk_fwd, dim3(grid), dim3(NWAVES * 64), LDS_BYTES, stream, p); }
#endif
    const hipError_t le = hipPeekAtLastError();
    if (le != hipSuccess) fprintf(stderr, "kernel_launch: launch failed: %s\n", hipGetErrorName(le));
}
```

```cpp
#include <hip/hip_runtime.h>
#include <cstdio>
#include <cstdint>
#include <cmath>

#ifndef MK_ONE_LAUNCH
#define MK_ONE_LAUNCH 1
#endif

constexpr int SSM_L = 32, SSM_CPB = 136, SSM_RPG = 1280, UH_LD = 768;
__host__ __device__ __forceinline__ int ssm_rg(int b, int c) { return c >= 8 ? b * 128 + (c - 8) : 1024 + b * 8 + c; }

#ifndef REP_MASK
#define REP_MASK 0
#endif
#define NREP(b) (1 + ((REP_MASK >> (b)) & 1))
__device__ __forceinline__ int lane_id() { int l; asm volatile("v_mbcnt_lo_u32_b32 %0, -1, 0\n\tv_mbcnt_hi_u32_b32 %0, -1, %0" : "=v"(l)); return l; }
namespace pg8 {
#define PG8_LAS __attribute__((address_space(3)))
typedef unsigned short bf16_t;
typedef short bf16x8 __attribute__((ext_vector_type(8)));
typedef float f32x4 __attribute__((ext_vector_type(4)));
typedef unsigned u32x4 __attribute__((ext_vector_type(4)));
constexpr int BM = 256, BK = 64, HALF = 128, HTB = HALF * BK * 2  , STAGE_BYTES = 8 * HTB, NXCD = 8, WGM = 8;

__host__ __device__ __forceinline__ int lds_byte(int r, int c) { const int st = (r >> 4) * 2 + (c >> 5), rr = r & 15, cc = c & 31, ob = rr * 64 + cc * 2; return st * 1024 + (ob ^ (((ob >> 9) & 1) << 5)); }
__host__ __device__ __forceinline__ void stage_rc(int b, int& R, int& C) { const int st = b / 1024, sb = b % 1024, swz = sb ^ (((sb >> 9) & 1) << 5); R = (st >> 1) * 16 + swz / 64; C = (st & 1) * 32 + (swz % 64) / 2; }
__host__ __device__ __forceinline__ int perm32(int rho) { const int n = rho >> 4, i = rho & 15; return 8 * (i >> 2) + 4 * n + (i & 3); }

struct Unit { int pm, pn, ko, nt; };
struct Gemm { const bf16_t* A; const bf16_t* Bt; int M, N, K, lda, ldb; };

struct StaticOrder {
    int nM, nN, nwg, G, c;
    __host__ __device__ void init(int M, int N, int G_, int c_) { nM = M / BM; nN = N / BM; nwg = nM * nN; G = G_; c = c_; }
    __host__ __device__ bool next(int i, Unit& u) const {
        const long L = (long)i * G + c; if (L >= nwg) return false;
        int wgid = (int)L; { const int q = nwg / NXCD, r = nwg % NXCD, xcd = wgid % NXCD, off = wgid / NXCD; wgid = (xcd < r ? xcd * (q + 1) : r * (q + 1) + (xcd - r) * q) + off; }
        const int nig = WGM * nN, gid = wgid / nig, fm = gid * WGM, gsz = (nM - fm) < WGM ? (nM - fm) : WGM;
        u.pm = fm + ((wgid % nig) % gsz); u.pn = (wgid % nig) / gsz; return true;
    }
    __device__ __forceinline__ void a_ready(const Unit&) const {}
    __device__ __forceinline__ void done(const Unit&) const {}
};

__device__ __forceinline__ unsigned cvt_pk_bf16(float lo, float hi) { unsigned r; asm volatile("v_cvt_pk_bf16_f32 %0, %1, %2" : "=v"(r) : "v"(lo), "v"(hi)); return r; }
typedef float f32x2 __attribute__((ext_vector_type(2)));
struct EpiBf16 {
    static constexpr bool PERM = true, AFTER_DRAIN = false; static constexpr int NST = 0;
    bf16_t* O; int ldc; float* YP; int nt_full;
    __device__ __forceinline__ void operator()(const f32x4 (&acc)[2][2][4][2], const Unit& u, int wr, int wc, int fr, int fq) const {
        const int col0 = u.pn * BM + wc * 32 + 8 * fq;
        if (u.nt != nt_full) {
            const int q = u.ko / (u.nt * BK), b = u.pm / 17; float* base = YP + ((size_t)q * 2048 + b * 256 + wr * 64 + fr) * ldc + col0;
#pragma unroll
            for (int ai = 0; ai < 2; ++ai)
#pragma unroll
                for (int m = 0; m < 4; ++m) { float* rowp = base + (size_t)(ai * HALF + m * 16) * ldc;
#pragma unroll
                    for (int bj = 0; bj < 2; ++bj) { *(f32x4*)(rowp + bj * HALF) = acc[ai][bj][m][0]; *(f32x4*)(rowp + bj * HALF + 4) = acc[ai][bj][m][1]; } }
            return;
        }
        const int row0 = u.pm * BM + wr * 64 + fr;
#pragma unroll
        for (int ai = 0; ai < 2; ++ai)
#pragma unroll
            for (int m = 0; m < 4; ++m) { bf16_t* rowp = O + (size_t)(row0 + ai * HALF + m * 16) * ldc + col0;
#pragma unroll
                for (int bj = 0; bj < 2; ++bj) { const f32x4 v0 = acc[ai][bj][m][0], v1 = acc[ai][bj][m][1];
                    u32x4 w; w.x = cvt_pk_bf16(v0[0], v0[1]); w.y = cvt_pk_bf16(v0[2], v0[3]); w.z = cvt_pk_bf16(v1[0], v1[1]); w.w = cvt_pk_bf16(v1[2], v1[3]);
                    *(u32x4*)(rowp + bj * HALF) = w; } }
    }
};
struct RowOrder {
    int nN, G, c, ctx, ntq;
    __device__ bool next(int i, Unit& u) const {
        const int nlat = 128 * nN, L = i * G + c;
        if (L < nlat) {
            const int q = nlat / NXCD, wgid = (L % NXCD) * q + L / NXCD;
            const int nig = WGM * nN, gid = wgid / nig, rem = wgid - gid * nig, pml = gid * WGM + (rem % WGM);
            u.pn = rem / WGM; u.pm = (pml >> 4) * 17 + 1 + (pml & 15); return true;
        }
        const int Lc = L - nlat;
        if (ctx == 1) { if (Lc >= 8 * nN) return false; u.pm = (Lc / nN) * 17; u.pn = Lc % nN; return true; }
        if (ctx == 2) { if (Lc >= 32 * nN) return false; const int t = Lc >> 2; u.pm = (t / nN) * 17; u.pn = t % nN; u.ko = (Lc & 3) * ntq * BK; u.nt = ntq; return true; }
        return false;
    }
    __device__ __forceinline__ void a_ready(const Unit&) const {}
    __device__ __forceinline__ void done(const Unit&) const {}
};
__device__ __forceinline__ float bflo(unsigned w) { return __uint_as_float(w << 16); }
__device__ __forceinline__ float bfhi(unsigned w) { return __uint_as_float(w & 0xffff0000u); }
__device__ __forceinline__ float sigmoidf_(float x) { return __builtin_amdgcn_rcpf(1.0f + __expf(-x)); }
struct EpiGlu {
    static constexpr bool PERM = true, AFTER_DRAIN = false; static constexpr int NST = 0;
    const bf16_t* G; int ldg; bf16_t* O; int ldo; const float* bias;
    __device__ __forceinline__ void operator()(const f32x4 (&acc)[2][2][4][2], const Unit& u, int wr, int wc, int fr, int fq) const {
        const int row0 = u.pm * BM + wr * 64 + fr; const int col0 = u.pn * BM + wc * 32 + 8 * fq;
        f32x4 bv[2][2];
#pragma unroll
        for (int bj = 0; bj < 2; ++bj)
#pragma unroll
            for (int n = 0; n < 2; ++n) bv[bj][n] = *(const f32x4*)(bias + col0 + bj * HALF + 4 * n);
#pragma unroll
        for (int ai = 0; ai < 2; ++ai) {
            u32x4 gv[4][2];
#pragma unroll
            for (int m = 0; m < 4; ++m)
#pragma unroll
                for (int bj = 0; bj < 2; ++bj) gv[m][bj] = *(const u32x4*)(G + (size_t)(row0 + ai * HALF + m * 16) * ldg + col0 + bj * HALF);
            asm volatile("" ::: "memory");
#pragma unroll
            for (int m = 0; m < 4; ++m) { const size_t row = (size_t)(row0 + ai * HALF + m * 16);
#pragma unroll
                for (int bj = 0; bj < 2; ++bj) { const f32x4 v0 = acc[ai][bj][m][0] + bv[bj][0], v1 = acc[ai][bj][m][1] + bv[bj][1];
                    const u32x4 g = gv[m][bj];
                    const float o0 = bflo(g.x) * sigmoidf_(v0[0]), o1 = bfhi(g.x) * sigmoidf_(v0[1]), o2 = bflo(g.y) * sigmoidf_(v0[2]), o3 = bfhi(g.y) * sigmoidf_(v0[3]);
                    const float o4 = bflo(g.z) * sigmoidf_(v1[0]), o5 = bfhi(g.z) * sigmoidf_(v1[1]), o6 = bflo(g.w) * sigmoidf_(v1[2]), o7 = bfhi(g.w) * sigmoidf_(v1[3]);
                    u32x4 w; w.x = cvt_pk_bf16(o0, o1); w.y = cvt_pk_bf16(o2, o3); w.z = cvt_pk_bf16(o4, o5); w.w = cvt_pk_bf16(o6, o7);
                    *(u32x4*)(O + row * ldo + col0 + bj * HALF) = w; } }
            asm volatile("" ::: "memory");
        }
    }
};
struct EpiSwiGlu {
    static constexpr bool PERM = true, AFTER_DRAIN = false; static constexpr int NST = 8;
    bf16_t* O; int ldo;
    __device__ __forceinline__ void operator()(const f32x4 (&acc)[2][2][4][2], const Unit& u, int wr, int wc, int fr, int fq) const {
        const int row0 = u.pm * BM + wr * 64 + fr; const int col0 = u.pn * HALF + wc * 32 + 8 * fq;
#pragma unroll
        for (int ai = 0; ai < 2; ++ai)
#pragma unroll
            for (int m = 0; m < 4; ++m) { const size_t row = (size_t)(row0 + ai * HALF + m * 16);
                float o[8];
#pragma unroll
                for (int n = 0; n < 2; ++n)
#pragma unroll
                    for (int j = 0; j < 4; ++j) { const float g = acc[ai][0][m][n][j], up = acc[ai][1][m][n][j]; o[n * 4 + j] = g * sigmoidf_(g) * up; }
                u32x4 w; w.x = cvt_pk_bf16(o[0], o[1]); w.y = cvt_pk_bf16(o[2], o[3]); w.z = cvt_pk_bf16(o[4], o[5]); w.w = cvt_pk_bf16(o[6], o[7]);
                *(u32x4*)(O + row * ldo + col0) = w; }
    }
};
struct EpiInProj {
    static constexpr bool PERM = true, AFTER_DRAIN = false; static constexpr int NST = 0;
    bf16_t* Z; bf16_t* UH;
    __device__ __forceinline__ void operator()(const f32x4 (&acc)[2][2][4][2], const Unit& u, int wr, int wc, int fr, int fq) const {
        const int row0 = u.pm * BM + wr * 64 + fr; const int col0 = u.pn * BM + wc * 32 + 8 * fq;
        const bool ssm = (u.pn == 6 || u.pn == 7);
#pragma unroll
        for (int ai = 0; ai < 2; ++ai)
#pragma unroll
            for (int m = 0; m < 4; ++m) { const int row = row0 + ai * HALF + m * 16;
                int b = 0, pos = 0; if (ssm) { b = row / 4352; pos = row - b * 4352; }
#pragma unroll
                for (int bj = 0; bj < 2; ++bj) { const f32x4 v0 = acc[ai][bj][m][0], v1 = acc[ai][bj][m][1];
                    u32x4 w; w.x = cvt_pk_bf16(v0[0], v0[1]); w.y = cvt_pk_bf16(v0[2], v0[3]); w.z = cvt_pk_bf16(v1[0], v1[1]); w.w = cvt_pk_bf16(v1[2], v1[3]);
                    const int col = col0 + bj * HALF;
                    if (ssm) { const int sc = col - 1536, g = sc >> 4, n0 = sc & 15; *(u32x4*)(UH + ((size_t)(g * SSM_RPG + ssm_rg(b, pos >> 5)) * UH_LD + (pos & 31) * 16 + n0)) = w; }
                    else *(u32x4*)(Z + (size_t)row * 3584 + col) = w; } }
    }
};
struct EpiS5State {
    static constexpr bool PERM = true, AFTER_DRAIN = false; static constexpr int NST = 0;
    float* S;
    __device__ __forceinline__ void operator()(const f32x4 (&acc)[2][2][4][2], const Unit& u, int wr, int wc, int fr, int fq) const {
        const int row0 = u.pm * BM + wr * 64 + fr; const int col0 = wc * 32 + 8 * fq;
#pragma unroll
        for (int ai = 0; ai < 2; ++ai)
#pragma unroll
            for (int m = 0; m < 4; ++m) { float* rowp = S + (size_t)(row0 + ai * HALF + m * 16) * 256 + col0;
#pragma unroll
                for (int bj = 0; bj < 2; ++bj) { *(f32x4*)(rowp + bj * HALF) = acc[ai][bj][m][0]; *(f32x4*)(rowp + bj * HALF + 4) = acc[ai][bj][m][1]; } }
    }
};
__device__ __forceinline__ float gelu_tanh_(float y) {
    const float z = 0.7978845608028654f * (y + 0.044715f * y * y * y);
    const float t = 1.0f - 2.0f * __builtin_amdgcn_rcpf(__expf(2.0f * z) + 1.0f);
    return 0.5f * y * (1.0f + t);
}
struct EpiS5Out {
    static constexpr bool PERM = true, AFTER_DRAIN = false; static constexpr int NST = 0;
    bf16_t* G;
    __device__ __forceinline__ void operator()(const f32x4 (&acc)[2][2][4][2], const Unit& u, int wr, int wc, int fr, int fq) const {
        const int g = u.pn >> 1, j = u.pn & 1, i = u.pm - 5 * g;
        const int rg0 = i * BM + wr * 64 + fr; const int col0 = j * BM + wc * 32 + 8 * fq;
#pragma unroll
        for (int ai = 0; ai < 2; ++ai)
#pragma unroll
            for (int m = 0; m < 4; ++m) { const int rg = rg0 + ai * HALF + m * 16;
                if (rg < 1088) {
                    int b, c; if (rg < 1024) { b = rg >> 7; c = 8 + (rg & 127); } else { b = (rg - 1024) >> 3; c = (rg - 1024) & 7; }
                    const size_t grow0 = (size_t)b * 4352 + c * 32;
#pragma unroll
                    for (int bj = 0; bj < 2; ++bj) { const f32x4 v0 = acc[ai][bj][m][0], v1 = acc[ai][bj][m][1];
                        const int col = col0 + bj * HALF, t = col >> 4, n0 = col & 15;
                        u32x4 w; w.x = cvt_pk_bf16(gelu_tanh_(v0[0]), gelu_tanh_(v0[1])); w.y = cvt_pk_bf16(gelu_tanh_(v0[2]), gelu_tanh_(v0[3]));
                        w.z = cvt_pk_bf16(gelu_tanh_(v1[0]), gelu_tanh_(v1[1])); w.w = cvt_pk_bf16(gelu_tanh_(v1[2]), gelu_tanh_(v1[3]));
                        *(u32x4*)(G + (grow0 + t) * 512 + g * 16 + n0) = w; } } }
    }
};
struct S5Order1 { int G, c;
    __device__ bool next(int i, Unit& u) const { const int L = i * G + c; if (L >= 160) return false; u.pm = L; u.pn = L / 5; return true; }
    __device__ __forceinline__ void a_ready(const Unit&) const {}
    __device__ __forceinline__ void done(const Unit&) const {} };
struct S5Order2 { int G, c, nt;
    __device__ bool next(int i, Unit& u) const { const int L = i * G + c; if (L >= 32 * nt * 2) return false; const int g = L / (2 * nt), r = L - g * 2 * nt; u.pm = g * 5 + (r >> 1); u.pn = g * 2 + (r & 1); return true; }
    __device__ __forceinline__ void a_ready(const Unit&) const {}
    __device__ __forceinline__ void done(const Unit&) const {} };
template <class Epi, class Sched, bool ALIGN_EPI = false, bool SP2 = false>
__device__ __forceinline__ void gemm_phase(PG8_LAS unsigned char* lds, const Gemm g, const Sched& S, const Epi& E, int wave_s) {
    int tid_ = wave_s * 64 + lane_id(); asm volatile("" : "+v"(tid_));
    const int tid = tid_, wid = __builtin_amdgcn_readfirstlane(tid >> 6), lane = tid & 63, wr = wid >> 2, wc = wid & 3, fr = lane & 15, fq = lane >> 4;
    const int K = g.K, lda = g.lda ? g.lda : K, ldb = g.ldb ? g.ldb : K;
    unsigned voffA[2], voffB[2];
#pragma unroll
    for (int i = 0; i < 2; ++i) { int R, C; stage_rc(tid * 16 + i * 8192, R, C); const int Rb = Epi::PERM ? ((R & ~31) + perm32(R & 31)) : R;
        voffA[i] = (unsigned)(R * lda + C) * 2u; voffB[i] = (unsigned)(Rb * ldb + C) * 2u; }
    const size_t kstep = (size_t)(BK * 2);
    const size_t hstepA = (size_t)HALF * lda * 2, hstepB = (size_t)HALF * ldb * 2;
    const size_t tstepA = 2 * hstepA, tstepB = 2 * hstepB;
    const unsigned ldsw = (unsigned)wid * 1024u;
    const int aoff = lds_byte(wr * 64 + fr, fq * 8), boff = lds_byte(wc * 32 + fr, fq * 8);
#define PG8_SA(b, h) (((b) * 2 + (h)) * HTB)
#define PG8_SB(b, h) ((4 + (b) * 2 + (h)) * HTB)
#define PG8_STAGE(bufoff, gbase, voff) do { _Pragma("unroll") for (int _i = 0; _i < 2; ++_i) \
        __builtin_amdgcn_global_load_lds((const unsigned*)((const char*)(gbase) + (voff)[_i]), (PG8_LAS unsigned*)(lds + (bufoff) + ldsw + _i * 8192), 16, 0, 0); } while (0)
#define PG8_LDA(dst, b, h) do { _Pragma("unroll") for (int m = 0; m < 4; ++m) _Pragma("unroll") for (int k = 0; k < 2; ++k) dst[m][k] = *(const PG8_LAS bf16x8*)(lds + PG8_SA(b, h) + aoff + m * 2048 + k * 1024); } while (0)
#define PG8_LDB(dst, b, h) do { _Pragma("unroll") for (int n = 0; n < 2; ++n) _Pragma("unroll") for (int k = 0; k < 2; ++k) dst[n][k] = *(const PG8_LAS bf16x8*)(lds + PG8_SB(b, h) + boff + n * 2048 + k * 1024); } while (0)
#define PG8_MMA(ai, bj, At, Bt) do { __builtin_amdgcn_s_setprio(1); _Pragma("unroll") for (int m = 0; m < 4; ++m) _Pragma("unroll") for (int n = 0; n < 2; ++n) _Pragma("unroll") for (int k = 0; k < 2; ++k) \
        acc[ai][bj][m][n] = __builtin_amdgcn_mfma_f32_16x16x32_bf16(Bt[n][k], At[m][k], acc[ai][bj][m][n], 0, 0, 0); __builtin_amdgcn_s_setprio(0); } while (0)
#define PG8_WAIT_V(n) asm volatile("s_waitcnt vmcnt(" #n ")" ::: "memory")
#define PG8_WAIT_L(n) asm volatile("s_waitcnt lgkmcnt(" #n ")" ::: "memory")
#define PG8_BAR __builtin_amdgcn_s_barrier()
#define PG8_SCHED __builtin_amdgcn_sched_barrier(0)
    Unit cur, nxt; int ui = 0;
    cur.ko = 0; cur.nt = K / BK; nxt.ko = 0; nxt.nt = K / BK;
    if (!S.next(0, cur)) return;
    f32x4 acc[2][2][4][2];
#pragma unroll
    for (int a = 0; a < 2; ++a)
#pragma unroll
        for (int b = 0; b < 2; ++b)
#pragma unroll
            for (int m = 0; m < 4; ++m)
#pragma unroll
                for (int n = 0; n < 2; ++n) acc[a][b][m][n] = (f32x4){0.f, 0.f, 0.f, 0.f};
    bf16x8 At[4][2], B0[2][2], B1[2][2];
    const char* cA = (const char*)g.A + (size_t)cur.pm * tstepA + (size_t)cur.ko * 2; const char* cB = (const char*)g.Bt + (size_t)cur.pn * tstepB + (size_t)cur.ko * 2;
    S.a_ready(cur);
    if constexpr (SP2) {
        PG8_STAGE(PG8_SB(0, 0), cB, voffB); PG8_STAGE(PG8_SB(0, 1), cB + hstepB, voffB); PG8_STAGE(PG8_SA(0, 0), cA, voffA); PG8_STAGE(PG8_SA(0, 1), cA + hstepA, voffA);
        if (wr == 1) PG8_BAR;
        PG8_WAIT_V(2); PG8_BAR;
        PG8_STAGE(PG8_SB(1, 0), cB + kstep, voffB); PG8_STAGE(PG8_SA(1, 0), cA + kstep, voffA); PG8_STAGE(PG8_SB(1, 1), cB + hstepB + kstep, voffB);
        PG8_WAIT_V(6); PG8_BAR;
    } else {
        PG8_STAGE(PG8_SB(0, 0), cB, voffB); PG8_STAGE(PG8_SA(0, 0), cA, voffA); PG8_STAGE(PG8_SB(0, 1), cB + hstepB, voffB); PG8_STAGE(PG8_SA(0, 1), cA + hstepA, voffA);
        if (wr == 1) PG8_BAR;
        PG8_WAIT_V(4); PG8_BAR;
        PG8_STAGE(PG8_SB(1, 0), cB + kstep, voffB); PG8_STAGE(PG8_SA(1, 0), cA + kstep, voffA); PG8_STAGE(PG8_SB(1, 1), cB + hstepB + kstep, voffB);
        PG8_WAIT_V(6); PG8_BAR;
    }
    for (;;) {
        nxt.ko = 0; nxt.nt = K / BK;
        const bool has_next = S.next(ui + 1, nxt);
        const int nt = cur.nt;
        const char* nA = has_next ? (const char*)g.A + (size_t)nxt.pm * tstepA + (size_t)nxt.ko * 2 : cA; const char* nB = has_next ? (const char*)g.Bt + (size_t)nxt.pn * tstepB + (size_t)nxt.ko * 2 : cB;
        static_assert(SP2, "this build keeps only the two-super-phase K-loop");
#define PG8_TRIP(WV12) { \
            const bool last = (t == nt - 2); \
            const char* a1 = cA + (size_t)(t + 1) * kstep; \
            const char* a2 = last ? nA : cA + (size_t)(t + 2) * kstep; const char* b2 = last ? nB : cB + (size_t)(t + 2) * kstep; \
            const char* a3 = a2 + kstep; const char* b3 = b2 + kstep; \
            if (last && has_next) S.a_ready(nxt); \
              \
            PG8_LDB(B0, 0, 0); PG8_LDB(B1, 0, 1); PG8_SCHED; PG8_LDA(At, 0, 0); PG8_STAGE(PG8_SA(1, 1), a1 + hstepA, voffA); \
            WV12; PG8_WAIT_L(0); PG8_BAR; PG8_MMA(0, 0, At, B0); PG8_MMA(0, 1, At, B1); PG8_BAR; PG8_SCHED; \
              \
            PG8_LDA(At, 0, 1); PG8_STAGE(PG8_SB(0, 0), b2, voffB); PG8_STAGE(PG8_SB(0, 1), b2 + hstepB, voffB); PG8_STAGE(PG8_SA(0, 0), a2, voffA); \
            WV12; PG8_WAIT_L(0); PG8_BAR; PG8_MMA(1, 0, At, B0); PG8_MMA(1, 1, At, B1); PG8_BAR; PG8_SCHED; \
              \
            PG8_LDB(B0, 1, 0); PG8_LDB(B1, 1, 1); PG8_SCHED; PG8_LDA(At, 1, 0); PG8_STAGE(PG8_SA(0, 1), a2 + hstepA, voffA); \
            PG8_WAIT_V(8); PG8_WAIT_L(0); PG8_BAR; PG8_MMA(0, 0, At, B0); PG8_MMA(0, 1, At, B1); PG8_BAR; PG8_SCHED; \
              \
            PG8_LDA(At, 1, 1); PG8_STAGE(PG8_SB(1, 0), b3, voffB); PG8_STAGE(PG8_SB(1, 1), b3 + hstepB, voffB); PG8_STAGE(PG8_SA(1, 0), a3, voffA); \
            PG8_WAIT_V(8); PG8_WAIT_L(0); PG8_BAR; PG8_MMA(1, 0, At, B0); PG8_MMA(1, 1, At, B1); PG8_BAR; PG8_SCHED; }
        int t = 0;
        if constexpr (Epi::NST == 16) { if (ui > 0) { PG8_TRIP(PG8_WAIT_V(24)) t = 2; } }
        if constexpr (Epi::NST == 8) { if (ui > 0) { PG8_TRIP(PG8_WAIT_V(16)) t = 2; } }
        for (; t < nt; t += 2) PG8_TRIP(PG8_WAIT_V(8))
#undef PG8_TRIP
        if constexpr (ALIGN_EPI) { if (wr == 0) PG8_BAR; }
        if constexpr (!Epi::AFTER_DRAIN) { E(acc, cur, wr, wc, fr, fq); S.done(cur); }
        if (!has_next) break;
#pragma unroll
        for (int a = 0; a < 2; ++a)
#pragma unroll
            for (int b = 0; b < 2; ++b)
#pragma unroll
                for (int m = 0; m < 4; ++m)
#pragma unroll
                    for (int n = 0; n < 2; ++n) acc[a][b][m][n] = (f32x4){0.f, 0.f, 0.f, 0.f};
        cur = nxt; cA = nA; cB = nB; ++ui;
        if constexpr (ALIGN_EPI) { if (wr == 1) PG8_BAR; }
    }
    PG8_WAIT_V(0);
    if constexpr (!ALIGN_EPI) { if (wr == 0) PG8_BAR; }
    PG8_BAR;
    if constexpr (Epi::AFTER_DRAIN) { E.fused(acc, cur, wr, wc, fr, fq, lds, wid, lane); S.done(cur); }
#undef PG8_SA
#undef PG8_SB
#undef PG8_STAGE
#undef PG8_LDA
#undef PG8_LDB
#undef PG8_MMA
#undef PG8_WAIT_V
#undef PG8_WAIT_L
#undef PG8_BAR
#undef PG8_SCHED
}
}
namespace attn {
typedef unsigned short bf16;
using bf16x8 = __attribute__((ext_vector_type(8))) short;
using s16x4  = __attribute__((ext_vector_type(4))) short;
using f32x16 = __attribute__((ext_vector_type(16))) float;
using u32x4  = __attribute__((ext_vector_type(4))) unsigned;
constexpr int   D = 128, NW = 8, QBLK = 32, KVBLK = 64;
constexpr float SCALE = 0.088388347648318440f;
constexpr float THR = 8.f;
constexpr int LDQ = 3584, LDK = 3584, LDO = 2048;
constexpr size_t SHM_V = KVBLK * D * 2, SHM_K = KVBLK * D * 2, SHM_ATTN = 2 * SHM_V + 2 * SHM_K + NW * 64 * 4;
#define KSWZ(row, colB) ((row) * 256 + ((colB) ^ (((row) & 7) << 4)))
#define SBAR() __builtin_amdgcn_sched_barrier(0)
__device__ __forceinline__ int crow(int r, int hi) { return (r & 3) + 8 * (r >> 2) + 4 * hi; }
__device__ __forceinline__ unsigned cvtpk(float lo, float hi) { unsigned r; asm volatile("v_cvt_pk_bf16_f32 %0, %1, %2" : "=v"(r) : "v"(lo), "v"(hi)); return r; }
__device__ __forceinline__ bf16x8 ld8(const bf16* p) { return *reinterpret_cast<const bf16x8*>(p); }
__device__ __forceinline__ void partialSM(f32x16& p0, f32x16& p1, float& m_reg, float& mn, float& alpha) {
  constexpr float C = SCALE * 1.4426950408889634f;
  float pmax = p0[0]; for (int r = 1; r < 16; ++r) pmax = fmaxf(pmax, p0[r]); for (int r = 0; r < 16; ++r) pmax = fmaxf(pmax, p1[r]);
  { auto rr = __builtin_amdgcn_permlane32_swap(__float_as_uint(pmax), __float_as_uint(pmax), false, false);
    pmax = fmaxf(__uint_as_float(rr[0]), __uint_as_float(rr[1])); }
  if (__builtin_expect(__all(pmax - m_reg <= THR / SCALE), 1)) { mn = m_reg; alpha = 1.f; }
  else { mn = fmaxf(m_reg, pmax); alpha = __builtin_amdgcn_exp2f((m_reg - mn) * C); m_reg = mn; }
  float mnC = -mn * C;
  for (int r = 0; r < 16; ++r) p0[r] = fmaf(p0[r], C, mnC); for (int r = 0; r < 16; ++r) p1[r] = fmaf(p1[r], C, mnC);
  for (int r = 0; r < 16; ++r) p0[r] = __builtin_amdgcn_exp2f(p0[r]);
}
__device__ __forceinline__ void finishSM(f32x16& p0, f32x16& p1, float alpha, float& l_reg, bf16x8& pa0, bf16x8& pa1, bf16x8& pa2, bf16x8& pa3) {
  for (int r = 0; r < 16; ++r) p1[r] = __builtin_amdgcn_exp2f(p1[r]);
  float ps = 0; for (int r = 0; r < 16; ++r) ps += p0[r]; for (int r = 0; r < 16; ++r) ps += p1[r];
  { auto rr = __builtin_amdgcn_permlane32_swap(__float_as_uint(ps), __float_as_uint(ps), false, false);
    ps = __uint_as_float(rr[0]) + __uint_as_float(rr[1]); }
  l_reg = l_reg * alpha + ps;
#define PK4(P, BASE, OUT) do { unsigned a0 = cvtpk(P[BASE + 0], P[BASE + 1]), a1 = cvtpk(P[BASE + 2], P[BASE + 3]);   \
    unsigned b0 = cvtpk(P[BASE + 4], P[BASE + 5]), b1 = cvtpk(P[BASE + 6], P[BASE + 7]);                              \
    auto r0 = __builtin_amdgcn_permlane32_swap(a0, b0, false, false); auto r1 = __builtin_amdgcn_permlane32_swap(a1, b1, false, false); \
    u32x4 w = {r0[0], r1[0], r0[1], r1[1]}; OUT = *reinterpret_cast<bf16x8*>(&w); } while (0)
  PK4(p0, 0, pa0); PK4(p0, 8, pa1); PK4(p1, 0, pa2); PK4(p1, 8, pa3);
#undef PK4
}
__device__ __forceinline__ void qkt(f32x16& p0, f32x16& p1, const bf16* Ks, const bf16x8* qr, int r32, int hi) {
  p0 = f32x16{}; p1 = f32x16{};
  for (int d0 = 0; d0 < 8; ++d0) { int cb = (d0 * 16 + hi * 8) * 2;
    bf16x8 b0 = *reinterpret_cast<const bf16x8*>((const char*)Ks + KSWZ(r32, cb));
    bf16x8 b1 = *reinterpret_cast<const bf16x8*>((const char*)Ks + KSWZ(32 + r32, cb));
    p0 = __builtin_amdgcn_mfma_f32_32x32x16_bf16(b0, qr[d0], p0, 0, 0, 0);
    p1 = __builtin_amdgcn_mfma_f32_32x32x16_bf16(b1, qr[d0], p1, 0, 0, 0); }
}
__device__ __forceinline__ int v_st(int k, int c) { const int kk = (k & ~0xC) | ((k & 4) << 1) | ((k & 8) >> 1); return ((kk >> 3) * 4 + (c >> 5)) * 512 + ((kk & 7) * 32 + (c & 31)) * 2; }
__device__ __forceinline__ int v_rd_base(int lane) { return ((lane & 3) << 3) | (((lane >> 2) & 3) << 6) | (((lane >> 4) & 1) << 5) | (((lane >> 5) & 1) << 8); }
constexpr int v_rd_off(int d0, int ks, int half) { return d0 * 512 + ks * 4096 + half * 2048; }
template <int OFF> __device__ __forceinline__ s16x4 tr_read(int vb) {
  s16x4 r; asm volatile("ds_read_b64_tr_b16 %0, %1 offset:%2" : "=&v"(r) : "v"(vb), "i"(OFF) : "memory"); return r;
}
template <int D0> __device__ __forceinline__ void pv_one(f32x16& od, int vb, bf16x8 pa0, bf16x8 pa1, bf16x8 pa2, bf16x8 pa3) {
  const s16x4 l0 = tr_read<v_rd_off(D0, 0, 0)>(vb), h0 = tr_read<v_rd_off(D0, 0, 1)>(vb), l1 = tr_read<v_rd_off(D0, 1, 0)>(vb), h1 = tr_read<v_rd_off(D0, 1, 1)>(vb);
  const s16x4 l2 = tr_read<v_rd_off(D0, 2, 0)>(vb), h2 = tr_read<v_rd_off(D0, 2, 1)>(vb), l3 = tr_read<v_rd_off(D0, 3, 0)>(vb), h3 = tr_read<v_rd_off(D0, 3, 1)>(vb);
  asm volatile("s_waitcnt lgkmcnt(0)" ::: "memory"); SBAR();
#define PK(L, H) (bf16x8){L[0], L[1], L[2], L[3], H[0], H[1], H[2], H[3]}
  od = __builtin_amdgcn_mfma_f32_32x32x16_bf16(pa0, PK(l0, h0), od, 0, 0, 0);
  od = __builtin_amdgcn_mfma_f32_32x32x16_bf16(pa1, PK(l1, h1), od, 0, 0, 0);
  od = __builtin_amdgcn_mfma_f32_32x32x16_bf16(pa2, PK(l2, h2), od, 0, 0, 0);
  od = __builtin_amdgcn_mfma_f32_32x32x16_bf16(pa3, PK(l3, h3), od, 0, 0, 0);
#undef PK
}
__device__ __forceinline__ void pv_d0(f32x16* o, int vb, bf16x8 pa0, bf16x8 pa1, bf16x8 pa2, bf16x8 pa3) {
  pv_one<0>(o[0], vb, pa0, pa1, pa2, pa3); pv_one<1>(o[1], vb, pa0, pa1, pa2, pa3); pv_one<2>(o[2], vb, pa0, pa1, pa2, pa3); pv_one<3>(o[3], vb, pa0, pa1, pa2, pa3);
}
__device__ __forceinline__ void attn_unit(const bf16* __restrict__ Qb, const bf16* __restrict__ Kh, const bf16* __restrict__ Vh, bf16* __restrict__ Ob, int seq, char* lds, int wave_s,
                                          const float* __restrict__ qg, const float* __restrict__ rope, int t0) {
  constexpr int SDEPTH = 2;
  int tid_ = wave_s * 64 + lane_id(); asm volatile("" : "+v"(tid_));
  const int tid = tid_, wid = tid >> 6, lane = tid & 63, r32 = lane & 31, hi = lane >> 5;
  bf16* V_lds = (bf16*)lds; bf16* K_lds = (bf16*)(lds + 2 * SHM_V);
  float* ws = (float*)(lds + 2 * SHM_V + 2 * SHM_K) + wid * 64; float* li_l = ws; float* al_l = ws + 32;
  float m_reg = -1e30f, l_reg = 0; f32x16 o[4] = {}; bf16x8 qr[8];
  const bf16* Qw = Qb + (long)(wid * QBLK + r32) * LDQ + hi * 8;
  {
    float qf[8][8]; float ss = 0.f;
#pragma unroll
    for (int d0 = 0; d0 < 8; ++d0) { const bf16x8 raw = ld8(Qw + d0 * 16);
#pragma unroll
      for (int e = 0; e < 8; ++e) { qf[d0][e] = __uint_as_float(((unsigned)(unsigned short)raw[e]) << 16); ss += qf[d0][e] * qf[d0][e]; } }
    ss += __shfl_xor(ss, 32);
    const float rr = 1.0f / sqrtf(ss * (1.0f / 128.0f) + 1e-6f);
#pragma unroll
    for (int d0 = 0; d0 < 8; ++d0) { const float* gp = qg + d0 * 16 + hi * 8;
#pragma unroll
      for (int e = 0; e < 8; ++e) qf[d0][e] = qf[d0][e] * rr * gp[e]; }
    if (rope != nullptr) {
      const int t = t0 + wid * QBLK + r32, rowc = t >> 6, colc = t & 63;
#pragma unroll
      for (int pr = 0; pr < 4; ++pr) { const int d0 = (pr & 1) + (pr >> 1) * 4;
        const float* cs = rope + ((pr >> 1) ? colc : rowc) * 32 + (d0 & 1) * 16 + hi * 8; const float* sn = cs + 2048;
#pragma unroll
        for (int e = 0; e < 8; ++e) { const float c = cs[e], s = sn[e], x1 = qf[d0][e], x2 = qf[d0 + 2][e]; qf[d0][e] = x1 * c - x2 * s; qf[d0 + 2][e] = x1 * s + x2 * c; } }
    }
#pragma unroll
    for (int d0 = 0; d0 < 8; ++d0) { u32x4 w = {cvtpk(qf[d0][0], qf[d0][1]), cvtpk(qf[d0][2], qf[d0][3]), cvtpk(qf[d0][4], qf[d0][5]), cvtpk(qf[d0][6], qf[d0][7])}; qr[d0] = *reinterpret_cast<bf16x8*>(&w); }
  }
  const int sr = tid >> 4, sc = (tid & 15) * 8, vst0 = v_st(sr, sc), vst1 = v_st(32 + sr, sc);
  const int vb0 = (int)(uintptr_t)V_lds + v_rd_base(lane);
  struct { bf16x8 vs0, vs1, ks0, ks1; } sr_[SDEPTH];
#define SLOAD(i, k0) do { sr_[i].vs0 = ld8(&Vh[(long)((k0) + sr) * LDK + sc]); sr_[i].vs1 = ld8(&Vh[(long)((k0) + 32 + sr) * LDK + sc]); \
    sr_[i].ks0 = ld8(&Kh[(long)((k0) + sr) * LDK + sc]); sr_[i].ks1 = ld8(&Kh[(long)((k0) + 32 + sr) * LDK + sc]); } while (0)
#define SWRITE(b, i) do { *(bf16x8*)((char*)V_lds + (b) * SHM_V + vst0) = sr_[i].vs0;          \
    *(bf16x8*)((char*)V_lds + (b) * SHM_V + vst1) = sr_[i].vs1; int kc = sc * 2;               \
    *(bf16x8*)((char*)K_lds + (b) * SHM_K + KSWZ(sr, kc)) = sr_[i].ks0;                       \
    *(bf16x8*)((char*)K_lds + (b) * SHM_K + KSWZ(32 + sr, kc)) = sr_[i].ks1; } while (0)
#define SWAIT() asm volatile("s_waitcnt vmcnt(4)" ::: "memory")
#define RESC(a) do { if (__any((a) < 1.f)) { if (hi == 0) al_l[r32] = (a); asm volatile("s_waitcnt lgkmcnt(0)" ::: "memory"); \
    for (int d = 0; d < 4; ++d) for (int r = 0; r < 16; ++r) o[d][r] *= al_l[crow(r, hi)]; } } while (0)
  f32x16 pA0, pA1, pB0, pB1; float mnA, mnB, alA, alB; bf16x8 pa0, pa1, pa2, pa3; const int NT = seq / KVBLK;
  constexpr int SE = 0, SO = SDEPTH - 1;
  SLOAD(SE, 0); asm volatile("s_waitcnt vmcnt(0)" ::: "memory"); SWRITE(0, SE); __syncthreads();
  qkt(pA0, pA1, K_lds, qr, r32, hi); partialSM(pA0, pA1, m_reg, mnA, alA);
  SLOAD(SO, KVBLK); if (2 < NT) SLOAD(SE, 2 * KVBLK);
  SWAIT(); SWRITE(1, SO); __syncthreads();
  for (int j = 1; j + 1 < NT; j += 2) {
    SBAR(); qkt(pB0, pB1, (bf16*)((char*)K_lds + SHM_K), qr, r32, hi);
    finishSM(pA0, pA1, alA, l_reg, pa0, pa1, pa2, pa3); SBAR();
    SLOAD(SO, (j + SDEPTH) * KVBLK); SBAR();
    pv_d0(o, vb0, pa0, pa1, pa2, pa3); partialSM(pB0, pB1, m_reg, mnB, alB);
    __syncthreads(); SWAIT(); SWRITE(0, SE);
    RESC(alB); __syncthreads();
    SBAR(); qkt(pA0, pA1, K_lds, qr, r32, hi);
    finishSM(pB0, pB1, alB, l_reg, pa0, pa1, pa2, pa3); SBAR();
    if (j + 3 < NT) SLOAD(SE, (j + 1 + SDEPTH) * KVBLK); SBAR();
    pv_d0(o, vb0 + (int)SHM_V, pa0, pa1, pa2, pa3); partialSM(pA0, pA1, m_reg, mnA, alA);
    __syncthreads(); SWAIT(); SWRITE(1, SO);
    RESC(alA); __syncthreads();
  }
  SBAR(); qkt(pB0, pB1, (bf16*)((char*)K_lds + SHM_K), qr, r32, hi);
  finishSM(pA0, pA1, alA, l_reg, pa0, pa1, pa2, pa3); SBAR();
  pv_d0(o, vb0, pa0, pa1, pa2, pa3); partialSM(pB0, pB1, m_reg, mnB, alB);
  __syncthreads(); RESC(alB);
  finishSM(pB0, pB1, alB, l_reg, pa0, pa1, pa2, pa3); SBAR();
  pv_d0(o, vb0 + (int)SHM_V, pa0, pa1, pa2, pa3);
  if (hi == 0) li_l[r32] = l_reg; asm volatile("s_waitcnt lgkmcnt(0)" ::: "memory");
  float rli[16];
#pragma unroll
  for (int r = 0; r < 16; ++r) rli[r] = __builtin_amdgcn_rcpf(li_l[crow(r, hi)]);
  bf16* Ow = Ob + (long)(wid * QBLK) * LDO;
#pragma unroll
  for (int r = 0; r < 16; ++r) { int orow = crow(r, hi);
    for (int d0 = 0; d0 < 4; ++d0) { const float v = o[d0][r] * rli[r]; unsigned u = __float_as_uint(v); u = (u + 0x7fffu + ((u >> 16) & 1u)) >> 16;
      Ow[(long)orow * LDO + d0 * 32 + r32] = (bf16)u; } }
  __syncthreads();
#undef SLOAD
#undef SWRITE
#undef SWAIT
#undef RESC
}
#undef KSWZ
#undef SBAR
}
constexpr int DM = 2048, NB = 8, SEQ = 4096, CTXL = 256, DEPTH = 4;
constexpr int TPB = SEQ + CTXL;
constexpr int M = NB * TPB;
constexpr int ZW = 3584, FF = 5632, NMOD = 6 * DM;
constexpr int CONVW = 512, SSMW = 512, ATTW = 1024, NG = 32, NP = 64, NSG = 16;
constexpr int Z_CV = 0, Z_CB = 512, Z_CC = 1024, Z_SSM = 1536, Z_Q = 2048, Z_K = 3072, Z_V = 3328;
constexpr int MIX_CONV = 0, MIX_SSM = 512, MIX_ATT = 1024;
constexpr float RMS_EPS = 1e-6f;
constexpr int NWAVES = 8;
#ifndef REP_MASK
#define REP_MASK 0
#endif
#define NREP(b) (1 + ((REP_MASK >> (b)) & 1))

constexpr size_t MiB = 1u << 20;
constexpr size_t WS_CTL = 0, CTL_ZERO_BYTES = 1 * MiB;
constexpr size_t WS_MODP = 1 * MiB;
constexpr size_t WS_MOD  = 15 * MiB;
constexpr size_t WS_ROPE = 17 * MiB;
constexpr size_t WS_BBAR = 18 * MiB;
constexpr size_t WS_POW  = 20 * MiB;
constexpr size_t WS_KT   = 25 * MiB;
constexpr size_t WS_W    = 33 * MiB, W_LAYER = 89 * MiB;
constexpr size_t W_IN = 0, W_OUT = 14 * MiB, W_GU = 22 * MiB, W_DOWN = 66 * MiB, W_GLU = 88 * MiB;
constexpr size_t WS_TW   = WS_W + 4 * W_LAYER;
constexpr size_t WS_W1   = WS_TW + 96 * MiB;
constexpr size_t WS_X    = WS_W1 + 32 * MiB;
constexpr size_t WS_H    = WS_X + 272 * MiB;
constexpr size_t WS_Y    = WS_H + 136 * MiB;
constexpr size_t WS_UH   = WS_Y, WS_SB = WS_Y + 60 * MiB;
constexpr size_t WS_Z    = WS_Y + 136 * MiB;
constexpr size_t WS_MIX  = WS_Z + 238 * MiB;
constexpr size_t WS_ACT  = WS_Z;
constexpr size_t WS_G    = WS_MIX + 136 * MiB;
constexpr size_t WS_YP   = WS_G + 34 * MiB;
constexpr size_t WS_END  = WS_YP + 64 * MiB;
static_assert((size_t)M * DM * 4 == 272 * MiB && (size_t)M * ZW * 2 == 238 * MiB && (size_t)M * FF * 2 == 374 * MiB && (size_t)32 * SSM_RPG * UH_LD * 2 == 60 * MiB && (size_t)32 * SSM_RPG * 256 * 4 == 40 * MiB, "ws map");
static_assert(WS_END <= 1536 * MiB, "ws budget");
constexpr int CW_BAR = 4096;

constexpr int RING_OFF = 0, RING_BYTES = 131072;
constexpr int LDSCTL_OFF = RING_BYTES, MISC_OFF = LDSCTL_OFF + 320;
constexpr int LDS_BYTES = 147456;

#define GAS __attribute__((address_space(1)))
#define LAS __attribute__((address_space(3)))
typedef unsigned short bf16;
typedef unsigned v4u __attribute__((ext_vector_type(4)));
typedef unsigned v2u __attribute__((ext_vector_type(2)));
typedef float f32x4 __attribute__((ext_vector_type(4)));
typedef float f32x2 __attribute__((ext_vector_type(2)));
#define LDS_WAIT() asm volatile("s_waitcnt lgkmcnt(0)" ::: "memory")
#define VM_WAIT() asm volatile("s_waitcnt vmcnt(0)" ::: "memory")
__device__ __forceinline__ unsigned f2bf(float f) { unsigned u = __builtin_bit_cast(unsigned, f); return (u + 0x7fffu + ((u >> 16) & 1u)) >> 16; }
__device__ __forceinline__ unsigned pk2(float lo, float hi) { return f2bf(lo) | (f2bf(hi) << 16); }
__device__ __forceinline__ float blo(unsigned w) { return __uint_as_float(w << 16); }
__device__ __forceinline__ float bhi(unsigned w) { return __uint_as_float(w & 0xffff0000u); }
__device__ __forceinline__ float wave_sum(float v) {
#pragma unroll
    for (int o = 1; o < 64; o <<= 1) v += __shfl_xor(v, o);
    return v;
}

#define XB_TMO      128
#define XB_XCNT(j)  (256  + 64 * (j))
#define XB_XSUB(j)  (1280 + 64 * (j))
#define XB_XGEN(j)  (2304 + 64 * (j))
#define XB_TOP      3328
#define XB_TOPGEN   3392
#define XCD_BAR_WORDS 3456
#define XB_SPIN_CAP (1u << 18)

__device__ __forceinline__ unsigned xb_ld(unsigned* p)              { return __hip_atomic_load(p, __ATOMIC_RELAXED, __HIP_MEMORY_SCOPE_AGENT); }
__device__ __forceinline__ unsigned xb_add(unsigned* p, unsigned v) { return __hip_atomic_fetch_add(p, v, __ATOMIC_RELAXED, __HIP_MEMORY_SCOPE_AGENT); }
__device__ __forceinline__ unsigned xb_xcc_id() { return (unsigned)__builtin_amdgcn_s_getreg((3 << 11) | 20) & 0xFu; }
#define XB_SPIN(cond, bar) do { unsigned _sp = 0; while (cond) { __builtin_amdgcn_s_sleep(1); \
    if ((++_sp & 255u) == 0u) { if (xb_ld(&(bar)[XB_TMO])) break; if (_sp > XB_SPIN_CAP) { atomicAdd(&(bar)[XB_TMO], 1u); break; } } } } while (0)

struct XcdBarrier {
    unsigned* bar; unsigned x;
    volatile LAS unsigned* st;
};

__device__ __forceinline__ XcdBarrier xcd_barrier_post(unsigned* bar, volatile LAS unsigned* st, bool leader  ) {
    XcdBarrier b; b.bar = bar; b.x = xb_xcc_id(); b.st = st;
    if (leader) (void)xb_add(&bar[XB_XCNT(b.x)], 1u);
    return b;
}
__device__ __forceinline__ void xcd_barrier_complete(unsigned* bar, unsigned x, unsigned& nloc, unsigned& nx) {
    const unsigned G = gridDim.x * gridDim.y * gridDim.z;
    unsigned sum, cnt, mine, sp = 0u;
    for (;;) {
        sum = 0u; cnt = 0u; mine = 0u;
#pragma unroll
        for (unsigned j = 0; j < 16; ++j) { const unsigned c = xb_ld(&bar[XB_XCNT(j)]); sum += c; cnt += (c > 0u) ? 1u : 0u; mine = (j == x) ? c : mine; }
        if (sum == G) break;
        __builtin_amdgcn_s_sleep(1);
        if ((++sp & 255u) == 0u) { if (xb_ld(&bar[XB_TMO])) break; if (sp > XB_SPIN_CAP) { atomicAdd(&bar[XB_TMO], 1u); break; } }
    }
    nloc = mine > 0u ? mine : 1u; nx = cnt > 0u ? cnt : 1u;
}

__device__ __forceinline__ void xcd_barrier(const XcdBarrier& b, bool leader  ) {
    asm volatile("s_waitcnt vmcnt(0)" ::: "memory");
    __syncthreads();
    if (leader) {
        unsigned* bar = b.bar;
        __builtin_amdgcn_s_waitcnt(0);
        unsigned nloc = b.st[0], nx = b.st[1];
        if (nloc == 0u) { xcd_barrier_complete(bar, b.x, nloc, nx); b.st[0] = nloc; b.st[1] = nx; }
        const unsigned old = xb_add(&bar[XB_XSUB(b.x)], 1u);
        const unsigned gen = old / nloc;
        if (old + 1u == (gen + 1u) * nloc) {
            __builtin_amdgcn_fence(__ATOMIC_RELEASE, "agent");
            asm volatile("s_waitcnt vmcnt(0)" ::: "memory");
            const unsigned og = xb_add(&bar[XB_TOP], 1u);
            const unsigned tg = og / nx;
            if (og + 1u == (tg + 1u) * nx) xb_add(&bar[XB_TOPGEN], 1u);
            else XB_SPIN(xb_ld(&bar[XB_TOPGEN]) == tg, bar);
            __builtin_amdgcn_fence(__ATOMIC_ACQUIRE, "agent");
            xb_add(&bar[XB_XGEN(b.x)], 1u);
            asm volatile("s_waitcnt vmcnt(0)" ::: "memory");
        } else {
            XB_SPIN(xb_ld(&bar[XB_XGEN(b.x)]) == gen, bar);
            __builtin_amdgcn_fence(__ATOMIC_ACQUIRE, "agent");
            asm volatile("s_waitcnt vmcnt(0)" ::: "memory");
        }
    }
    __syncthreads();
}

struct Params { const float* in[28]; float* out; unsigned char* ws; int ph_lo, ph_hi; };
typedef const __attribute__((address_space(4))) Params* KP;
__device__ __forceinline__ KP kparams() { KP kp = (KP)__builtin_amdgcn_kernarg_segment_ptr(); asm volatile("" : "+s"(kp)); return kp; }
enum { I_X = 0, I_C, I_CTX, I_CCTX, I_WMOD, I_BMOD, I_GPREMIX, I_GPOSTMIX, I_GPREFFN, I_GPOSTFFN, I_WIN, I_CONVW, I_LAMRE, I_LAMIM, I_LOGDT, I_BRE, I_BIM, I_CRE, I_CIM,
       I_SSMD, I_WGLU, I_BGLU, I_QNORM, I_KNORM, I_WOUT, I_WGATE, I_WUP, I_WDOWN };

__device__ __forceinline__ void transpose_item(const float* __restrict__ W, int K, int N, bf16* WT, int k0, int n0, int dst_row0, LAS float* scr, int lane) {
#pragma unroll 8
    for (int i = 0; i < 32; ++i) { const int kk = 2 * i + (lane >> 5); scr[kk * 33 + (lane & 31)] = W[(size_t)(k0 + kk) * N + n0 + (lane & 31)]; }
    LDS_WAIT(); asm volatile("" ::: "memory");
    const int c = lane & 7;
#pragma unroll
    for (int j = 0; j < 4; ++j) { const int n = (lane >> 3) + 8 * j; const LAS float* s = scr + (8 * c) * 33 + n;
        v4u o; o.x = pk2(s[0 * 33], s[1 * 33]); o.y = pk2(s[2 * 33], s[3 * 33]); o.z = pk2(s[4 * 33], s[5 * 33]); o.w = pk2(s[6 * 33], s[7 * 33]);
        *(GAS v4u*)(WT + (size_t)(dst_row0 + n) * K + k0 + 8 * c) = o; }
    LDS_WAIT(); asm volatile("" ::: "memory");
}
constexpr int IT_MOD = DEPTH * 8 * 48;
constexpr int IT_ROPE = 32, IT_SSM = 256;
constexpr int TPL_IN = 32 * 112, TPL_OUT = 32 * 64, TPL_G = 32 * 176, TPL_D = 88 * 64, TPL_GLU = 8 * 16;
constexpr int TPL = TPL_IN + TPL_OUT + 2 * TPL_G + TPL_D + TPL_GLU;
constexpr int IT_TOTAL = IT_MOD + IT_ROPE + IT_SSM + DEPTH * TPL;

__device__ __forceinline__ void prologue_a(KP P, LAS unsigned char* lds, int wave, int lane) {
    LAS float* scr = (LAS float*)(lds + RING_OFF + wave * 16384);
    const int G = gridDim.x, gw = wave * G + (int)blockIdx.x, NGW = NWAVES * G;
    unsigned char* ws = P->ws;
    for (int it = gw; it < IT_TOTAL; it += NGW) {
        int r = it;
        if (r < IT_MOD) {
            const int l = r / 384, kc = (r % 384) / 48, nc = r % 48;
#pragma unroll
            for (int j = 0; j < 9; ++j)
#pragma unroll
                for (int q = 0; q < 4; ++q) { const int kk = q * 64 + lane, k = kc * 256 + kk;
                    const float cv = (j < 8) ? P->in[I_C][j * DM + k] : P->in[I_CCTX][k];
                    scr[j * 256 + kk] = cv / (1.0f + __expf(-cv)); }
            LDS_WAIT(); asm volatile("" ::: "memory");
            f32x4 acc[9];
#pragma unroll
            for (int j = 0; j < 9; ++j) acc[j] = (f32x4){0.f, 0.f, 0.f, 0.f};
            const float* wp = P->in[I_WMOD] + ((size_t)l * DM + kc * 256) * NMOD + nc * 256 + lane * 4;
#pragma unroll 4
            for (int kk = 0; kk < 256; ++kk) { const f32x4 w = *(const f32x4*)(wp + (size_t)kk * NMOD);
#pragma unroll
                for (int j = 0; j < 9; ++j) { const float s = scr[j * 256 + kk]; acc[j] += w * s; } }
            float* mp = (float*)(ws + WS_MODP) + ((size_t)(kc * DEPTH + l) * 9) * NMOD + nc * 256 + lane * 4;
#pragma unroll
            for (int j = 0; j < 9; ++j) *(f32x4*)(mp + (size_t)j * NMOD) = acc[j];
            LDS_WAIT(); asm volatile("" ::: "memory");
            continue;
        }
        r -= IT_MOD;
        if (r < IT_ROPE) {
            const int e = r * 64 + lane, coord = e >> 5, i = e & 31;
            const double inv = exp(-(double)i * (9.210340371976184 / 32.0));
            const double ang = (double)coord * inv;
            float* rp = (float*)(ws + WS_ROPE);
            rp[e] = (float)cos(ang); rp[2048 + e] = (float)sin(ang);
            continue;
        }
        r -= IT_ROPE;
        if (r < IT_SSM) {
            const int idx = r * 64 + lane;
            const int p = idx & 63, ldg = idx >> 6;
            const double lre = (double)P->in[I_LAMRE][idx], lim = (double)P->in[I_LAMIM][idx];
            const double dt = exp((double)P->in[I_LOGDT][ldg]);
            const double ea = exp(lre * dt), th = lim * dt;
            const double lbre = ea * cos(th), lbim = ea * sin(th);
            const double nr = lbre - 1.0, ni = lbim, dd = lre * lre + lim * lim;
            const double qre = (nr * lre + ni * lim) / dd, qim = (ni * lre - nr * lim) / dd;
            f32x2* bb = (f32x2*)(ws + WS_BBAR) + (size_t)idx * 16;
#pragma unroll
            for (int n = 0; n < 16; ++n) {
                const double bre = (double)P->in[I_BRE][(size_t)idx * 16 + n], bim = (double)P->in[I_BIM][(size_t)idx * 16 + n];
                bb[n] = (f32x2){(float)(qre * bre - qim * bim), (float)(qre * bim + qim * bre)};
            }
            f32x2* pw = (f32x2*)(ws + WS_POW) + (size_t)ldg * 33 * 64 + p;
            for (int e = 0; e <= 32; ++e) { const double m = exp(lre * dt * (double)e), a = th * (double)e; pw[e * 64] = (f32x2){(float)(m * cos(a)), (float)(m * sin(a))}; }
            continue;
        }
        r -= IT_SSM;
        const int l = r / TPL; r -= l * TPL;
        bf16* wl = (bf16*)(ws + WS_W + (size_t)l * W_LAYER);
        if (r < TPL_IN) { const int kb = r / 112, nb = r % 112; transpose_item(P->in[I_WIN] + (size_t)l * DM * ZW, DM, ZW, (bf16*)((unsigned char*)wl + W_IN), 64 * kb, 32 * nb, 32 * nb, scr, lane); continue; }
        r -= TPL_IN;
        if (r < TPL_OUT) { const int kb = r / 64, nb = r % 64; transpose_item(P->in[I_WOUT] + (size_t)l * DM * DM, DM, DM, (bf16*)((unsigned char*)wl + W_OUT), 64 * kb, 32 * nb, 32 * nb, scr, lane); continue; }
        r -= TPL_OUT;
        if (r < 2 * TPL_G) { const int up = r >= TPL_G; if (up) r -= TPL_G; const int kb = r / 176, nb = r % 176, n0 = 32 * nb;
            transpose_item(P->in[up ? I_WUP : I_WGATE] + (size_t)l * DM * FF, DM, FF, (bf16*)((unsigned char*)wl + W_GU), 64 * kb, n0, (n0 >> 7) * 256 + (n0 & 127) + (up ? 128 : 0), scr, lane); continue; }
        r -= 2 * TPL_G;
        if (r < TPL_D) { const int kb = r / 64, nb = r % 64; transpose_item(P->in[I_WDOWN] + (size_t)l * FF * DM, FF, DM, (bf16*)((unsigned char*)wl + W_DOWN), 64 * kb, 32 * nb, 32 * nb, scr, lane); continue; }
        r -= TPL_D;
        { const int kb = r / 16, nb = r % 16; transpose_item(P->in[I_WGLU] + (size_t)l * 512 * 512, 512, 512, (bf16*)((unsigned char*)wl + W_GLU), 64 * kb, 32 * nb, 32 * nb, scr, lane); }
    }
}
__device__ __forceinline__ void prologue_b(KP P, int tid) {
    const int total = DEPTH * 9 * NMOD;
    const float* mp = (const float*)(P->ws + WS_MODP); float* mo = (float*)(P->ws + WS_MOD);
    for (int idx = (int)blockIdx.x * 512 + tid; idx < total; idx += (int)gridDim.x * 512) {
        const int l = idx / (9 * NMOD), n = idx % NMOD;
        float s = P->in[I_BMOD][l * NMOD + n];
#pragma unroll
        for (int kc = 0; kc < 8; ++kc) s += mp[(size_t)kc * total + idx];
        const int ch = n / DM, col = n - ch * DM;
        if (ch == 1) s = P->in[I_GPREMIX][l * DM + col] * (1.0f + s);
        else if (ch == 2) s = s * P->in[I_GPOSTMIX][l * DM + col];
        else if (ch == 4) s = P->in[I_GPREFFN][l * DM + col] * (1.0f + s);
        else if (ch == 5) s = s * P->in[I_GPOSTFFN][l * DM + col];
        mo[idx] = s;
    }
}

__device__ __forceinline__ void prologue_kt(KP P, int tid) {
    const f32x2* pw = (const f32x2*)(P->ws + WS_POW); const f32x2* bbar = (const f32x2*)(P->ws + WS_BBAR); float* kt = (float*)(P->ws + WS_KT);
    for (int idx = (int)blockIdx.x * 512 + tid; idx < DEPTH * 32 * 2 * 32 * 16; idx += (int)gridDim.x * 512) {
        const int no = idx & 15, tau = (idx >> 4) & 31, dir = (idx >> 9) & 1, g = (idx >> 10) & 31, l = idx >> 15;
        const int ldg = (l * 2 + dir) * 32 + g;
        float acc[16];
#pragma unroll
        for (int n = 0; n < 16; ++n) acc[n] = 0.f;
        for (int p = 0; p < 64; ++p) {
            const float cre = P->in[I_CRE][((size_t)ldg * 16 + no) * 64 + p], cim = P->in[I_CIM][((size_t)ldg * 16 + no) * 64 + p];
            const f32x2 w = pw[((size_t)ldg * 33 + tau) * 64 + p];
            const float are = cre * w[0] - cim * w[1], aim = cre * w[1] + cim * w[0];
            const f32x4* bp = (const f32x4*)(bbar + ((size_t)ldg * 64 + p) * 16);
#pragma unroll
            for (int q = 0; q < 8; ++q) { const f32x4 b2 = bp[q]; acc[2 * q] += are * b2[0] - aim * b2[1]; acc[2 * q + 1] += are * b2[2] - aim * b2[3]; }
        }
#pragma unroll
        for (int q = 0; q < 4; ++q) *(f32x4*)(kt + (size_t)idx * 16 + q * 4) = (f32x4){acc[q * 4], acc[q * 4 + 1], acc[q * 4 + 2], acc[q * 4 + 3]};
    }
}
__device__ __forceinline__ void prologue_s5w(KP P, int tid) {
    const f32x2* pw = (const f32x2*)(P->ws + WS_POW); const f32x2* bbar = (const f32x2*)(P->ws + WS_BBAR); const float* kt = (const float*)(P->ws + WS_KT);
    bf16* TW = (bf16*)(P->ws + WS_TW); bf16* W1 = (bf16*)(P->ws + WS_W1);
    for (int it = (int)blockIdx.x * 512 + tid; it < DEPTH * 32 * 65536; it += (int)gridDim.x * 512) {
        const int lg = it >> 16, l = lg >> 5, g = lg & 31; int r = it & 65535; float v[8];
        if (r < 49152) {
            const int row = r / 96, ch = r - row * 96, t = row >> 4, no = row & 15, k0 = ch * 8;
            if (k0 < 512) {
                const int s = k0 >> 4, ni0 = k0 & 15;
#pragma unroll
                for (int e = 0; e < 8; ++e) v[e] = 0.f;
                if (t >= s) { const float* kp = kt + ((((size_t)(l * 32 + g) * 2 + 0) * 32 + (t - s)) * 16 + no) * 16 + ni0;
#pragma unroll
                    for (int e = 0; e < 8; ++e) v[e] += kp[e]; }
                if (s >= t) { const float* kp = kt + ((((size_t)(l * 32 + g) * 2 + 1) * 32 + (s - t)) * 16 + no) * 16 + ni0;
#pragma unroll
                    for (int e = 0; e < 8; ++e) v[e] += kp[e]; }
                if (t == s) { const float dv = P->in[I_SSMD][l * SSMW + g * NSG + no];
#pragma unroll
                    for (int e = 0; e < 8; ++e) if (ni0 + e == no) v[e] += dv; }
            } else {
                const int kk = k0 - 512, dir = kk >> 7, part = (kk >> 6) & 1, p0 = kk & 63, ep = dir == 0 ? t + 1 : 32 - t, ldg = (l * 2 + dir) * 32 + g;
#pragma unroll
                for (int e = 0; e < 8; ++e) { const int p = p0 + e; const f32x2 w = pw[((size_t)ldg * 33 + ep) * 64 + p];
                    const float cre = P->in[I_CRE][((size_t)ldg * 16 + no) * 64 + p], cim = P->in[I_CIM][((size_t)ldg * 16 + no) * 64 + p];
                    v[e] = part == 0 ? (cre * w[0] - cim * w[1]) : -(cre * w[1] + cim * w[0]); }
            }
            v4u o; o.x = pk2(v[0], v[1]); o.y = pk2(v[2], v[3]); o.z = pk2(v[4], v[5]); o.w = pk2(v[6], v[7]);
            *(v4u*)(TW + ((size_t)lg * 512 + row) * 768 + k0) = o;
        } else {
            r -= 49152;
            const int r1 = r >> 6, ch = r & 63, dir = r1 >> 7, part = (r1 >> 6) & 1, p = r1 & 63, k0 = ch * 8, s = k0 >> 4, n0 = k0 & 15, ep = dir == 0 ? 31 - s : s, ldg = (l * 2 + dir) * 32 + g;
            const f32x2 w = pw[((size_t)ldg * 33 + ep) * 64 + p]; const f32x2* bp = bbar + ((size_t)ldg * 64 + p) * 16 + n0;
#pragma unroll
            for (int e = 0; e < 8; ++e) { const f32x2 b2 = bp[e]; v[e] = part == 0 ? (w[0] * b2[0] - w[1] * b2[1]) : (w[0] * b2[1] + w[1] * b2[0]); }
            v4u o; o.x = pk2(v[0], v[1]); o.y = pk2(v[2], v[3]); o.z = pk2(v[4], v[5]); o.w = pk2(v[6], v[7]);
            *(v4u*)(W1 + ((size_t)lg * 256 + r1) * 512 + k0) = o;
        }
    }
}

struct Thin {
    int init, fin;
    const float* x_lat; const float* x_ctx; const bf16* X; bf16* Xout; const bf16* Y; bf16* H; float* OUT;
    const float* modg; int gc;
    const float* mods; int sc;
    const float* YP; int ctx_mode;
};
__device__ __forceinline__ void thin_rows(const Thin& T, int wave, int lane) {
    const int G = gridDim.x;
    for (int r = (int)blockIdx.x * NWAVES + wave; r < M; r += G * NWAVES) {
        const int b = r / TPB, p = r - b * TPB, j = (p < CTXL) ? 8 : b;
        if ((T.fin || T.ctx_mode == 0) && p < CTXL) continue;
        float x[32], y[32];
        f32x4 ga[8], mu[8], sh[8];
        const float* gate = T.init ? nullptr : T.modg + (size_t)(j * 6 + T.gc) * DM;
        const float* shift = T.mods + (size_t)(j * 6 + T.sc) * DM; const float* mul = shift + DM;
        if (T.init) {
            const float* xsrc = (p < CTXL) ? T.x_ctx + ((size_t)b * CTXL + p) * DM : T.x_lat + ((size_t)b * SEQ + (p - CTXL)) * DM;
#pragma unroll
            for (int c = 0; c < 4; ++c) { const f32x4 a = *(const f32x4*)(xsrc + c * 512 + lane * 8), d = *(const f32x4*)(xsrc + c * 512 + lane * 8 + 4);
                x[c * 8 + 0] = a[0]; x[c * 8 + 1] = a[1]; x[c * 8 + 2] = a[2]; x[c * 8 + 3] = a[3]; x[c * 8 + 4] = d[0]; x[c * 8 + 5] = d[1]; x[c * 8 + 6] = d[2]; x[c * 8 + 7] = d[3]; }
        } else {
            v4u xw[4], yw[4];
#pragma unroll
            for (int c = 0; c < 4; ++c) xw[c] = *(const v4u*)(T.X + (size_t)r * DM + c * 512 + lane * 8);
            if (p < CTXL && T.ctx_mode == 2) {
#pragma unroll
                for (int e = 0; e < 32; ++e) y[e] = 0.f;
#pragma unroll
                for (int q = 0; q < 4; ++q) { const float* yp = T.YP + ((size_t)q * 2048 + b * CTXL + p) * DM;
#pragma unroll
                    for (int c = 0; c < 4; ++c) { const f32x4 a = *(const f32x4*)(yp + c * 512 + lane * 8), d = *(const f32x4*)(yp + c * 512 + lane * 8 + 4);
                        y[c * 8 + 0] += a[0]; y[c * 8 + 1] += a[1]; y[c * 8 + 2] += a[2]; y[c * 8 + 3] += a[3]; y[c * 8 + 4] += d[0]; y[c * 8 + 5] += d[1]; y[c * 8 + 6] += d[2]; y[c * 8 + 7] += d[3]; } }
            } else {
#pragma unroll
                for (int c = 0; c < 4; ++c) yw[c] = *(const v4u*)(T.Y + (size_t)r * DM + c * 512 + lane * 8);
#pragma unroll
                for (int c = 0; c < 4; ++c) { const v4u w = yw[c];
                    y[c * 8 + 0] = blo(w.x); y[c * 8 + 1] = bhi(w.x); y[c * 8 + 2] = blo(w.y); y[c * 8 + 3] = bhi(w.y); y[c * 8 + 4] = blo(w.z); y[c * 8 + 5] = bhi(w.z); y[c * 8 + 6] = blo(w.w); y[c * 8 + 7] = bhi(w.w); }
            }
#pragma unroll
            for (int c = 0; c < 4; ++c) { ga[2 * c] = *(const f32x4*)(gate + c * 512 + lane * 8); ga[2 * c + 1] = *(const f32x4*)(gate + c * 512 + lane * 8 + 4); }
#pragma unroll
            for (int c = 0; c < 4; ++c) { const v4u w = xw[c];
                x[c * 8 + 0] = blo(w.x); x[c * 8 + 1] = bhi(w.x); x[c * 8 + 2] = blo(w.y); x[c * 8 + 3] = bhi(w.y); x[c * 8 + 4] = blo(w.z); x[c * 8 + 5] = bhi(w.z); x[c * 8 + 6] = blo(w.w); x[c * 8 + 7] = bhi(w.w); }
        }
        if (!T.fin) {
#pragma unroll
            for (int c = 0; c < 4; ++c) { mu[2 * c] = *(const f32x4*)(mul + c * 512 + lane * 8); mu[2 * c + 1] = *(const f32x4*)(mul + c * 512 + lane * 8 + 4);
                sh[2 * c] = *(const f32x4*)(shift + c * 512 + lane * 8); sh[2 * c + 1] = *(const f32x4*)(shift + c * 512 + lane * 8 + 4); }
        }
        if (!T.init) {
            float ss = 0.f;
#pragma unroll
            for (int e = 0; e < 32; ++e) ss += y[e] * y[e];
            ss = wave_sum(ss);
            const float r1 = 1.0f / sqrtf(ss * (1.0f / DM) + RMS_EPS);
#pragma unroll
            for (int e = 0; e < 32; ++e) x[e] += ga[e >> 2][e & 3] * (y[e] * r1);
        }
        if (T.fin) {
            float* o = T.OUT + ((size_t)b * SEQ + (p - CTXL)) * DM;
#pragma unroll
            for (int c = 0; c < 4; ++c) { *(f32x4*)(o + c * 512 + lane * 8) = (f32x4){x[c * 8 + 0], x[c * 8 + 1], x[c * 8 + 2], x[c * 8 + 3]}; *(f32x4*)(o + c * 512 + lane * 8 + 4) = (f32x4){x[c * 8 + 4], x[c * 8 + 5], x[c * 8 + 6], x[c * 8 + 7]}; }
            continue;
        }
        float ss2 = 0.f;
#pragma unroll
        for (int e = 0; e < 32; ++e) ss2 += x[e] * x[e];
        ss2 = wave_sum(ss2);
        const float r2 = 1.0f / sqrtf(ss2 * (1.0f / DM) + RMS_EPS);
        bf16* xo = T.Xout + (size_t)r * DM; bf16* ho = T.H + (size_t)r * DM;
#pragma unroll
        for (int c = 0; c < 4; ++c) {
            v4u w; w.x = pk2(x[c * 8 + 0], x[c * 8 + 1]); w.y = pk2(x[c * 8 + 2], x[c * 8 + 3]); w.z = pk2(x[c * 8 + 4], x[c * 8 + 5]); w.w = pk2(x[c * 8 + 6], x[c * 8 + 7]); *(v4u*)(xo + c * 512 + lane * 8) = w;
            float hv[8];
#pragma unroll
            for (int e = 0; e < 8; ++e) hv[e] = (x[c * 8 + e] * r2) * mu[2 * c + (e >> 2)][e & 3] + sh[2 * c + (e >> 2)][e & 3];
            v4u hw; hw.x = pk2(hv[0], hv[1]); hw.y = pk2(hv[2], hv[3]); hw.z = pk2(hv[4], hv[5]); hw.w = pk2(hv[6], hv[7]); *(v4u*)(ho + c * 512 + lane * 8) = hw; }
    }
}
__device__ __forceinline__ void unpack8(const v4u w, float* f) { f[0] = blo(w.x); f[1] = bhi(w.x); f[2] = blo(w.y); f[3] = bhi(w.y); f[4] = blo(w.z); f[5] = bhi(w.z); f[6] = blo(w.w); f[7] = bhi(w.w); }
__device__ __forceinline__ void prep_row(KP P, int l, int r, int lane) {
    bf16* Z = (bf16*)(P->ws + WS_Z); bf16* MIX = (bf16*)(P->ws + WS_MIX); const float* rope = (const float*)(P->ws + WS_ROPE);
    const int b = r / TPB, p = r - b * TPB; const bool lat = p >= CTXL;
    const int seg_lo = lat ? CTXL : 0, seg_hi = lat ? TPB : CTXL;
    bf16* zr = Z + (size_t)r * ZW;
    {
        const int ch = lane * 8; float v[8], gb[8], gc[8], up[8], un[8], uc[8];
        unpack8(*(const v4u*)(zr + Z_CV + ch), v); unpack8(*(const v4u*)(zr + Z_CB + ch), gb); unpack8(*(const v4u*)(zr + Z_CC + ch), gc);
#pragma unroll
        for (int e = 0; e < 8; ++e) uc[e] = gc[e] * v[e];
        if (p > seg_lo) { float a[8], c[8]; unpack8(*(const v4u*)(zr - ZW + Z_CV + ch), a); unpack8(*(const v4u*)(zr - ZW + Z_CC + ch), c);
#pragma unroll
            for (int e = 0; e < 8; ++e) up[e] = a[e] * c[e]; }
        else {
#pragma unroll
            for (int e = 0; e < 8; ++e) up[e] = 0.f; }
        if (p + 1 < seg_hi) { float a[8], c[8]; unpack8(*(const v4u*)(zr + ZW + Z_CV + ch), a); unpack8(*(const v4u*)(zr + ZW + Z_CC + ch), c);
#pragma unroll
            for (int e = 0; e < 8; ++e) un[e] = a[e] * c[e]; }
        else {
#pragma unroll
            for (int e = 0; e < 8; ++e) un[e] = 0.f; }
        const float* cw = P->in[I_CONVW] + (size_t)l * 3 * CONVW + ch; float o[8];
#pragma unroll
        for (int h = 0; h < 2; ++h) { const f32x4 w0 = *(const f32x4*)(cw + h * 4), w1 = *(const f32x4*)(cw + CONVW + h * 4), w2 = *(const f32x4*)(cw + 2 * CONVW + h * 4);
#pragma unroll
            for (int e = 0; e < 4; ++e) { const int k = h * 4 + e; o[k] = gb[k] * (w0[e] * up[k] + w1[e] * uc[k] + w2[e] * un[k]); } }
        v4u w; w.x = pk2(o[0], o[1]); w.y = pk2(o[2], o[3]); w.z = pk2(o[4], o[5]); w.w = pk2(o[6], o[7]);
        *(v4u*)(MIX + (size_t)r * DM + MIX_CONV + ch) = w;
    }
    const int t = p - CTXL, rowc = t >> 6, colc = t & 63;
    {
        const int sub = lane & 31; float k[4]; bf16* kp = zr + Z_K + lane * 4;
        const v2u kw = *(const v2u*)kp; k[0] = blo(kw.x); k[1] = bhi(kw.x); k[2] = blo(kw.y); k[3] = bhi(kw.y);
        float ss = k[0] * k[0] + k[1] * k[1] + k[2] * k[2] + k[3] * k[3];
        ss += __shfl_xor(ss, 1); ss += __shfl_xor(ss, 2); ss += __shfl_xor(ss, 4); ss += __shfl_xor(ss, 8); ss += __shfl_xor(ss, 16);
        const float rr = 1.0f / sqrtf(ss * (1.0f / 128.0f) + RMS_EPS);
        const float* kg = P->in[I_KNORM] + l * 128 + sub * 4;
#pragma unroll
        for (int e = 0; e < 4; ++e) k[e] = k[e] * rr * kg[e];
        if (lat) {
            const int coord = (sub < 16) ? rowc : colc; const float* cs = rope + coord * 32 + (sub & 7) * 4; const float* sn = cs + 2048;
#pragma unroll
            for (int e = 0; e < 4; ++e) { const float other = __shfl_xor(k[e], 8); const float c = cs[e], s = sn[e];
                k[e] = ((sub & 8) == 0) ? (k[e] * c - other * s) : (other * s + k[e] * c); }
        }
        v2u w; w.x = pk2(k[0], k[1]); w.y = pk2(k[2], k[3]); *(v2u*)kp = w;
    }
}

__device__ __forceinline__ void s5_carry_phase(KP P, int l, int wave, int lane) {
    const int G = gridDim.x;
    bf16* UH = (bf16*)(P->ws + WS_UH); const float* SB = (const float*)(P->ws + WS_SB);
    for (int it = wave * G + (int)blockIdx.x; it < 32 * NB * 2; it += NWAVES * G) {
        const int dir = it & 1, b = (it >> 1) & 7, g = it >> 4;
        const f32x2 l32 = ((const f32x2*)(P->ws + WS_POW))[((size_t)((l * 2 + dir) * 32 + g) * 33 + 32) * 64 + lane];
        float hre = 0.f, him = 0.f;
#pragma unroll 8
        for (int k = 0; k < SSM_CPB; ++k) {
            const int c = dir == 0 ? k : (k < 8 ? 7 - k : 143 - k);
            const size_t rowi = (size_t)g * SSM_RPG + ssm_rg(b, c);
            bf16* up = UH + rowi * UH_LD + 512 + dir * 128 + lane;
            up[0] = (bf16)f2bf(hre); up[64] = (bf16)f2bf(him);
            const float* sp = SB + rowi * 256 + dir * 128 + lane;
            const float sre = sp[0], sim = sp[64];
            const float nre = l32[0] * hre - l32[1] * him + sre, nim = l32[0] * him + l32[1] * hre + sim;
            hre = nre; him = nim;
        }
    }
}

__device__ __forceinline__ void attention_phase(KP P, int l, unsigned char* lds_generic, int wave_s) {
    const bf16* Z = (const bf16*)(P->ws + WS_Z); bf16* MIX = (bf16*)(P->ws + WS_MIX);
    const int G = gridDim.x;
    for (int i = 0; ; ++i) {
        int b, h, qb;
        if (G == 256) { if (i >= 4) break; const int xcd = blockIdx.x & 7, slot = blockIdx.x >> 3; const int pair = 2 * xcd + (i >> 1), uip = (i & 1) * 32 + slot; b = pair >> 1; h = (pair & 1) * 4 + (uip >> 4); qb = uip & 15; }
        else { const int u = i * G + blockIdx.x; if (u >= 1024) break; b = u >> 7; h = (u >> 4) & 7; qb = u & 15; }
        const int kvh = h >> 2; const size_t row0 = (size_t)b * TPB;
        attn::attn_unit(Z + (row0 + CTXL + qb * 256) * ZW + Z_Q + h * 128, Z + row0 * ZW + Z_K + kvh * 128, Z + row0 * ZW + Z_V + kvh * 128,
                        MIX + (row0 + CTXL + qb * 256) * DM + MIX_ATT + h * 128, TPB, (char*)lds_generic, wave_s, P->in[I_QNORM] + l * 128, (const float*)(P->ws + WS_ROPE), qb * 256);
    }
    if (l < DEPTH - 1) {
        for (int u = blockIdx.x; u < NB * 8; u += G) { const int b = u >> 3, h = u & 7, kvh = h >> 2; const size_t row0 = (size_t)b * TPB;
            attn::attn_unit(Z + row0 * ZW + Z_Q + h * 128, Z + row0 * ZW + Z_K + kvh * 128, Z + row0 * ZW + Z_V + kvh * 128, MIX + row0 * DM + MIX_ATT + h * 128, CTXL, (char*)lds_generic, wave_s, P->in[I_QNORM] + l * 128, nullptr, 0); }
    }
}
constexpr int PH_PRO = 3, PH_PER_LAYER = 10, PH_TOTAL = PH_PRO + DEPTH * PH_PER_LAYER;
__global__ void __launch_bounds__(NWAVES * 64, 2) trunk_fwd(Params Pval) {
    extern __shared__ __attribute__((aligned(16))) unsigned char lds_raw[];
    LAS unsigned char* lds = (LAS unsigned char*)lds_raw;
    const int wave = __builtin_amdgcn_readfirstlane((int)threadIdx.x >> 6);

    const int G = gridDim.x;
    for (int u = wave * 64 + lane_id(); u < (LDS_BYTES - LDSCTL_OFF) / 4; u += NWAVES * 64) ((LAS unsigned*)(lds + LDSCTL_OFF))[u] = 0u;
    __syncthreads();
    (void)Pval;
    KP P = kparams();
    const int lo = P->ph_lo, hi = P->ph_hi;
    unsigned char* ws = P->ws;
    XcdBarrier bar; bar.bar = (unsigned*)(ws + WS_CTL) + CW_BAR; bar.x = 0; bar.st = nullptr;
    if (hi - lo > 1) bar = xcd_barrier_post((unsigned*)(ws + WS_CTL) + CW_BAR, (volatile LAS unsigned*)(lds + MISC_OFF) + 8, wave == 0 && lane_id() == 0);
#define IN(k) (lo <= (k) && (k) < hi)
#define SEAM(k) do { if (IN((k) + 1)) { const bool ldr_ = (wave == 0) && (lane_id() == 0); xcd_barrier(bar, ldr_); if (NREP(17) > 1) xcd_barrier(bar, ldr_); } } while (0)

    if (IN(0)) { for (int rep = 0; rep < NREP(0); ++rep) prologue_a(P, lds, wave, lane_id()); SEAM(0); }
    if (IN(1)) { for (int rep = 0; rep < NREP(0); ++rep) { prologue_b(P, wave * 64 + lane_id()); prologue_kt(P, wave * 64 + lane_id()); } SEAM(1); }
    if (IN(2)) {
        for (int rep = 0; rep < NREP(0); ++rep) prologue_s5w(P, wave * 64 + lane_id());
        Thin T{}; T.init = 1; T.fin = 0; T.x_lat = P->in[I_X]; T.x_ctx = P->in[I_CTX]; T.X = (const bf16*)(ws + WS_X); T.Xout = (bf16*)(ws + WS_X); T.Y = nullptr; T.H = (bf16*)(ws + WS_H); T.OUT = nullptr;
        T.modg = nullptr; T.gc = 0; T.mods = (const float*)(ws + WS_MOD); T.sc = 0; T.YP = nullptr; T.ctx_mode = 1;
        for (int rep = 0; rep < NREP(0); ++rep) thin_rows(T, wave, lane_id()); SEAM(2);
    }
    for (int l = 0; l < DEPTH; ++l) {
        const int pb = PH_PRO + l * PH_PER_LAYER;
        if (pb + PH_PER_LAYER <= lo || pb >= hi) continue;
        P = kparams(); ws = P->ws;
        const unsigned char* wl = ws + WS_W + (size_t)l * W_LAYER;
        const float* modl = (const float*)(ws + WS_MOD) + (size_t)l * 9 * NMOD;
        const bool lastl = (l == DEPTH - 1);
        float* YPp = (float*)(ws + WS_YP);
        if (IN(pb + 0)) {
            pg8::Gemm g{(const bf16*)(ws + WS_H), (const bf16*)(wl + W_IN), M, ZW, DM}; pg8::RowOrder S{ZW / 256, G, (int)blockIdx.x, 1, 0};
            pg8::EpiInProj E{(bf16*)(ws + WS_Z), (bf16*)(ws + WS_UH)};
            for (int rep = 0; rep < NREP(3); ++rep) pg8::gemm_phase<pg8::EpiInProj, pg8::RowOrder, true, true>(lds + RING_OFF, g, S, E, wave);
            SEAM(pb + 0);
        }
        if (IN(pb + 1)) {
            for (int r = (int)blockIdx.x * NWAVES + wave; r < M; r += NWAVES * G) prep_row(P, l, r, lane_id());
            pg8::Gemm g{(const bf16*)(ws + WS_UH), (const bf16*)(ws + WS_W1) + (size_t)l * 32 * 256 * 512, 0, 0, 512, UH_LD, 512}; pg8::S5Order1 S{G, (int)blockIdx.x};
            pg8::EpiS5State E{(float*)(ws + WS_SB)};
            for (int rep = 0; rep < NREP(13); ++rep) pg8::gemm_phase<pg8::EpiS5State, pg8::S5Order1, true, true>(lds + RING_OFF, g, S, E, wave);
            SEAM(pb + 1);
        }
        if (IN(pb + 2)) { for (int rep = 0; rep < NREP(14); ++rep) s5_carry_phase(P, l, wave, lane_id()); SEAM(pb + 2); }
        if (IN(pb + 3)) {
            { pg8::Gemm g{(const bf16*)(ws + WS_UH), (const bf16*)(ws + WS_TW) + (size_t)l * 32 * 512 * 768, 0, 0, 768, UH_LD, 768}; pg8::S5Order2 S{G, (int)blockIdx.x, l < DEPTH - 1 ? 5 : 4};
              pg8::EpiS5Out E{(bf16*)(ws + WS_G)};
              for (int rep = 0; rep < NREP(15); ++rep) pg8::gemm_phase<pg8::EpiS5Out, pg8::S5Order2, true, true>(lds + RING_OFF, g, S, E, wave); }
            __syncthreads();
            for (int rep = 0; rep < NREP(12); ++rep) attention_phase(P, l, lds_raw, wave);
            SEAM(pb + 3);
        }
        if (IN(pb + 4)) {
            pg8::Gemm g{(const bf16*)(ws + WS_G), (const bf16*)(wl + W_GLU), M, SSMW, SSMW}; pg8::RowOrder S{SSMW / 256, G, (int)blockIdx.x, lastl ? 0 : 1, 0};
            pg8::EpiGlu E{(const bf16*)(ws + WS_G), SSMW, (bf16*)(ws + WS_MIX) + MIX_SSM, DM, P->in[I_BGLU] + l * SSMW};
            for (int rep = 0; rep < NREP(11); ++rep) pg8::gemm_phase<pg8::EpiGlu, pg8::RowOrder, true, true>(lds + RING_OFF, g, S, E, wave);
            SEAM(pb + 4);
        }
        if (IN(pb + 5)) {
            pg8::Gemm g{(const bf16*)(ws + WS_MIX), (const bf16*)(wl + W_OUT), M, DM, DM}; pg8::RowOrder S{DM / 256, G, (int)blockIdx.x, lastl ? 0 : 2, DM / 256};
            pg8::EpiBf16 E{(bf16*)(ws + WS_Y), DM, YPp, DM / 64};
            for (int rep = 0; rep < NREP(6); ++rep) pg8::gemm_phase<pg8::EpiBf16, pg8::RowOrder, true, true>(lds + RING_OFF, g, S, E, wave);
            SEAM(pb + 5);
        }
        if (IN(pb + 6)) {
            Thin T{}; T.init = 0; T.fin = 0; T.x_lat = nullptr; T.x_ctx = nullptr; T.X = (const bf16*)(ws + WS_X); T.Xout = (bf16*)(ws + WS_X); T.Y = (const bf16*)(ws + WS_Y); T.H = (bf16*)(ws + WS_H); T.OUT = nullptr;
            T.modg = modl; T.gc = 2; T.mods = modl; T.sc = 3; T.YP = YPp; T.ctx_mode = lastl ? 0 : 2;
            if (NREP(7) > 1) { Thin T2 = T; T2.Xout = (bf16*)(ws + WS_Z); thin_rows(T2, wave, lane_id()); }
            thin_rows(T, wave, lane_id()); SEAM(pb + 6);
        }
        if (IN(pb + 7)) {
            pg8::Gemm g{(const bf16*)(ws + WS_H), (const bf16*)(wl + W_GU), M, 2 * FF, DM}; pg8::RowOrder S{2 * FF / 256, G, (int)blockIdx.x, lastl ? 0 : 1, 0};
            pg8::EpiSwiGlu E{(bf16*)(ws + WS_ACT), FF};
            for (int rep = 0; rep < NREP(8); ++rep) pg8::gemm_phase<pg8::EpiSwiGlu, pg8::RowOrder, true, true>(lds + RING_OFF, g, S, E, wave);
            SEAM(pb + 7);
        }
        if (IN(pb + 8)) {
            pg8::Gemm g{(const bf16*)(ws + WS_ACT), (const bf16*)(wl + W_DOWN), M, DM, FF}; pg8::RowOrder S{DM / 256, G, (int)blockIdx.x, lastl ? 0 : 2, FF / 256};
            pg8::EpiBf16 E{(bf16*)(ws + WS_Y), DM, YPp, FF / 64};
            for (int rep = 0; rep < NREP(9); ++rep) pg8::gemm_phase<pg8::EpiBf16, pg8::RowOrder, true, true>(lds + RING_OFF, g, S, E, wave);
            SEAM(pb + 8);
        }
        if (IN(pb + 9)) {
            const bool last = (l == DEPTH - 1); const int l2 = last ? l : l + 1;
            Thin T{}; T.init = 0; T.fin = last ? 1 : 0; T.x_lat = nullptr; T.x_ctx = nullptr; T.X = (const bf16*)(ws + WS_X); T.Xout = (bf16*)(ws + WS_X); T.Y = (const bf16*)(ws + WS_Y); T.H = (bf16*)(ws + WS_H); T.OUT = P->out;
            T.modg = modl; T.gc = 5; T.mods = (const float*)(ws + WS_MOD) + (size_t)l2 * 9 * NMOD; T.sc = 0; T.YP = YPp; T.ctx_mode = lastl ? 0 : 2;
            if (NREP(7) > 1) { Thin T2 = T; T2.Xout = (bf16*)(ws + WS_Z); thin_rows(T2, wave, lane_id()); }
            thin_rows(T, wave, lane_id()); SEAM(pb + 9);
        }
    }
#undef IN
#undef SEAM
}

extern "C" void kernel_launch(void* const* d_in, const int* in_sizes, int n_in, void* d_out, int out_size, void* d_ws, size_t ws_size, hipStream_t stream) {
    static int grid = 0;
    if (grid == 0) {
        if (n_in != 28 || in_sizes[0] != NB * SEQ * DM || out_size != NB * SEQ * DM || ws_size < WS_END) {
            fprintf(stderr, "kernel_launch: built for 28 inputs, x/out of %d floats, >= %zu bytes of workspace; got n_in %d, in0 %d, out %d, ws %zu; nothing launched\n", NB * SEQ * DM, (size_t)WS_END, n_in, n_in > 0 ? in_sizes[0] : -1, out_size, ws_size);
            grid = -1; return; }
        int dev = 0, cus = 0;
        if (hipGetDevice(&dev) != hipSuccess || hipDeviceGetAttribute(&cus, hipDeviceAttributeMultiprocessorCount, dev) != hipSuccess) { fprintf(stderr, "kernel_launch: device query failed\n"); grid = -1; return; }
        if (hipFuncSetAttribute((const void*)trunk_fwd, hipFuncAttributeMaxDynamicSharedMemorySize, LDS_BYTES) != hipSuccess) { fprintf(stderr, "kernel_launch: hipFuncSetAttribute failed\n"); grid = -1; return; }
        int per_cu = 0;
        if (hipOccupancyMaxActiveBlocksPerMultiprocessor(&per_cu, (const void*)trunk_fwd, NWAVES * 64, LDS_BYTES) != hipSuccess || per_cu < 1)
            fprintf(stderr, "kernel_launch: note: occupancy query reports %d workgroups per CU\n", per_cu);
        (void)hipGetLastError();
        grid = cus;
    }
    if (grid < 0) return;
    if (hipMemsetAsync((char*)d_ws + WS_CTL, 0, CTL_ZERO_BYTES, stream) != hipSuccess) { fprintf(stderr, "kernel_launch: memset failed\n"); return; }
    Params p{};
    for (int i = 0; i < 28; ++i) p.in[i] = (const float*)d_in[i];
    p.out = (float*)d_out; p.ws = (unsigned char*)d_ws;
#if MK_ONE_LAUNCH
    p.ph_lo = 0; p.ph_hi = PH_TOTAL;
    hipLaunchKernelGGL(trunk_fwd, dim3(grid), dim3(NWAVES * 64), LDS_BYTES, stream, p);
#else
    for (int k = 0; k < PH_TOTAL; ++k) { p.ph_lo = k; p.ph_hi = k + 1; hipLaunchKernelGGL(trunk_fwd, dim3(grid), dim3(NWAVES * 64), LDS_BYTES, stream, p); }
#endif
    const hipError_t le = hipPeekAtLastError();
    if (le != hipSuccess) fprintf(stderr, "kernel_launch: launch failed: %s\n", hipGetErrorName(le));
}
```

```cpp
#include <hip/hip_runtime.h>
#include <cstdio>
#include <cstdint>
#include <cmath>

#ifndef MK_ONE_LAUNCH
#define MK_ONE_LAUNCH 1
#endif

constexpr int SSM_L = 32, SSM_CPB = 136, SSM_RPG = 1280, UH_LD = 768;
__host__ __device__ __forceinline__ int ssm_rg(int b, int c) { return c >= 8 ? b * 128 + (c - 8) : 1024 + b * 8 + c; }

#ifndef REP_MASK
#define REP_MASK 0
#endif
#define NREP(b) (1 + ((REP_MASK >> (b)) & 1))
__device__ __forceinline__ int lane_id() { int l; asm volatile("v_mbcnt_lo_u32_b32 %0, -1, 0\n\tv_mbcnt_hi_u32_b32 %0, -1, %0" : "=v"(l)); return l; }
namespace pg8 {
#define PG8_LAS __attribute__((address_space(3)))
typedef unsigned short bf16_t;
typedef short bf16x8 __attribute__((ext_vector_type(8)));
typedef float f32x4 __attribute__((ext_vector_type(4)));
typedef unsigned u32x4 __attribute__((ext_vector_type(4)));
constexpr int BM = 256, BK = 64, HALF = 128, HTB = HALF * BK * 2  , STAGE_BYTES = 8 * HTB, NXCD = 8, WGM = 8;

__host__ __device__ __forceinline__ int lds_byte(int r, int c) { const int st = (r >> 4) * 2 + (c >> 5), rr = r & 15, cc = c & 31, ob = rr * 64 + cc * 2; return st * 1024 + (ob ^ (((ob >> 9) & 1) << 5)); }
__host__ __device__ __forceinline__ void stage_rc(int b, int& R, int& C) { const int st = b / 1024, sb = b % 1024, swz = sb ^ (((sb >> 9) & 1) << 5); R = (st >> 1) * 16 + swz / 64; C = (st & 1) * 32 + (swz % 64) / 2; }
__host__ __device__ __forceinline__ int perm32(int rho) { const int n = rho >> 4, i = rho & 15; return 8 * (i >> 2) + 4 * n + (i & 3); }

struct Unit { int pm, pn, ko, nt; };
struct Gemm { const bf16_t* A; const bf16_t* Bt; int M, N, K, lda, ldb; };

struct StaticOrder {
    int nM, nN, nwg, G, c;
    __host__ __device__ void init(int M, int N, int G_, int c_) { nM = M / BM; nN = N / BM; nwg = nM * nN; G = G_; c = c_; }
    __host__ __device__ bool next(int i, Unit& u) const {
        const long L = (long)i * G + c; if (L >= nwg) return false;
        int wgid = (int)L; { const int q = nwg / NXCD, r = nwg % NXCD, xcd = wgid % NXCD, off = wgid / NXCD; wgid = (xcd < r ? xcd * (q + 1) : r * (q + 1) + (xcd - r) * q) + off; }
        const int nig = WGM * nN, gid = wgid / nig, fm = gid * WGM, gsz = (nM - fm) < WGM ? (nM - fm) : WGM;
        u.pm = fm + ((wgid % nig) % gsz); u.pn = (wgid % nig) / gsz; return true;
    }
    __device__ __forceinline__ void a_ready(const Unit&) const {}
    __device__ __forceinline__ void done(const Unit&) const {}
};

__device__ __forceinline__ unsigned cvt_pk_bf16(float lo, float hi) { unsigned r; asm volatile("v_cvt_pk_bf16_f32 %0, %1, %2" : "=v"(r) : "v"(lo), "v"(hi)); return r; }
typedef float f32x2 __attribute__((ext_vector_type(2)));
struct EpiBf16 {
    static constexpr bool PERM = true, AFTER_DRAIN = false; static constexpr int NST = 0;
    bf16_t* O; int ldc; float* YP; int nt_full;
    __device__ __forceinline__ void operator()(const f32x4 (&acc)[2][2][4][2], const Unit& u, int wr, int wc, int fr, int fq) const {
        const int col0 = u.pn * BM + wc * 32 + 8 * fq;
        if (u.nt != nt_full) {
            const int q = u.ko / (u.nt * BK), b = u.pm / 17; float* base = YP + ((size_t)q * 2048 + b * 256 + wr * 64 + fr) * ldc + col0;
#pragma unroll
            for (int ai = 0; ai < 2; ++ai)
#pragma unroll
                for (int m = 0; m < 4; ++m) { float* rowp = base + (size_t)(ai * HALF + m * 16) * ldc;
#pragma unroll
                    for (int bj = 0; bj < 2; ++bj) { *(f32x4*)(rowp + bj * HALF) = acc[ai][bj][m][0]; *(f32x4*)(rowp + bj * HALF + 4) = acc[ai][bj][m][1]; } }
            return;
        }
        const int row0 = u.pm * BM + wr * 64 + fr;
#pragma unroll
        for (int ai = 0; ai < 2; ++ai)
#pragma unroll
            for (int m = 0; m < 4; ++m) { bf16_t* rowp = O + (size_t)(row0 + ai * HALF + m * 16) * ldc + col0;
#pragma unroll
                for (int bj = 0; bj < 2; ++bj) { const f32x4 v0 = acc[ai][bj][m][0], v1 = acc[ai][bj][m][1];
                    u32x4 w; w.x = cvt_pk_bf16(v0[0], v0[1]); w.y = cvt_pk_bf16(v0[2], v0[3]); w.z = cvt_pk_bf16(v1[0], v1[1]); w.w = cvt_pk_bf16(v1[2], v1[3]);
                    *(u32x4*)(rowp + bj * HALF) = w; } }
    }
};
struct RowOrder {
    int nN, G, c, ctx, ntq;
    __device__ bool next(int i, Unit& u) const {
        const int nlat = 128 * nN, L = i * G + c;
        if (L < nlat) {
            const int q = nlat / NXCD, wgid = (L % NXCD) * q + L / NXCD;
            const int nig = WGM * nN, gid = wgid / nig, rem = wgid - gid * nig, pml = gid * WGM + (rem % WGM);
            u.pn = rem / WGM; u.pm = (pml >> 4) * 17 + 1 + (pml & 15); return true;
        }
        const int Lc = L - nlat;
        if (ctx == 1) { if (Lc >= 8 * nN) return false; u.pm = (Lc / nN) * 17; u.pn = Lc % nN; return true; }
        if (ctx == 2) { if (Lc >= 32 * nN) return false; const int t = Lc >> 2; u.pm = (t / nN) * 17; u.pn = t % nN; u.ko = (Lc & 3) * ntq * BK; u.nt = ntq; return true; }
        return false;
    }
    __device__ __forceinline__ void a_ready(const Unit&) const {}
    __device__ __forceinline__ void done(const Unit&) const {}
};
__device__ __forceinline__ float bflo(unsigned w) { return __uint_as_float(w << 16); }
__device__ __forceinline__ float bfhi(unsigned w) { return __uint_as_float(w & 0xffff0000u); }
__device__ __forceinline__ float sigmoidf_(float x) { return __builtin_amdgcn_rcpf(1.0f + __expf(-x)); }
struct EpiGlu {
    static constexpr bool PERM = true, AFTER_DRAIN = false; static constexpr int NST = 0;
    const bf16_t* G; int ldg; bf16_t* O; int ldo; const float* bias;
    __device__ __forceinline__ void operator()(const f32x4 (&acc)[2][2][4][2], const Unit& u, int wr, int wc, int fr, int fq) const {
        const int row0 = u.pm * BM + wr * 64 + fr; const int col0 = u.pn * BM + wc * 32 + 8 * fq;
        f32x4 bv[2][2];
#pragma unroll
        for (int bj = 0; bj < 2; ++bj)
#pragma unroll
            for (int n = 0; n < 2; ++n) bv[bj][n] = *(const f32x4*)(bias + col0 + bj * HALF + 4 * n);
#pragma unroll
        for (int ai = 0; ai < 2; ++ai) {
            u32x4 gv[4][2];
#pragma unroll
            for (int m = 0; m < 4; ++m)
#pragma unroll
                for (int bj = 0; bj < 2; ++bj) gv[m][bj] = *(const u32x4*)(G + (size_t)(row0 + ai * HALF + m * 16) * ldg + col0 + bj * HALF);
            asm volatile("" ::: "memory");
#pragma unroll
            for (int m = 0; m < 4; ++m) { const size_t row = (size_t)(row0 + ai * HALF + m * 16);
#pragma unroll
                for (int bj = 0; bj < 2; ++bj) { const f32x4 v0 = acc[ai][bj][m][0] + bv[bj][0], v1 = acc[ai][bj][m][1] + bv[bj][1];
                    const u32x4 g = gv[m][bj];
                    const float o0 = bflo(g.x) * sigmoidf_(v0[0]), o1 = bfhi(g.x) * sigmoidf_(v0[1]), o2 = bflo(g.y) * sigmoidf_(v0[2]), o3 = bfhi(g.y) * sigmoidf_(v0[3]);
                    const float o4 = bflo(g.z) * sigmoidf_(v1[0]), o5 = bfhi(g.z) * sigmoidf_(v1[1]), o6 = bflo(g.w) * sigmoidf_(v1[2]), o7 = bfhi(g.w) * sigmoidf_(v1[3]);
                    u32x4 w; w.x = cvt_pk_bf16(o0, o1); w.y = cvt_pk_bf16(o2, o3); w.z = cvt_pk_bf16(o4, o5); w.w = cvt_pk_bf16(o6, o7);
                    *(u32x4*)(O + row * ldo + col0 + bj * HALF) = w; } }
            asm volatile("" ::: "memory");
        }
    }
};
struct EpiSwiGlu {
    static constexpr bool PERM = true, AFTER_DRAIN = false; static constexpr int NST = 8;
    bf16_t* O; int ldo;
    __device__ __forceinline__ void operator()(const f32x4 (&acc)[2][2][4][2], const Unit& u, int wr, int wc, int fr, int fq) const {
        const int row0 = u.pm * BM + wr * 64 + fr; const int col0 = u.pn * HALF + wc * 32 + 8 * fq;
#pragma unroll
        for (int ai = 0; ai < 2; ++ai)
#pragma unroll
            for (int m = 0; m < 4; ++m) { const size_t row = (size_t)(row0 + ai * HALF + m * 16);
                float o[8];
#pragma unroll
                for (int n = 0; n < 2; ++n)
#pragma unroll
                    for (int j = 0; j < 4; ++j) { const float g = acc[ai][0][m][n][j], up = acc[ai][1][m][n][j]; o[n * 4 + j] = g * sigmoidf_(g) * up; }
                u32x4 w; w.x = cvt_pk_bf16(o[0], o[1]); w.y = cvt_pk_bf16(o[2], o[3]); w.z = cvt_pk_bf16(o[4], o[5]); w.w = cvt_pk_bf16(o[6], o[7]);
                *(u32x4*)(O + row * ldo + col0) = w; }
    }
};
struct EpiInProj {
    static constexpr bool PERM = true, AFTER_DRAIN = false; static constexpr int NST = 0;
    bf16_t* Z; bf16_t* UH;
    __device__ __forceinline__ void operator()(const f32x4 (&acc)[2][2][4][2], const Unit& u, int wr, int wc, int fr, int fq) const {
        const int row0 = u.pm * BM + wr * 64 + fr; const int col0 = u.pn * BM + wc * 32 + 8 * fq;
        const bool ssm = (u.pn == 6 || u.pn == 7);
#pragma unroll
        for (int ai = 0; ai < 2; ++ai)
#pragma unroll
            for (int m = 0; m < 4; ++m) { const int row = row0 + ai * HALF + m * 16;
                int b = 0, pos = 0; if (ssm) { b = row / 4352; pos = row - b * 4352; }
#pragma unroll
                for (int bj = 0; bj < 2; ++bj) { const f32x4 v0 = acc[ai][bj][m][0], v1 = acc[ai][bj][m][1];
                    u32x4 w; w.x = cvt_pk_bf16(v0[0], v0[1]); w.y = cvt_pk_bf16(v0[2], v0[3]); w.z = cvt_pk_bf16(v1[0], v1[1]); w.w = cvt_pk_bf16(v1[2], v1[3]);
                    const int col = col0 + bj * HALF;
                    if (ssm) { const int sc = col - 1536, g = sc >> 4, n0 = sc & 15; *(u32x4*)(UH + ((size_t)(g * SSM_RPG + ssm_rg(b, pos >> 5)) * UH_LD + (pos & 31) * 16 + n0)) = w; }
                    else *(u32x4*)(Z + (size_t)row * 3584 + col) = w; } }
    }
};
struct EpiS5State {
    static constexpr bool PERM = true, AFTER_DRAIN = false; static constexpr int NST = 0;
    float* S;
    __device__ __forceinline__ void operator()(const f32x4 (&acc)[2][2][4][2], const Unit& u, int wr, int wc, int fr, int fq) const {
        const int row0 = u.pm * BM + wr * 64 + fr; const int col0 = wc * 32 + 8 * fq;
#pragma unroll
        for (int ai = 0; ai < 2; ++ai)
#pragma unroll
            for (int m = 0; m < 4; ++m) { float* rowp = S + (size_t)(row0 + ai * HALF + m * 16) * 256 + col0;
#pragma unroll
                for (int bj = 0; bj < 2; ++bj) { *(f32x4*)(rowp + bj * HALF) = acc[ai][bj][m][0]; *(f32x4*)(rowp + bj * HALF + 4) = acc[ai][bj][m][1]; } }
    }
};
__device__ __forceinline__ float gelu_tanh_(float y) {
    const float z = 0.7978845608028654f * (y + 0.044715f * y * y * y);
    const float t = 1.0f - 2.0f * __builtin_amdgcn_rcpf(__expf(2.0f * z) + 1.0f);
    return 0.5f * y * (1.0f + t);
}
struct EpiS5Out {
    static constexpr bool PERM = true, AFTER_DRAIN = false; static constexpr int NST = 0;
    bf16_t* G;
    __device__ __forceinline__ void operator()(const f32x4 (&acc)[2][2][4][2], const Unit& u, int wr, int wc, int fr, int fq) const {
        const int g = u.pn >> 1, j = u.pn & 1, i = u.pm - 5 * g;
        const int rg0 = i * BM + wr * 64 + fr; const int col0 = j * BM + wc * 32 + 8 * fq;
#pragma unroll
        for (int ai = 0; ai < 2; ++ai)
#pragma unroll
            for (int m = 0; m < 4; ++m) { const int rg = rg0 + ai * HALF + m * 16;
                if (rg < 1088) {
                    int b, c; if (rg < 1024) { b = rg >> 7; c = 8 + (rg & 127); } else { b = (rg - 1024) >> 3; c = (rg - 1024) & 7; }
                    const size_t grow0 = (size_t)b * 4352 + c * 32;
#pragma unroll
                    for (int bj = 0; bj < 2; ++bj) { const f32x4 v0 = acc[ai][bj][m][0], v1 = acc[ai][bj][m][1];
                        const int col = col0 + bj * HALF, t = col >> 4, n0 = col & 15;
                        u32x4 w; w.x = cvt_pk_bf16(gelu_tanh_(v0[0]), gelu_tanh_(v0[1])); w.y = cvt_pk_bf16(gelu_tanh_(v0[2]), gelu_tanh_(v0[3]));
                        w.z = cvt_pk_bf16(gelu_tanh_(v1[0]), gelu_tanh_(v1[1])); w.w = cvt_pk_bf16(gelu_tanh_(v1[2]), gelu_tanh_(v1[3]));
                        *(u32x4*)(G + (grow0 + t) * 512 + g * 16 + n0) = w; } } }
    }
};
struct S5Order1 { int G, c;
    __device__ bool next(int i, Unit& u) const { const int L = i * G + c; if (L >= 160) return false; u.pm = L; u.pn = L / 5; return true; }
    __device__ __forceinline__ void a_ready(const Unit&) const {}
    __device__ __forceinline__ void done(const Unit&) const {} };
struct S5Order2 { int G, c, nt;
    __device__ bool next(int i, Unit& u) const { const int L = i * G + c; if (L >= 32 * nt * 2) return false; const int g = L / (2 * nt), r = L - g * 2 * nt; u.pm = g * 5 + (r >> 1); u.pn = g * 2 + (r & 1); return true; }
    __device__ __forceinline__ void a_ready(const Unit&) const {}
    __device__ __forceinline__ void done(const Unit&) const {} };
template <class Epi, class Sched, bool ALIGN_EPI = false, bool SP2 = false>
__device__ __forceinline__ void gemm_phase(PG8_LAS unsigned char* lds, const Gemm g, const Sched& S, const Epi& E, int wave_s) {
    int tid_ = wave_s * 64 + lane_id(); asm volatile("" : "+v"(tid_));
    const int tid = tid_, wid = __builtin_amdgcn_readfirstlane(tid >> 6), lane = tid & 63, wr = wid >> 2, wc = wid & 3, fr = lane & 15, fq = lane >> 4;
    const int K = g.K, lda = g.lda ? g.lda : K, ldb = g.ldb ? g.ldb : K;
    unsigned voffA[2], voffB[2];
#pragma unroll
    for (int i = 0; i < 2; ++i) { int R, C; stage_rc(tid * 16 + i * 8192, R, C); const int Rb = Epi::PERM ? ((R & ~31) + perm32(R & 31)) : R;
        voffA[i] = (unsigned)(R * lda + C) * 2u; voffB[i] = (unsigned)(Rb * ldb + C) * 2u; }
    const size_t kstep = (size_t)(BK * 2);
    const size_t hstepA = (size_t)HALF * lda * 2, hstepB = (size_t)HALF * ldb * 2;
    const size_t tstepA = 2 * hstepA, tstepB = 2 * hstepB;
    const unsigned ldsw = (unsigned)wid * 1024u;
    const int aoff = lds_byte(wr * 64 + fr, fq * 8), boff = lds_byte(wc * 32 + fr, fq * 8);
#define PG8_SA(b, h) (((b) * 2 + (h)) * HTB)
#define PG8_SB(b, h) ((4 + (b) * 2 + (h)) * HTB)
#define PG8_STAGE(bufoff, gbase, voff) do { _Pragma("unroll") for (int _i = 0; _i < 2; ++_i) \
        __builtin_amdgcn_global_load_lds((const unsigned*)((const char*)(gbase) + (voff)[_i]), (PG8_LAS unsigned*)(lds + (bufoff) + ldsw + _i * 8192), 16, 0, 0); } while (0)
#define PG8_LDA(dst, b, h) do { _Pragma("unroll") for (int m = 0; m < 4; ++m) _Pragma("unroll") for (int k = 0; k < 2; ++k) dst[m][k] = *(const PG8_LAS bf16x8*)(lds + PG8_SA(b, h) + aoff + m * 2048 + k * 1024); } while (0)
#define PG8_LDB(dst, b, h) do { _Pragma("unroll") for (int n = 0; n < 2; ++n) _Pragma("unroll") for (int k = 0; k < 2; ++k) dst[n][k] = *(const PG8_LAS bf16x8*)(lds + PG8_SB(b, h) + boff + n * 2048 + k * 1024); } while (0)
#define PG8_MMA(ai, bj, At, Bt) do { __builtin_amdgcn_s_setprio(1); _Pragma("unroll") for (int m = 0; m < 4; ++m) _Pragma("unroll") for (int n = 0; n < 2; ++n) _Pragma("unroll") for (int k = 0; k < 2; ++k) \
        acc[ai][bj][m][n] = __builtin_amdgcn_mfma_f32_16x16x32_bf16(Bt[n][k], At[m][k], acc[ai][bj][m][n], 0, 0, 0); __builtin_amdgcn_s_setprio(0); } while (0)
#define PG8_WAIT_V(n) asm volatile("s_waitcnt vmcnt(" #n ")" ::: "memory")
#define PG8_WAIT_L(n) asm volatile("s_waitcnt lgkmcnt(" #n ")" ::: "memory")
#define PG8_BAR __builtin_amdgcn_s_barrier()
#define PG8_SCHED __builtin_amdgcn_sched_barrier(0)
    Unit cur, nxt; int ui = 0;
    cur.ko = 0; cur.nt = K / BK; nxt.ko = 0; nxt.nt = K / BK;
    if (!S.next(0, cur)) return;
    f32x4 acc[2][2][4][2];
#pragma unroll
    for (int a = 0; a < 2; ++a)
#pragma unroll
        for (int b = 0; b < 2; ++b)
#pragma unroll
            for (int m = 0; m < 4; ++m)
#pragma unroll
                for (int n = 0; n < 2; ++n) acc[a][b][m][n] = (f32x4){0.f, 0.f, 0.f, 0.f};
    bf16x8 At[4][2], B0[2][2], B1[2][2];
    const char* cA = (const char*)g.A + (size_t)cur.pm * tstepA + (size_t)cur.ko * 2; const char* cB = (const char*)g.Bt + (size_t)cur.pn * tstepB + (size_t)cur.ko * 2;
    S.a_ready(cur);
    if constexpr (SP2) {
        PG8_STAGE(PG8_SB(0, 0), cB, voffB); PG8_STAGE(PG8_SB(0, 1), cB + hstepB, voffB); PG8_STAGE(PG8_SA(0, 0), cA, voffA); PG8_STAGE(PG8_SA(0, 1), cA + hstepA, voffA);
        if (wr == 1) PG8_BAR;
        PG8_WAIT_V(2); PG8_BAR;
        PG8_STAGE(PG8_SB(1, 0), cB + kstep, voffB); PG8_STAGE(PG8_SA(1, 0), cA + kstep, voffA); PG8_STAGE(PG8_SB(1, 1), cB + hstepB + kstep, voffB);
        PG8_WAIT_V(6); PG8_BAR;
    } else {
        PG8_STAGE(PG8_SB(0, 0), cB, voffB); PG8_STAGE(PG8_SA(0, 0), cA, voffA); PG8_STAGE(PG8_SB(0, 1), cB + hstepB, voffB); PG8_STAGE(PG8_SA(0, 1), cA + hstepA, voffA);
        if (wr == 1) PG8_BAR;
        PG8_WAIT_V(4); PG8_BAR;
        PG8_STAGE(PG8_SB(1, 0), cB + kstep, voffB); PG8_STAGE(PG8_SA(1, 0), cA + kstep, voffA); PG8_STAGE(PG8_SB(1, 1), cB + hstepB + kstep, voffB);
        PG8_WAIT_V(6); PG8_BAR;
    }
    for (;;) {
        nxt.ko = 0; nxt.nt = K / BK;
        const bool has_next = S.next(ui + 1, nxt);
        const int nt = cur.nt;
        const char* nA = has_next ? (const char*)g.A + (size_t)nxt.pm * tstepA + (size_t)nxt.ko * 2 : cA; const char* nB = has_next ? (const char*)g.Bt + (size_t)nxt.pn * tstepB + (size_t)nxt.ko * 2 : cB;
        static_assert(SP2, "this build keeps only the two-super-phase K-loop");
#define PG8_TRIP(WV12) { \
            const bool last = (t == nt - 2); \
            const char* a1 = cA + (size_t)(t + 1) * kstep; \
            const char* a2 = last ? nA : cA + (size_t)(t + 2) * kstep; const char* b2 = last ? nB : cB + (size_t)(t + 2) * kstep; \
            const char* a3 = a2 + kstep; const char* b3 = b2 + kstep; \
            if (last && has_next) S.a_ready(nxt); \
              \
            PG8_LDB(B0, 0, 0); PG8_LDB(B1, 0, 1); PG8_SCHED; PG8_LDA(At, 0, 0); PG8_STAGE(PG8_SA(1, 1), a1 + hstepA, voffA); \
            WV12; PG8_WAIT_L(0); PG8_BAR; PG8_MMA(0, 0, At, B0); PG8_MMA(0, 1, At, B1); PG8_BAR; PG8_SCHED; \
              \
            PG8_LDA(At, 0, 1); PG8_STAGE(PG8_SB(0, 0), b2, voffB); PG8_STAGE(PG8_SB(0, 1), b2 + hstepB, voffB); PG8_STAGE(PG8_SA(0, 0), a2, voffA); \
            WV12; PG8_WAIT_L(0); PG8_BAR; PG8_MMA(1, 0, At, B0); PG8_MMA(1, 1, At, B1); PG8_BAR; PG8_SCHED; \
              \
            PG8_LDB(B0, 1, 0); PG8_LDB(B1, 1, 1); PG8_SCHED; PG8_LDA(At, 1, 0); PG8_STAGE(PG8_SA(0, 1), a2 + hstepA, voffA); \
            PG8_WAIT_V(8); PG8_WAIT_L(0); PG8_BAR; PG8_MMA(0, 0, At, B0); PG8_MMA(0, 1, At, B1); PG8_BAR; PG8_SCHED; \
              \
            PG8_LDA(At, 1, 1); PG8_STAGE(PG8_SB(1, 0), b3, voffB); PG8_STAGE(PG8_SB(1, 1), b3 + hstepB, voffB); PG8_STAGE(PG8_SA(1, 0), a3, voffA); \
            PG8_WAIT_V(8); PG8_WAIT_L(0); PG8_BAR; PG8_MMA(1, 0, At, B0); PG8_MMA(1, 1, At, B1); PG8_BAR; PG8_SCHED; }
        int t = 0;
        if constexpr (Epi::NST == 16) { if (ui > 0) { PG8_TRIP(PG8_WAIT_V(24)) t = 2; } }
        if constexpr (Epi::NST == 8) { if (ui > 0) { PG8_TRIP(PG8_WAIT_V(16)) t = 2; } }
        for (; t < nt; t += 2) PG8_TRIP(PG8_WAIT_V(8))
#undef PG8_TRIP
        if constexpr (ALIGN_EPI) { if (wr == 0) PG8_BAR; }
        if constexpr (!Epi::AFTER_DRAIN) { E(acc, cur, wr, wc, fr, fq); S.done(cur); }
        if (!has_next) break;
#pragma unroll
        for (int a = 0; a < 2; ++a)
#pragma unroll
            for (int b = 0; b < 2; ++b)
#pragma unroll
                for (int m = 0; m < 4; ++m)
#pragma unroll
                    for (int n = 0; n < 2; ++n) acc[a][b][m][n] = (f32x4){0.f, 0.f, 0.f, 0.f};
        cur = nxt; cA = nA; cB = nB; ++ui;
        if constexpr (ALIGN_EPI) { if (wr == 1) PG8_BAR; }
    }
    PG8_WAIT_V(0);
    if constexpr (!ALIGN_EPI) { if (wr == 0) PG8_BAR; }
    PG8_BAR;
    if constexpr (Epi::AFTER_DRAIN) { E.fused(acc, cur, wr, wc, fr, fq, lds, wid, lane); S.done(cur); }
#undef PG8_SA
#undef PG8_SB
#undef PG8_STAGE
#undef PG8_LDA
#undef PG8_LDB
#undef PG8_MMA
#undef PG8_WAIT_V
#undef PG8_WAIT_L
#undef PG8_BAR
#undef PG8_SCHED
}
}
namespace attn {
typedef unsigned short bf16;
using bf16x8 = __attribute__((ext_vector_type(8))) short;
using s16x4  = __attribute__((ext_vector_type(4))) short;
using f32x16 = __attribute__((ext_vector_type(16))) float;
using u32x4  = __attribute__((ext_vector_type(4))) unsigned;
constexpr int   D = 128, NW = 8, QBLK = 32, KVBLK = 64;
constexpr float SCALE = 0.088388347648318440f;
constexpr float THR = 8.f;
constexpr int LDQ = 3584, LDK = 3584, LDO = 2048;
constexpr size_t SHM_V = KVBLK * D * 2, SHM_K = KVBLK * D * 2, SHM_ATTN = 2 * SHM_V + 2 * SHM_K + NW * 64 * 4;
#define KSWZ(row, colB) ((row) * 256 + ((colB) ^ (((row) & 7) << 4)))
#define SBAR() __builtin_amdgcn_sched_barrier(0)
__device__ __forceinline__ int crow(int r, int hi) { return (r & 3) + 8 * (r >> 2) + 4 * hi; }
__device__ __forceinline__ unsigned cvtpk(float lo, float hi) { unsigned r; asm volatile("v_cvt_pk_bf16_f32 %0, %1, %2" : "=v"(r) : "v"(lo), "v"(hi)); return r; }
__device__ __forceinline__ bf16x8 ld8(const bf16* p) { return *reinterpret_cast<const bf16x8*>(p); }
__device__ __forceinline__ void partialSM(f32x16& p0, f32x16& p1, float& m_reg, float& mn, float& alpha) {
  constexpr float C = SCALE * 1.4426950408889634f;
  float pmax = p0[0]; for (int r = 1; r < 16; ++r) pmax = fmaxf(pmax, p0[r]); for (int r = 0; r < 16; ++r) pmax = fmaxf(pmax, p1[r]);
  { auto rr = __builtin_amdgcn_permlane32_swap(__float_as_uint(pmax), __float_as_uint(pmax), false, false);
    pmax = fmaxf(__uint_as_float(rr[0]), __uint_as_float(rr[1])); }
  if (__builtin_expect(__all(pmax - m_reg <= THR / SCALE), 1)) { mn = m_reg; alpha = 1.f; }
  else { mn = fmaxf(m_reg, pmax); alpha = __builtin_amdgcn_exp2f((m_reg - mn) * C); m_reg = mn; }
  float mnC = -mn * C;
  for (int r = 0; r < 16; ++r) p0[r] = fmaf(p0[r], C, mnC); for (int r = 0; r < 16; ++r) p1[r] = fmaf(p1[r], C, mnC);
  for (int r = 0; r < 16; ++r) p0[r] = __builtin_amdgcn_exp2f(p0[r]);
}
__device__ __forceinline__ void finishSM(f32x16& p0, f32x16& p1, float alpha, float& l_reg, bf16x8& pa0, bf16x8& pa1, bf16x8& pa2, bf16x8& pa3) {
  for (int r = 0; r < 16; ++r) p1[r] = __builtin_amdgcn_exp2f(p1[r]);
  float ps = 0; for (int r = 0; r < 16; ++r) ps += p0[r]; for (int r = 0; r < 16; ++r) ps += p1[r];
  { auto rr = __builtin_amdgcn_permlane32_swap(__float_as_uint(ps), __float_as_uint(ps), false, false);
    ps = __uint_as_float(rr[0]) + __uint_as_float(rr[1]); }
  l_reg = l_reg * alpha + ps;
#define PK4(P, BASE, OUT) do { unsigned a0 = cvtpk(P[BASE + 0], P[BASE + 1]), a1 = cvtpk(P[BASE + 2], P[BASE + 3]);   \
    unsigned b0 = cvtpk(P[BASE + 4], P[BASE + 5]), b1 = cvtpk(P[BASE + 6], P[BASE + 7]);                              \
    auto r0 = __builtin_amdgcn_permlane32_swap(a0, b0, false, false); auto r1 = __builtin_amdgcn_permlane32_swap(a1, b1, false, false); \
    u32x4 w = {r0[0], r1[0], r0[1], r1[1]}; OUT = *reinterpret_cast<bf16x8*>(&w); } while (0)
  PK4(p0, 0, pa0); PK4(p0, 8, pa1); PK4(p1, 0, pa2); PK4(p1, 8, pa3);
#undef PK4
}
__device__ __forceinline__ void qkt(f32x16& p0, f32x16& p1, const bf16* Ks, const bf16x8* qr, int r32, int hi) {
  p0 = f32x16{}; p1 = f32x16{};
  for (int d0 = 0; d0 < 8; ++d0) { int cb = (d0 * 16 + hi * 8) * 2;
    bf16x8 b0 = *reinterpret_cast<const bf16x8*>((const char*)Ks + KSWZ(r32, cb));
    bf16x8 b1 = *reinterpret_cast<const bf16x8*>((const char*)Ks + KSWZ(32 + r32, cb));
    p0 = __builtin_amdgcn_mfma_f32_32x32x16_bf16(b0, qr[d0], p0, 0, 0, 0);
    p1 = __builtin_amdgcn_mfma_f32_32x32x16_bf16(b1, qr[d0], p1, 0, 0, 0); }
}
__device__ __forceinline__ int v_st(int k, int c) { const int kk = (k & ~0xC) | ((k & 4) << 1) | ((k & 8) >> 1); return ((kk >> 3) * 4 + (c >> 5)) * 512 + ((kk & 7) * 32 + (c & 31)) * 2; }
__device__ __forceinline__ int v_rd_base(int lane) { return ((lane & 3) << 3) | (((lane >> 2) & 3) << 6) | (((lane >> 4) & 1) << 5) | (((lane >> 5) & 1) << 8); }
constexpr int v_rd_off(int d0, int ks, int half) { return d0 * 512 + ks * 4096 + half * 2048; }
template <int OFF> __device__ __forceinline__ s16x4 tr_read(int vb) {
  s16x4 r; asm volatile("ds_read_b64_tr_b16 %0, %1 offset:%2" : "=&v"(r) : "v"(vb), "i"(OFF) : "memory"); return r;
}
template <int D0> __device__ __forceinline__ void pv_one(f32x16& od, int vb, bf16x8 pa0, bf16x8 pa1, bf16x8 pa2, bf16x8 pa3) {
  const s16x4 l0 = tr_read<v_rd_off(D0, 0, 0)>(vb), h0 = tr_read<v_rd_off(D0, 0, 1)>(vb), l1 = tr_read<v_rd_off(D0, 1, 0)>(vb), h1 = tr_read<v_rd_off(D0, 1, 1)>(vb);
  const s16x4 l2 = tr_read<v_rd_off(D0, 2, 0)>(vb), h2 = tr_read<v_rd_off(D0, 2, 1)>(vb), l3 = tr_read<v_rd_off(D0, 3, 0)>(vb), h3 = tr_read<v_rd_off(D0, 3, 1)>(vb);
  asm volatile("s_waitcnt lgkmcnt(0)" ::: "memory"); SBAR();
#define PK(L, H) (bf16x8){L[0], L[1], L[2], L[3], H[0], H[1], H[2], H[3]}
  od = __builtin_amdgcn_mfma_f32_32x32x16_bf16(pa0, PK(l0, h0), od, 0, 0, 0);
  od = __builtin_amdgcn_mfma_f32_32x32x16_bf16(pa1, PK(l1, h1), od, 0, 0, 0);
  od = __builtin_amdgcn_mfma_f32_32x32x16_bf16(pa2, PK(l2, h2), od, 0, 0, 0);
  od = __builtin_amdgcn_mfma_f32_32x32x16_bf16(pa3, PK(l3, h3), od, 0, 0, 0);
#undef PK
}
__device__ __forceinline__ void pv_d0(f32x16* o, int vb, bf16x8 pa0, bf16x8 pa1, bf16x8 pa2, bf16x8 pa3) {
  pv_one<0>(o[0], vb, pa0, pa1, pa2, pa3); pv_one<1>(o[1], vb, pa0, pa1, pa2, pa3); pv_one<2>(o[2], vb, pa0, pa1, pa2, pa3); pv_one<3>(o[3], vb, pa0, pa1, pa2, pa3);
}
__device__ __forceinline__ void attn_unit(const bf16* __restrict__ Qb, const bf16* __restrict__ Kh, const bf16* __restrict__ Vh, bf16* __restrict__ Ob, int seq, char* lds, int wave_s,
                                          const float* __restrict__ qg, const float* __restrict__ rope, int t0) {
  constexpr int SDEPTH = 2;
  int tid_ = wave_s * 64 + lane_id(); asm volatile("" : "+v"(tid_));
  const int tid = tid_, wid = tid >> 6, lane = tid & 63, r32 = lane & 31, hi = lane >> 5;
  bf16* V_lds = (bf16*)lds; bf16* K_lds = (bf16*)(lds + 2 * SHM_V);
  float* ws = (float*)(lds + 2 * SHM_V + 2 * SHM_K) + wid * 64; float* li_l = ws; float* al_l = ws + 32;
  float m_reg = -1e30f, l_reg = 0; f32x16 o[4] = {}; bf16x8 qr[8];
  const bf16* Qw = Qb + (long)(wid * QBLK + r32) * LDQ + hi * 8;
  {
    float qf[8][8]; float ss = 0.f;
#pragma unroll
    for (int d0 = 0; d0 < 8; ++d0) { const bf16x8 raw = ld8(Qw + d0 * 16);
#pragma unroll
      for (int e = 0; e < 8; ++e) { qf[d0][e] = __uint_as_float(((unsigned)(unsigned short)raw[e]) << 16); ss += qf[d0][e] * qf[d0][e]; } }
    ss += __shfl_xor(ss, 32);
    const float rr = 1.0f / sqrtf(ss * (1.0f / 128.0f) + 1e-6f);
#pragma unroll
    for (int d0 = 0; d0 < 8; ++d0) { const float* gp = qg + d0 * 16 + hi * 8;
#pragma unroll
      for (int e = 0; e < 8; ++e) qf[d0][e] = qf[d0][e] * rr * gp[e]; }
    if (rope != nullptr) {
      const int t = t0 + wid * QBLK + r32, rowc = t >> 6, colc = t & 63;
#pragma unroll
      for (int pr = 0; pr < 4; ++pr) { const int d0 = (pr & 1) + (pr >> 1) * 4;
        const float* cs = rope + ((pr >> 1) ? colc : rowc) * 32 + (d0 & 1) * 16 + hi * 8; const float* sn = cs + 2048;
#pragma unroll
        for (int e = 0; e < 8; ++e) { const float c = cs[e], s = sn[e], x1 = qf[d0][e], x2 = qf[d0 + 2][e]; qf[d0][e] = x1 * c - x2 * s; qf[d0 + 2][e] = x1 * s + x2 * c; } }
    }
#pragma unroll
    for (int d0 = 0; d0 < 8; ++d0) { u32x4 w = {cvtpk(qf[d0][0], qf[d0][1]), cvtpk(qf[d0][2], qf[d0][3]), cvtpk(qf[d0][4], qf[d0][5]), cvtpk(qf[d0][6], qf[d0][7])}; qr[d0] = *reinterpret_cast<bf16x8*>(&w); }
  }
  const int sr = tid >> 4, sc = (tid & 15) * 8, vst0 = v_st(sr, sc), vst1 = v_st(32 + sr, sc);
  const int vb0 = (int)(uintptr_t)V_lds + v_rd_base(lane);
  struct { bf16x8 vs0, vs1, ks0, ks1; } sr_[SDEPTH];
#define SLOAD(i, k0) do { sr_[i].vs0 = ld8(&Vh[(long)((k0) + sr) * LDK + sc]); sr_[i].vs1 = ld8(&Vh[(long)((k0) + 32 + sr) * LDK + sc]); \
    sr_[i].ks0 = ld8(&Kh[(long)((k0) + sr) * LDK + sc]); sr_[i].ks1 = ld8(&Kh[(long)((k0) + 32 + sr) * LDK + sc]); } while (0)
#define SWRITE(b, i) do { *(bf16x8*)((char*)V_lds + (b) * SHM_V + vst0) = sr_[i].vs0;          \
    *(bf16x8*)((char*)V_lds + (b) * SHM_V + vst1) = sr_[i].vs1; int kc = sc * 2;               \
    *(bf16x8*)((char*)K_lds + (b) * SHM_K + KSWZ(sr, kc)) = sr_[i].ks0;                       \
    *(bf16x8*)((char*)K_lds + (b) * SHM_K + KSWZ(32 + sr, kc)) = sr_[i].ks1; } while (0)
#define SWAIT() asm volatile("s_waitcnt vmcnt(4)" ::: "memory")
#define RESC(a) do { if (__any((a) < 1.f)) { if (hi == 0) al_l[r32] = (a); asm volatile("s_waitcnt lgkmcnt(0)" ::: "memory"); \
    for (int d = 0; d < 4; ++d) for (int r = 0; r < 16; ++r) o[d][r] *= al_l[crow(r, hi)]; } } while (0)
  f32x16 pA0, pA1, pB0, pB1; float mnA, mnB, alA, alB; bf16x8 pa0, pa1, pa2, pa3; const int NT = seq / KVBLK;
  constexpr int SE = 0, SO = SDEPTH - 1;
  SLOAD(SE, 0); asm volatile("s_waitcnt vmcnt(0)" ::: "memory"); SWRITE(0, SE); __syncthreads();
  qkt(pA0, pA1, K_lds, qr, r32, hi); partialSM(pA0, pA1, m_reg, mnA, alA);
  SLOAD(SO, KVBLK); if (2 < NT) SLOAD(SE, 2 * KVBLK);
  SWAIT(); SWRITE(1, SO); __syncthreads();
  for (int j = 1; j + 1 < NT; j += 2) {
    SBAR(); qkt(pB0, pB1, (bf16*)((char*)K_lds + SHM_K), qr, r32, hi);
    finishSM(pA0, pA1, alA, l_reg, pa0, pa1, pa2, pa3); SBAR();
    SLOAD(SO, (j + SDEPTH) * KVBLK); SBAR();
    pv_d0(o, vb0, pa0, pa1, pa2, pa3); partialSM(pB0, pB1, m_reg, mnB, alB);
    __syncthreads(); SWAIT(); SWRITE(0, SE);
    RESC(alB); __syncthreads();
    SBAR(); qkt(pA0, pA1, K_lds, qr, r32, hi);
    finishSM(pB0, pB1, alB, l_reg, pa0, pa1, pa2, pa3); SBAR();
    if (j + 3 < NT) SLOAD(SE, (j + 1 + SDEPTH) * KVBLK); SBAR();
    pv_d0(o, vb0 + (int)SHM_V, pa0, pa1, pa2, pa3); partialSM(pA0, pA1, m_reg, mnA, alA);
    __syncthreads(); SWAIT(); SWRITE(1, SO);
    RESC(alA); __syncthreads();
  }
  SBAR(); qkt(pB0, pB1, (bf16*)((char*)K_lds + SHM_K), qr, r32, hi);
  finishSM(pA0, pA1, alA, l_reg, pa0, pa1, pa2, pa3); SBAR();
  pv_d0(o, vb0, pa0, pa1, pa2, pa3); partialSM(pB0, pB1, m_reg, mnB, alB);
  __syncthreads(); RESC(alB);
  finishSM(pB0, pB1, alB, l_reg, pa0, pa1, pa2, pa3); SBAR();
  pv_d0(o, vb0 + (int)SHM_V, pa0, pa1, pa2, pa3);
  if (hi == 0) li_l[r32] = l_reg; asm volatile("s_waitcnt lgkmcnt(0)" ::: "memory");
  float rli[16];
#pragma unroll
  for (int r = 0; r < 16; ++r) rli[r] = __builtin_amdgcn_rcpf(li_l[crow(r, hi)]);
  bf16* Ow = Ob + (long)(wid * QBLK) * LDO;
#pragma unroll
  for (int r = 0; r < 16; ++r) { int orow = crow(r, hi);
    for (int d0 = 0; d0 < 4; ++d0) { const float v = o[d0][r] * rli[r]; unsigned u = __float_as_uint(v); u = (u + 0x7fffu + ((u >> 16) & 1u)) >> 16;
      Ow[(long)orow * LDO + d0 * 32 + r32] = (bf16)u; } }
  __syncthreads();
#undef SLOAD
#undef SWRITE
#undef SWAIT
#undef RESC
}
#undef KSWZ
#undef SBAR
}
constexpr int DM = 2048, NB = 8, SEQ = 4096, CTXL = 256, DEPTH = 4;
constexpr int TPB = SEQ + CTXL;
constexpr int M = NB * TPB;
constexpr int ZW = 3584, FF = 5632, NMOD = 6 * DM;
constexpr int CONVW = 512, SSMW = 512, ATTW = 1024, NG = 32, NP = 64, NSG = 16;
constexpr int Z_CV = 0, Z_CB = 512, Z_CC = 1024, Z_SSM = 1536, Z_Q = 2048, Z_K = 3072, Z_V = 3328;
constexpr int MIX_CONV = 0, MIX_SSM = 512, MIX_ATT = 1024;
constexpr float RMS_EPS = 1e-6f;
constexpr int NWAVES = 8;
#ifndef REP_MASK
#define REP_MASK 0
#endif
#define NREP(b) (1 + ((REP_MASK >> (b)) & 1))

constexpr size_t MiB = 1u << 20;
constexpr size_t WS_CTL = 0, CTL_ZERO_BYTES = 1 * MiB;
constexpr size_t WS_MODP = 1 * MiB;
constexpr size_t WS_MOD  = 15 * MiB;
constexpr size_t WS_ROPE = 17 * MiB;
constexpr size_t WS_BBAR = 18 * MiB;
constexpr size_t WS_POW  = 20 * MiB;
constexpr size_t WS_KT   = 25 * MiB;
constexpr size_t WS_W    = 33 * MiB, W_LAYER = 89 * MiB;
constexpr size_t W_IN = 0, W_OUT = 14 * MiB, W_GU = 22 * MiB, W_DOWN = 66 * MiB, W_GLU = 88 * MiB;
constexpr size_t WS_TW   = WS_W + 4 * W_LAYER;
constexpr size_t WS_W1   = WS_TW + 96 * MiB;
constexpr size_t WS_X    = WS_W1 + 32 * MiB;
constexpr size_t WS_H    = WS_X + 272 * MiB;
constexpr size_t WS_Y    = WS_H + 136 * MiB;
constexpr size_t WS_UH   = WS_Y, WS_SB = WS_Y + 60 * MiB;
constexpr size_t WS_Z    = WS_Y + 136 * MiB;
constexpr size_t WS_MIX  = WS_Z + 238 * MiB;
constexpr size_t WS_ACT  = WS_Z;
constexpr size_t WS_G    = WS_MIX + 136 * MiB;
constexpr size_t WS_YP   = WS_G + 34 * MiB;
constexpr size_t WS_END  = WS_YP + 64 * MiB;
static_assert((size_t)M * DM * 4 == 272 * MiB && (size_t)M * ZW * 2 == 238 * MiB && (size_t)M * FF * 2 == 374 * MiB && (size_t)32 * SSM_RPG * UH_LD * 2 == 60 * MiB && (size_t)32 * SSM_RPG * 256 * 4 == 40 * MiB, "ws map");
static_assert(WS_END <= 1536 * MiB, "ws budget");
constexpr int CW_BAR = 4096;

constexpr int RING_OFF = 0, RING_BYTES = 131072;
constexpr int LDSCTL_OFF = RING_BYTES, MISC_OFF = LDSCTL_OFF + 320;
constexpr int LDS_BYTES = 147456;

#define GAS __attribute__((address_space(1)))
#define LAS __attribute__((address_space(3)))
typedef unsigned short bf16;
typedef unsigned v4u __attribute__((ext_vector_type(4)));
typedef unsigned v2u __attribute__((ext_vector_type(2)));
typedef float f32x4 __attribute__((ext_vector_type(4)));
typedef float f32x2 __attribute__((ext_vector_type(2)));
#define LDS_WAIT() asm volatile("s_waitcnt lgkmcnt(0)" ::: "memory")
#define VM_WAIT() asm volatile("s_waitcnt vmcnt(0)" ::: "memory")
__device__ __forceinline__ unsigned f2bf(float f) { unsigned u = __builtin_bit_cast(unsigned, f); return (u + 0x7fffu + ((u >> 16) & 1u)) >> 16; }
__device__ __forceinline__ unsigned pk2(float lo, float hi) { return f2bf(lo) | (f2bf(hi) << 16); }
__device__ __forceinline__ float blo(unsigned w) { return __uint_as_float(w << 16); }
__device__ __forceinline__ float bhi(unsigned w) { return __uint_as_float(w & 0xffff0000u); }
__device__ __forceinline__ float wave_sum(float v) {
#pragma unroll
    for (int o = 1; o < 64; o <<= 1) v += __shfl_xor(v, o);
    return v;
}

#define XB_TMO      128
#define XB_XCNT(j)  (256  + 64 * (j))
#define XB_XSUB(j)  (1280 + 64 * (j))
#define XB_XGEN(j)  (2304 + 64 * (j))
#define XB_TOP      3328
#define XB_TOPGEN   3392
#define XCD_BAR_WORDS 3456
#define XB_SPIN_CAP (1u << 18)

__device__ __forceinline__ unsigned xb_ld(unsigned* p)              { return __hip_atomic_load(p, __ATOMIC_RELAXED, __HIP_MEMORY_SCOPE_AGENT); }
__device__ __forceinline__ unsigned xb_add(unsigned* p, unsigned v) { return __hip_atomic_fetch_add(p, v, __ATOMIC_RELAXED, __HIP_MEMORY_SCOPE_AGENT); }
__device__ __forceinline__ unsigned xb_xcc_id() { return (unsigned)__builtin_amdgcn_s_getreg((3 << 11) | 20) & 0xFu; }
#define XB_SPIN(cond, bar) do { unsigned _sp = 0; while (cond) { __builtin_amdgcn_s_sleep(1); \
    if ((++_sp & 255u) == 0u) { if (xb_ld(&(bar)[XB_TMO])) break; if (_sp > XB_SPIN_CAP) { atomicAdd(&(bar)[XB_TMO], 1u); break; } } } } while (0)

struct XcdBarrier {
    unsigned* bar; unsigned x;
    volatile LAS unsigned* st;
};

__device__ __forceinline__ XcdBarrier xcd_barrier_post(unsigned* bar, volatile LAS unsigned* st, bool leader  ) {
    XcdBarrier b; b.bar = bar; b.x = xb_xcc_id(); b.st = st;
    if (leader) (void)xb_add(&bar[XB_XCNT(b.x)], 1u);
    return b;
}
__device__ __forceinline__ void xcd_barrier_complete(unsigned* bar, unsigned x, unsigned& nloc, unsigned& nx) {
    const unsigned G = gridDim.x * gridDim.y * gridDim.z;
    unsigned sum, cnt, mine, sp = 0u;
    for (;;) {
        sum = 0u; cnt = 0u; mine = 0u;
#pragma unroll
        for (unsigned j = 0; j < 16; ++j) { const unsigned c = xb_ld(&bar[XB_XCNT(j)]); sum += c; cnt += (c > 0u) ? 1u : 0u; mine = (j == x) ? c : mine; }
        if (sum == G) break;
        __builtin_amdgcn_s_sleep(1);
        if ((++sp & 255u) == 0u) { if (xb_ld(&bar[XB_TMO])) break; if (sp > XB_SPIN_CAP) { atomicAdd(&bar[XB_TMO], 1u); break; } }
    }
    nloc = mine > 0u ? mine : 1u; nx = cnt > 0u ? cnt : 1u;
}

__device__ __forceinline__ void xcd_barrier(const XcdBarrier& b, bool leader  ) {
    asm volatile("s_waitcnt vmcnt(0)" ::: "memory");
    __syncthreads();
    if (leader) {
        unsigned* bar = b.bar;
        __builtin_amdgcn_s_waitcnt(0);
        unsigned nloc = b.st[0], nx = b.st[1];
        if (nloc == 0u) { xcd_barrier_complete(bar, b.x, nloc, nx); b.st[0] = nloc; b.st[1] = nx; }
        const unsigned old = xb_add(&bar[XB_XSUB(b.x)], 1u);
        const unsigned gen = old / nloc;
        if (old + 1u == (gen + 1u) * nloc) {
            __builtin_amdgcn_fence(__ATOMIC_RELEASE, "agent");
            asm volatile("s_waitcnt vmcnt(0)" ::: "memory");
            const unsigned og = xb_add(&bar[XB_TOP], 1u);
            const unsigned tg = og / nx;
            if (og + 1u == (tg + 1u) * nx) xb_add(&bar[XB_TOPGEN], 1u);
            else XB_SPIN(xb_ld(&bar[XB_TOPGEN]) == tg, bar);
            __builtin_amdgcn_fence(__ATOMIC_ACQUIRE, "agent");
            xb_add(&bar[XB_XGEN(b.x)], 1u);
            asm volatile("s_waitcnt vmcnt(0)" ::: "memory");
        } else {
            XB_SPIN(xb_ld(&bar[XB_XGEN(b.x)]) == gen, bar);
            __builtin_amdgcn_fence(__ATOMIC_ACQUIRE, "agent");
            asm volatile("s_waitcnt vmcnt(0)" ::: "memory");
        }
    }
    __syncthreads();
}

struct Params { const float* in[28]; float* out; unsigned char* ws; int ph_lo, ph_hi; };
typedef const __attribute__((address_space(4))) Params* KP;
__device__ __forceinline__ KP kparams() { KP kp = (KP)__builtin_amdgcn_kernarg_segment_ptr(); asm volatile("" : "+s"(kp)); return kp; }
enum { I_X = 0, I_C, I_CTX, I_CCTX, I_WMOD, I_BMOD, I_GPREMIX, I_GPOSTMIX, I_GPREFFN, I_GPOSTFFN, I_WIN, I_CONVW, I_LAMRE, I_LAMIM, I_LOGDT, I_BRE, I_BIM, I_CRE, I_CIM,
       I_SSMD, I_WGLU, I_BGLU, I_QNORM, I_KNORM, I_WOUT, I_WGATE, I_WUP, I_WDOWN };

__device__ __forceinline__ void transpose_item(const float* __restrict__ W, int K, int N, bf16* WT, int k0, int n0, int dst_row0, LAS float* scr, int lane) {
#pragma unroll 8
    for (int i = 0; i < 32; ++i) { const int kk = 2 * i + (lane >> 5); scr[kk * 33 + (lane & 31)] = W[(size_t)(k0 + kk) * N + n0 + (lane & 31)]; }
    LDS_WAIT(); asm volatile("" ::: "memory");
    const int c = lane & 7;
#pragma unroll
    for (int j = 0; j < 4; ++j) { const int n = (lane >> 3) + 8 * j; const LAS float* s = scr + (8 * c) * 33 + n;
        v4u o; o.x = pk2(s[0 * 33], s[1 * 33]); o.y = pk2(s[2 * 33], s[3 * 33]); o.z = pk2(s[4 * 33], s[5 * 33]); o.w = pk2(s[6 * 33], s[7 * 33]);
        *(GAS v4u*)(WT + (size_t)(dst_row0 + n) * K + k0 + 8 * c) = o; }
    LDS_WAIT(); asm volatile("" ::: "memory");
}
constexpr int IT_MOD = DEPTH * 8 * 48;
constexpr int IT_ROPE = 32, IT_SSM = 256;
constexpr int TPL_IN = 32 * 112, TPL_OUT = 32 * 64, TPL_G = 32 * 176, TPL_D = 88 * 64, TPL_GLU = 8 * 16;
constexpr int TPL = TPL_IN + TPL_OUT + 2 * TPL_G + TPL_D + TPL_GLU;
constexpr int IT_TOTAL = IT_MOD + IT_ROPE + IT_SSM + DEPTH * TPL;

__device__ __forceinline__ void prologue_a(KP P, LAS unsigned char* lds, int wave, int lane) {
    LAS float* scr = (LAS float*)(lds + RING_OFF + wave * 16384);
    const int G = gridDim.x, gw = wave * G + (int)blockIdx.x, NGW = NWAVES * G;
    unsigned char* ws = P->ws;
    for (int it = gw; it < IT_TOTAL; it += NGW) {
        int r = it;
        if (r < IT_MOD) {
            const int l = r / 384, kc = (r % 384) / 48, nc = r % 48;
#pragma unroll
            for (int j = 0; j < 9; ++j)
#pragma unroll
                for (int q = 0; q < 4; ++q) { const int kk = q * 64 + lane, k = kc * 256 + kk;
                    const float cv = (j < 8) ? P->in[I_C][j * DM + k] : P->in[I_CCTX][k];
                    scr[j * 256 + kk] = cv / (1.0f + __expf(-cv)); }
            LDS_WAIT(); asm volatile("" ::: "memory");
            f32x4 acc[9];
#pragma unroll
            for (int j = 0; j < 9; ++j) acc[j] = (f32x4){0.f, 0.f, 0.f, 0.f};
            const float* wp = P->in[I_WMOD] + ((size_t)l * DM + kc * 256) * NMOD + nc * 256 + lane * 4;
#pragma unroll 4
            for (int kk = 0; kk < 256; ++kk) { const f32x4 w = *(const f32x4*)(wp + (size_t)kk * NMOD);
#pragma unroll
                for (int j = 0; j < 9; ++j) { const float s = scr[j * 256 + kk]; acc[j] += w * s; } }
            float* mp = (float*)(ws + WS_MODP) + ((size_t)(kc * DEPTH + l) * 9) * NMOD + nc * 256 + lane * 4;
#pragma unroll
            for (int j = 0; j < 9; ++j) *(f32x4*)(mp + (size_t)j * NMOD) = acc[j];
            LDS_WAIT(); asm volatile("" ::: "memory");
            continue;
        }
        r -= IT_MOD;
        if (r < IT_ROPE) {
            const int e = r * 64 + lane, coord = e >> 5, i = e & 31;
            const double inv = exp(-(double)i * (9.210340371976184 / 32.0));
            const double ang = (double)coord * inv;
            float* rp = (float*)(ws + WS_ROPE);
            rp[e] = (float)cos(ang); rp[2048 + e] = (float)sin(ang);
            continue;
        }
        r -= IT_ROPE;
        if (r < IT_SSM) {
            const int idx = r * 64 + lane;
            const int p = idx & 63, ldg = idx >> 6;
            const double lre = (double)P->in[I_LAMRE][idx], lim = (double)P->in[I_LAMIM][idx];
            const double dt = exp((double)P->in[I_LOGDT][ldg]);
            const double ea = exp(lre * dt), th = lim * dt;
            const double lbre = ea * cos(th), lbim = ea * sin(th);
            const double nr = lbre - 1.0, ni = lbim, dd = lre * lre + lim * lim;
            const double qre = (nr * lre + ni * lim) / dd, qim = (ni * lre - nr * lim) / dd;
            f32x2* bb = (f32x2*)(ws + WS_BBAR) + (size_t)idx * 16;
#pragma unroll
            for (int n = 0; n < 16; ++n) {
                const double bre = (double)P->in[I_BRE][(size_t)idx * 16 + n], bim = (double)P->in[I_BIM][(size_t)idx * 16 + n];
                bb[n] = (f32x2){(float)(qre * bre - qim * bim), (float)(qre * bim + qim * bre)};
            }
            f32x2* pw = (f32x2*)(ws + WS_POW) + (size_t)ldg * 33 * 64 + p;
            for (int e = 0; e <= 32; ++e) { const double m = exp(lre * dt * (double)e), a = th * (double)e; pw[e * 64] = (f32x2){(float)(m * cos(a)), (float)(m * sin(a))}; }
            continue;
        }
        r -= IT_SSM;
        const int l = r / TPL; r -= l * TPL;
        bf16* wl = (bf16*)(ws + WS_W + (size_t)l * W_LAYER);
        if (r < TPL_IN) { const int kb = r / 112, nb = r % 112; transpose_item(P->in[I_WIN] + (size_t)l * DM * ZW, DM, ZW, (bf16*)((unsigned char*)wl + W_IN), 64 * kb, 32 * nb, 32 * nb, scr, lane); continue; }
        r -= TPL_IN;
        if (r < TPL_OUT) { const int kb = r / 64, nb = r % 64; transpose_item(P->in[I_WOUT] + (size_t)l * DM * DM, DM, DM, (bf16*)((unsigned char*)wl + W_OUT), 64 * kb, 32 * nb, 32 * nb, scr, lane); continue; }
        r -= TPL_OUT;
        if (r < 2 * TPL_G) { const int up = r >= TPL_G; if (up) r -= TPL_G; const int kb = r / 176, nb = r % 176, n0 = 32 * nb;
            transpose_item(P->in[up ? I_WUP : I_WGATE] + (size_t)l * DM * FF, DM, FF, (bf16*)((unsigned char*)wl + W_GU), 64 * kb, n0, (n0 >> 7) * 256 + (n0 & 127) + (up ? 128 : 0), scr, lane); continue; }
        r -= 2 * TPL_G;
        if (r < TPL_D) { const int kb = r / 64, nb = r % 64; transpose_item(P->in[I_WDOWN] + (size_t)l * FF * DM, FF, DM, (bf16*)((unsigned char*)wl + W_DOWN), 64 * kb, 32 * nb, 32 * nb, scr, lane); continue; }
        r -= TPL_D;
        { const int kb = r / 16, nb = r % 16; transpose_item(P->in[I_WGLU] + (size_t)l * 512 * 512, 512, 512, (bf16*)((unsigned char*)wl + W_GLU), 64 * kb, 32 * nb, 32 * nb, scr, lane); }
    }
}
__device__ __forceinline__ void prologue_b(KP P, int tid) {
    const int total = DEPTH * 9 * NMOD;
    const float* mp = (const float*)(P->ws + WS_MODP); float* mo = (float*)(P->ws + WS_MOD);
    for (int idx = (int)blockIdx.x * 512 + tid; idx < total; idx += (int)gridDim.x * 512) {
        const int l = idx / (9 * NMOD), n = idx % NMOD;
        float s = P->in[I_BMOD][l * NMOD + n];
#pragma unroll
        for (int kc = 0; kc < 8; ++kc) s += mp[(size_t)kc * total + idx];
        const int ch = n / DM, col = n - ch * DM;
        if (ch == 1) s = P->in[I_GPREMIX][l * DM + col] * (1.0f + s);
        else if (ch == 2) s = s * P->in[I_GPOSTMIX][l * DM + col];
        else if (ch == 4) s = P->in[I_GPREFFN][l * DM + col] * (1.0f + s);
        else if (ch == 5) s = s * P->in[I_GPOSTFFN][l * DM + col];
        mo[idx] = s;
    }
}

__device__ __forceinline__ void prologue_kt(KP P, int tid) {
    const f32x2* pw = (const f32x2*)(P->ws + WS_POW); const f32x2* bbar = (const f32x2*)(P->ws + WS_BBAR); float* kt = (float*)(P->ws + WS_KT);
    for (int idx = (int)blockIdx.x * 512 + tid; idx < DEPTH * 32 * 2 * 32 * 16; idx += (int)gridDim.x * 512) {
        const int no = idx & 15, tau = (idx >> 4) & 31, dir = (idx >> 9) & 1, g = (idx >> 10) & 31, l = idx >> 15;
        const int ldg = (l * 2 + dir) * 32 + g;
        float acc[16];
#pragma unroll
        for (int n = 0; n < 16; ++n) acc[n] = 0.f;
        for (int p = 0; p < 64; ++p) {
            const float cre = P->in[I_CRE][((size_t)ldg * 16 + no) * 64 + p], cim = P->in[I_CIM][((size_t)ldg * 16 + no) * 64 + p];
            const f32x2 w = pw[((size_t)ldg * 33 + tau) * 64 + p];
            const float are = cre * w[0] - cim * w[1], aim = cre * w[1] + cim * w[0];
            const f32x4* bp = (const f32x4*)(bbar + ((size_t)ldg * 64 + p) * 16);
#pragma unroll
            for (int q = 0; q < 8; ++q) { const f32x4 b2 = bp[q]; acc[2 * q] += are * b2[0] - aim * b2[1]; acc[2 * q + 1] += are * b2[2] - aim * b2[3]; }
        }
#pragma unroll
        for (int q = 0; q < 4; ++q) *(f32x4*)(kt + (size_t)idx * 16 + q * 4) = (f32x4){acc[q * 4], acc[q * 4 + 1], acc[q * 4 + 2], acc[q * 4 + 3]};
    }
}
__device__ __forceinline__ void prologue_s5w(KP P, int tid) {
    const f32x2* pw = (const f32x2*)(P->ws + WS_POW); const f32x2* bbar = (const f32x2*)(P->ws + WS_BBAR); const float* kt = (const float*)(P->ws + WS_KT);
    bf16* TW = (bf16*)(P->ws + WS_TW); bf16* W1 = (bf16*)(P->ws + WS_W1);
    for (int it = (int)blockIdx.x * 512 + tid; it < DEPTH * 32 * 65536; it += (int)gridDim.x * 512) {
        const int lg = it >> 16, l = lg >> 5, g = lg & 31; int r = it & 65535; float v[8];
        if (r < 49152) {
            const int row = r / 96, ch = r - row * 96, t = row >> 4, no = row & 15, k0 = ch * 8;
            if (k0 < 512) {
                const int s = k0 >> 4, ni0 = k0 & 15;
#pragma unroll
                for (int e = 0; e < 8; ++e) v[e] = 0.f;
                if (t >= s) { const float* kp = kt + ((((size_t)(l * 32 + g) * 2 + 0) * 32 + (t - s)) * 16 + no) * 16 + ni0;
#pragma unroll
                    for (int e = 0; e < 8; ++e) v[e] += kp[e]; }
                if (s >= t) { const float* kp = kt + ((((size_t)(l * 32 + g) * 2 + 1) * 32 + (s - t)) * 16 + no) * 16 + ni0;
#pragma unroll
                    for (int e = 0; e < 8; ++e) v[e] += kp[e]; }
                if (t == s) { const float dv = P->in[I_SSMD][l * SSMW + g * NSG + no];
#pragma unroll
                    for (int e = 0; e < 8; ++e) if (ni0 + e == no) v[e] += dv; }
            } else {
                const int kk = k0 - 512, dir = kk >> 7, part = (kk >> 6) & 1, p0 = kk & 63, ep = dir == 0 ? t + 1 : 32 - t, ldg = (l * 2 + dir) * 32 + g;
#pragma unroll
                for (int e = 0; e < 8; ++e) { const int p = p0 + e; const f32x2 w = pw[((size_t)ldg * 33 + ep) * 64 + p];
                    const float cre = P->in[I_CRE][((size_t)ldg * 16 + no) * 64 + p], cim = P->in[I_CIM][((size_t)ldg * 16 + no) * 64 + p];
                    v[e] = part == 0 ? (cre * w[0] - cim * w[1]) : -(cre * w[1] + cim * w[0]); }
            }
            v4u o; o.x = pk2(v[0], v[1]); o.y = pk2(v[2], v[3]); o.z = pk2(v[4], v[5]); o.w = pk2(v[6], v[7]);
            *(v4u*)(TW + ((size_t)lg * 512 + row) * 768 + k0) = o;
        } else {
            r -= 49152;
            const int r1 = r >> 6, ch = r & 63, dir = r1 >> 7, part = (r1 >> 6) & 1, p = r1 & 63, k0 = ch * 8, s = k0 >> 4, n0 = k0 & 15, ep = dir == 0 ? 31 - s : s, ldg = (l * 2 + dir) * 32 + g;
            const f32x2 w = pw[((size_t)ldg * 33 + ep) * 64 + p]; const f32x2* bp = bbar + ((size_t)ldg * 64 + p) * 16 + n0;
#pragma unroll
            for (int e = 0; e < 8; ++e) { const f32x2 b2 = bp[e]; v[e] = part == 0 ? (w[0] * b2[0] - w[1] * b2[1]) : (w[0] * b2[1] + w[1] * b2[0]); }
            v4u o; o.x = pk2(v[0], v[1]); o.y = pk2(v[2], v[3]); o.z = pk2(v[4], v[5]); o.w = pk2(v[6], v[7]);
            *(v4u*)(W1 + ((size_t)lg * 256 + r1) * 512 + k0) = o;
        }
    }
}

struct Thin {
    int init, fin;
    const float* x_lat; const float* x_ctx; const bf16* X; bf16* Xout; const bf16* Y; bf16* H; float* OUT;
    const float* modg; int gc;
    const float* mods; int sc;
    const float* YP; int ctx_mode;
};
__device__ __forceinline__ void thin_rows(const Thin& T, int wave, int lane) {
    const int G = gridDim.x;
    for (int r = (int)blockIdx.x * NWAVES + wave; r < M; r += G * NWAVES) {
        const int b = r / TPB, p = r - b * TPB, j = (p < CTXL) ? 8 : b;
        if ((T.fin || T.ctx_mode == 0) && p < CTXL) continue;
        float x[32], y[32];
        f32x4 ga[8], mu[8], sh[8];
        const float* gate = T.init ? nullptr : T.modg + (size_t)(j * 6 + T.gc) * DM;
        const float* shift = T.mods + (size_t)(j * 6 + T.sc) * DM; const float* mul = shift + DM;
        if (T.init) {
            const float* xsrc = (p < CTXL) ? T.x_ctx + ((size_t)b * CTXL + p) * DM : T.x_lat + ((size_t)b * SEQ + (p - CTXL)) * DM;
#pragma unroll
            for (int c = 0; c < 4; ++c) { const f32x4 a = *(const f32x4*)(xsrc + c * 512 + lane * 8), d = *(const f32x4*)(xsrc + c * 512 + lane * 8 + 4);
                x[c * 8 + 0] = a[0]; x[c * 8 + 1] = a[1]; x[c * 8 + 2] = a[2]; x[c * 8 + 3] = a[3]; x[c * 8 + 4] = d[0]; x[c * 8 + 5] = d[1]; x[c * 8 + 6] = d[2]; x[c * 8 + 7] = d[3]; }
        } else {
            v4u xw[4], yw[4];
#pragma unroll
            for (int c = 0; c < 4; ++c) xw[c] = *(const v4u*)(T.X + (size_t)r * DM + c * 512 + lane * 8);
            if (p < CTXL && T.ctx_mode == 2) {
#pragma unroll
                for (int e = 0; e < 32; ++e) y[e] = 0.f;
#pragma unroll
                for (int q = 0; q < 4; ++q) { const float* yp = T.YP + ((size_t)q * 2048 + b * CTXL + p) * DM;
#pragma unroll
                    for (int c = 0; c < 4; ++c) { const f32x4 a = *(const f32x4*)(yp + c * 512 + lane * 8), d = *(const f32x4*)(yp + c * 512 + lane * 8 + 4);
                        y[c * 8 + 0] += a[0]; y[c * 8 + 1] += a[1]; y[c * 8 + 2] += a[2]; y[c * 8 + 3] += a[3]; y[c * 8 + 4] += d[0]; y[c * 8 + 5] += d[1]; y[c * 8 + 6] += d[2]; y[c * 8 + 7] += d[3]; } }
            } else {
#pragma unroll
                for (int c = 0; c < 4; ++c) yw[c] = *(const v4u*)(T.Y + (size_t)r * DM + c * 512 + lane * 8);
#pragma unroll
                for (int c = 0; c < 4; ++c) { const v4u w = yw[c];
                    y[c * 8 + 0] = blo(w.x); y[c * 8 + 1] = bhi(w.x); y[c * 8 + 2] = blo(w.y); y[c * 8 + 3] = bhi(w.y); y[c * 8 + 4] = blo(w.z); y[c * 8 + 5] = bhi(w.z); y[c * 8 + 6] = blo(w.w); y[c * 8 + 7] = bhi(w.w); }
            }
#pragma unroll
            for (int c = 0; c < 4; ++c) { ga[2 * c] = *(const f32x4*)(gate + c * 512 + lane * 8); ga[2 * c + 1] = *(const f32x4*)(gate + c * 512 + lane * 8 + 4); }
#pragma unroll
            for (int c = 0; c < 4; ++c) { const v4u w = xw[c];
                x[c * 8 + 0] = blo(w.x); x[c * 8 + 1] = bhi(w.x); x[c * 8 + 2] = blo(w.y); x[c * 8 + 3] = bhi(w.y); x[c * 8 + 4] = blo(w.z); x[c * 8 + 5] = bhi(w.z); x[c * 8 + 6] = blo(w.w); x[c * 8 + 7] = bhi(w.w); }
        }
        if (!T.fin) {
#pragma unroll
            for (int c = 0; c < 4; ++c) { mu[2 * c] = *(const f32x4*)(mul + c * 512 + lane * 8); mu[2 * c + 1] = *(const f32x4*)(mul + c * 512 + lane * 8 + 4);
                sh[2 * c] = *(const f32x4*)(shift + c * 512 + lane * 8); sh[2 * c + 1] = *(const f32x4*)(shift + c * 512 + lane * 8 + 4); }
        }
        if (!T.init) {
            float ss = 0.f;
#pragma unroll
            for (int e = 0; e < 32; ++e) ss += y[e] * y[e];
            ss = wave_sum(ss);
            const float r1 = 1.0f / sqrtf(ss * (1.0f / DM) + RMS_EPS);
#pragma unroll
            for (int e = 0; e < 32; ++e) x[e] += ga[e >> 2][e & 3] * (y[e] * r1);
        }
        if (T.fin) {
            float* o = T.OUT + ((size_t)b * SEQ + (p - CTXL)) * DM;
#pragma unroll
            for (int c = 0; c < 4; ++c) { *(f32x4*)(o + c * 512 + lane * 8) = (f32x4){x[c * 8 + 0], x[c * 8 + 1], x[c * 8 + 2], x[c * 8 + 3]}; *(f32x4*)(o + c * 512 + lane * 8 + 4) = (f32x4){x[c * 8 + 4], x[c * 8 + 5], x[c * 8 + 6], x[c * 8 + 7]}; }
            continue;
        }
        float ss2 = 0.f;
#pragma unroll
        for (int e = 0; e < 32; ++e) ss2 += x[e] * x[e];
        ss2 = wave_sum(ss2);
        const float r2 = 1.0f / sqrtf(ss2 * (1.0f / DM) + RMS_EPS);
        bf16* xo = T.Xout + (size_t)r * DM; bf16* ho = T.H + (size_t)r * DM;
#pragma unroll
        for (int c = 0; c < 4; ++c) {
            v4u w; w.x = pk2(x[c * 8 + 0], x[c * 8 + 1]); w.y = pk2(x[c * 8 + 2], x[c * 8 + 3]); w.z = pk2(x[c * 8 + 4], x[c * 8 + 5]); w.w = pk2(x[c * 8 + 6], x[c * 8 + 7]); *(v4u*)(xo + c * 512 + lane * 8) = w;
            float hv[8];
#pragma unroll
            for (int e = 0; e < 8; ++e) hv[e] = (x[c * 8 + e] * r2) * mu[2 * c + (e >> 2)][e & 3] + sh[2 * c + (e >> 2)][e & 3];
            v4u hw; hw.x = pk2(hv[0], hv[1]); hw.y = pk2(hv[2], hv[3]); hw.z = pk2(hv[4], hv[5]); hw.w = pk2(hv[6], hv[7]); *(v4u*)(ho + c * 512 + lane * 8) = hw; }
    }
}
__device__ __forceinline__ void unpack8(const v4u w, float* f) { f[0] = blo(w.x); f[1] = bhi(w.x); f[2] = blo(w.y); f[3] = bhi(w.y); f[4] = blo(w.z); f[5] = bhi(w.z); f[6] = blo(w.w); f[7] = bhi(w.w); }
__device__ __forceinline__ void prep_row(KP P, int l, int r, int lane) {
    bf16* Z = (bf16*)(P->ws + WS_Z); bf16* MIX = (bf16*)(P->ws + WS_MIX); const float* rope = (const float*)(P->ws + WS_ROPE);
    const int b = r / TPB, p = r - b * TPB; const bool lat = p >= CTXL;
    const int seg_lo = lat ? CTXL : 0, seg_hi = lat ? TPB : CTXL;
    bf16* zr = Z + (size_t)r * ZW;
    const int ch = lane * 8, sub = lane & 31, t = p - CTXL, rowc = t >> 6, colc = t & 63;
    const bool hasp = p > seg_lo, hasn = p + 1 < seg_hi;
    const v4u zv = *(const v4u*)(zr + Z_CV + ch), zb = *(const v4u*)(zr + Z_CB + ch), zc = *(const v4u*)(zr + Z_CC + ch);
    const v4u zero4 = {0u, 0u, 0u, 0u};
    const v4u pv = hasp ? *(const v4u*)(zr - ZW + Z_CV + ch) : zero4, pc = hasp ? *(const v4u*)(zr - ZW + Z_CC + ch) : zero4;
    const v4u nv = hasn ? *(const v4u*)(zr + ZW + Z_CV + ch) : zero4, nc = hasn ? *(const v4u*)(zr + ZW + Z_CC + ch) : zero4;
    bf16* kp = zr + Z_K + lane * 4;
    const v2u kw = *(const v2u*)kp;
    const float* cw = P->in[I_CONVW] + (size_t)l * 3 * CONVW + ch;
    f32x4 w0[2], w1[2], w2[2];
#pragma unroll
    for (int h = 0; h < 2; ++h) { w0[h] = *(const f32x4*)(cw + h * 4); w1[h] = *(const f32x4*)(cw + CONVW + h * 4); w2[h] = *(const f32x4*)(cw + 2 * CONVW + h * 4); }
    const f32x4 kg = *(const f32x4*)(P->in[I_KNORM] + l * 128 + sub * 4);
    f32x4 cs = {1.f, 1.f, 1.f, 1.f}, sn = {0.f, 0.f, 0.f, 0.f};
    if (lat) { const float* cp = rope + ((sub < 16) ? rowc : colc) * 32 + (sub & 7) * 4; cs = *(const f32x4*)cp; sn = *(const f32x4*)(cp + 2048); }
    asm volatile("" ::: "memory");
    {
        float v[8], gb[8], gc[8], a[8], c[8], o[8];
        unpack8(zv, v); unpack8(zb, gb); unpack8(zc, gc);
        float uc[8], up[8], un[8];
#pragma unroll
        for (int e = 0; e < 8; ++e) uc[e] = gc[e] * v[e];
        unpack8(pv, a); unpack8(pc, c);
#pragma unroll
        for (int e = 0; e < 8; ++e) up[e] = a[e] * c[e];
        unpack8(nv, a); unpack8(nc, c);
#pragma unroll
        for (int e = 0; e < 8; ++e) un[e] = a[e] * c[e];
#pragma unroll
        for (int h = 0; h < 2; ++h)
#pragma unroll
            for (int e = 0; e < 4; ++e) { const int k = h * 4 + e; o[k] = gb[k] * (w0[h][e] * up[k] + w1[h][e] * uc[k] + w2[h][e] * un[k]); }
        v4u w; w.x = pk2(o[0], o[1]); w.y = pk2(o[2], o[3]); w.z = pk2(o[4], o[5]); w.w = pk2(o[6], o[7]);
        *(v4u*)(MIX + (size_t)r * DM + MIX_CONV + ch) = w;
    }
    {
        float k[4]; k[0] = blo(kw.x); k[1] = bhi(kw.x); k[2] = blo(kw.y); k[3] = bhi(kw.y);
        float ss = k[0] * k[0] + k[1] * k[1] + k[2] * k[2] + k[3] * k[3];
        ss += __shfl_xor(ss, 1); ss += __shfl_xor(ss, 2); ss += __shfl_xor(ss, 4); ss += __shfl_xor(ss, 8); ss += __shfl_xor(ss, 16);
        const float rr = 1.0f / sqrtf(ss * (1.0f / 128.0f) + RMS_EPS);
#pragma unroll
        for (int e = 0; e < 4; ++e) k[e] = k[e] * rr * kg[e];
        if (lat) {
#pragma unroll
            for (int e = 0; e < 4; ++e) { const float other = __shfl_xor(k[e], 8);
                k[e] = ((sub & 8) == 0) ? (k[e] * cs[e] - other * sn[e]) : (other * sn[e] + k[e] * cs[e]); }
        }
        v2u w; w.x = pk2(k[0], k[1]); w.y = pk2(k[2], k[3]); *(v2u*)kp = w;
    }
}

__device__ __forceinline__ void s5_carry_phase(KP P, int l, int wave, int lane) {
    const int G = gridDim.x;
    bf16* UH = (bf16*)(P->ws + WS_UH); const float* SB = (const float*)(P->ws + WS_SB);
    for (int it = wave * G + (int)blockIdx.x; it < 32 * NB * 2; it += NWAVES * G) {
        const int dir = it & 1, b = (it >> 1) & 7, g = it >> 4;
        const f32x2 l32 = ((const f32x2*)(P->ws + WS_POW))[((size_t)((l * 2 + dir) * 32 + g) * 33 + 32) * 64 + lane];
        float hre = 0.f, him = 0.f;
#pragma unroll 8
        for (int k = 0; k < SSM_CPB; ++k) {
            const int c = dir == 0 ? k : (k < 8 ? 7 - k : 143 - k);
            const size_t rowi = (size_t)g * SSM_RPG + ssm_rg(b, c);
            bf16* up = UH + rowi * UH_LD + 512 + dir * 128 + lane;
            up[0] = (bf16)f2bf(hre); up[64] = (bf16)f2bf(him);
            const float* sp = SB + rowi * 256 + dir * 128 + lane;
            const float sre = sp[0], sim = sp[64];
            const float nre = l32[0] * hre - l32[1] * him + sre, nim = l32[0] * him + l32[1] * hre + sim;
            hre = nre; him = nim;
        }
    }
}

__device__ __forceinline__ void attention_phase(KP P, int l, unsigned char* lds_generic, int wave_s) {
    const bf16* Z = (const bf16*)(P->ws + WS_Z); bf16* MIX = (bf16*)(P->ws + WS_MIX);
    const int G = gridDim.x;
    for (int i = 0; ; ++i) {
        int b, h, qb;
        if (G == 256) { if (i >= 4) break; const int xcd = blockIdx.x & 7, slot = blockIdx.x >> 3; const int pair = 2 * xcd + (i >> 1), uip = (i & 1) * 32 + slot; b = pair >> 1; h = (pair & 1) * 4 + (uip >> 4); qb = uip & 15; }
        else { const int u = i * G + blockIdx.x; if (u >= 1024) break; b = u >> 7; h = (u >> 4) & 7; qb = u & 15; }
        const int kvh = h >> 2; const size_t row0 = (size_t)b * TPB;
        attn::attn_unit(Z + (row0 + CTXL + qb * 256) * ZW + Z_Q + h * 128, Z + row0 * ZW + Z_K + kvh * 128, Z + row0 * ZW + Z_V + kvh * 128,
                        MIX + (row0 + CTXL + qb * 256) * DM + MIX_ATT + h * 128, TPB, (char*)lds_generic, wave_s, P->in[I_QNORM] + l * 128, (const float*)(P->ws + WS_ROPE), qb * 256);
    }
    if (l < DEPTH - 1) {
        for (int u = blockIdx.x; u < NB * 8; u += G) { const int b = u >> 3, h = u & 7, kvh = h >> 2; const size_t row0 = (size_t)b * TPB;
            attn::attn_unit(Z + row0 * ZW + Z_Q + h * 128, Z + row0 * ZW + Z_K + kvh * 128, Z + row0 * ZW + Z_V + kvh * 128, MIX + row0 * DM + MIX_ATT + h * 128, CTXL, (char*)lds_generic, wave_s, P->in[I_QNORM] + l * 128, nullptr, 0); }
    }
}
constexpr int PH_PRO = 3, PH_PER_LAYER = 10, PH_TOTAL = PH_PRO + DEPTH * PH_PER_LAYER;
__global__ void __launch_bounds__(NWAVES * 64, 2) trunk_fwd(Params Pval) {
    extern __shared__ __attribute__((aligned(16))) unsigned char lds_raw[];
    LAS unsigned char* lds = (LAS unsigned char*)lds_raw;
    const int wave = __builtin_amdgcn_readfirstlane((int)threadIdx.x >> 6);

    const int G = gridDim.x;
    for (int u = wave * 64 + lane_id(); u < (LDS_BYTES - LDSCTL_OFF) / 4; u += NWAVES * 64) ((LAS unsigned*)(lds + LDSCTL_OFF))[u] = 0u;
    __syncthreads();
    (void)Pval;
    KP P = kparams();
    const int lo = P->ph_lo, hi = P->ph_hi;
    unsigned char* ws = P->ws;
    XcdBarrier bar; bar.bar = (unsigned*)(ws + WS_CTL) + CW_BAR; bar.x = 0; bar.st = nullptr;
    if (hi - lo > 1) bar = xcd_barrier_post((unsigned*)(ws + WS_CTL) + CW_BAR, (volatile LAS unsigned*)(lds + MISC_OFF) + 8, wave == 0 && lane_id() == 0);
#define IN(k) (lo <= (k) && (k) < hi)
#define SEAM(k) do { if (IN((k) + 1)) { const bool ldr_ = (wave == 0) && (lane_id() == 0); xcd_barrier(bar, ldr_); if (NREP(17) > 1) xcd_barrier(bar, ldr_); } } while (0)

    if (IN(0)) { for (int rep = 0; rep < NREP(0); ++rep) prologue_a(P, lds, wave, lane_id()); SEAM(0); }
    if (IN(1)) { for (int rep = 0; rep < NREP(0); ++rep) { prologue_b(P, wave * 64 + lane_id()); prologue_kt(P, wave * 64 + lane_id()); } SEAM(1); }
    if (IN(2)) {
        for (int rep = 0; rep < NREP(0); ++rep) prologue_s5w(P, wave * 64 + lane_id());
        Thin T{}; T.init = 1; T.fin = 0; T.x_lat = P->in[I_X]; T.x_ctx = P->in[I_CTX]; T.X = (const bf16*)(ws + WS_X); T.Xout = (bf16*)(ws + WS_X); T.Y = nullptr; T.H = (bf16*)(ws + WS_H); T.OUT = nullptr;
        T.modg = nullptr; T.gc = 0; T.mods = (const float*)(ws + WS_MOD); T.sc = 0; T.YP = nullptr; T.ctx_mode = 1;
        for (int rep = 0; rep < NREP(0); ++rep) thin_rows(T, wave, lane_id()); SEAM(2);
    }
    for (int l = 0; l < DEPTH; ++l) {
        const int pb = PH_PRO + l * PH_PER_LAYER;
        if (pb + PH_PER_LAYER <= lo || pb >= hi) continue;
        P = kparams(); ws = P->ws;
        const unsigned char* wl = ws + WS_W + (size_t)l * W_LAYER;
        const float* modl = (const float*)(ws + WS_MOD) + (size_t)l * 9 * NMOD;
        const bool lastl = (l == DEPTH - 1);
        float* YPp = (float*)(ws + WS_YP);
        if (IN(pb + 0)) {
            pg8::Gemm g{(const bf16*)(ws + WS_H), (const bf16*)(wl + W_IN), M, ZW, DM}; pg8::RowOrder S{ZW / 256, G, (int)blockIdx.x, 1, 0};
            pg8::EpiInProj E{(bf16*)(ws + WS_Z), (bf16*)(ws + WS_UH)};
            for (int rep = 0; rep < NREP(3); ++rep) pg8::gemm_phase<pg8::EpiInProj, pg8::RowOrder, true, true>(lds + RING_OFF, g, S, E, wave);
            SEAM(pb + 0);
        }
        if (IN(pb + 1)) {
            for (int r = (int)blockIdx.x * NWAVES + wave; r < M; r += NWAVES * G) prep_row(P, l, r, lane_id());
            pg8::Gemm g{(const bf16*)(ws + WS_UH), (const bf16*)(ws + WS_W1) + (size_t)l * 32 * 256 * 512, 0, 0, 512, UH_LD, 512}; pg8::S5Order1 S{G, (int)blockIdx.x};
            pg8::EpiS5State E{(float*)(ws + WS_SB)};
            for (int rep = 0; rep < NREP(13); ++rep) pg8::gemm_phase<pg8::EpiS5State, pg8::S5Order1, true, true>(lds + RING_OFF, g, S, E, wave);
            SEAM(pb + 1);
        }
        if (IN(pb + 2)) { for (int rep = 0; rep < NREP(14); ++rep) s5_carry_phase(P, l, wave, lane_id()); SEAM(pb + 2); }
        if (IN(pb + 3)) {
            { pg8::Gemm g{(const bf16*)(ws + WS_UH), (const bf16*)(ws + WS_TW) + (size_t)l * 32 * 512 * 768, 0, 0, 768, UH_LD, 768}; pg8::S5Order2 S{G, (int)blockIdx.x, l < DEPTH - 1 ? 5 : 4};
              pg8::EpiS5Out E{(bf16*)(ws + WS_G)};
              for (int rep = 0; rep < NREP(15); ++rep) pg8::gemm_phase<pg8::EpiS5Out, pg8::S5Order2, true, true>(lds + RING_OFF, g, S, E, wave); }
            __syncthreads();
            for (int rep = 0; rep < NREP(12); ++rep) attention_phase(P, l, lds_raw, wave);
            SEAM(pb + 3);
        }
        if (IN(pb + 4)) {
            pg8::Gemm g{(const bf16*)(ws + WS_G), (const bf16*)(wl + W_GLU), M, SSMW, SSMW}; pg8::RowOrder S{SSMW / 256, G, (int)blockIdx.x, lastl ? 0 : 1, 0};
            pg8::EpiGlu E{(const bf16*)(ws + WS_G), SSMW, (bf16*)(ws + WS_MIX) + MIX_SSM, DM, P->in[I_BGLU] + l * SSMW};
            for (int rep = 0; rep < NREP(11); ++rep) pg8::gemm_phase<pg8::EpiGlu, pg8::RowOrder, true, true>(lds + RING_OFF, g, S, E, wave);
            SEAM(pb + 4);
        }
        if (IN(pb + 5)) {
            pg8::Gemm g{(const bf16*)(ws + WS_MIX), (const bf16*)(wl + W_OUT), M, DM, DM}; pg8::RowOrder S{DM / 256, G, (int)blockIdx.x, lastl ? 0 : 2, DM / 256};
            pg8::EpiBf16 E{(bf16*)(ws + WS_Y), DM, YPp, DM / 64};
            for (int rep = 0; rep < NREP(6); ++rep) pg8::gemm_phase<pg8::EpiBf16, pg8::RowOrder, true, true>(lds + RING_OFF, g, S, E, wave);
            SEAM(pb + 5);
        }
        if (IN(pb + 6)) {
            Thin T{}; T.init = 0; T.fin = 0; T.x_lat = nullptr; T.x_ctx = nullptr; T.X = (const bf16*)(ws + WS_X); T.Xout = (bf16*)(ws + WS_X); T.Y = (const bf16*)(ws + WS_Y); T.H = (bf16*)(ws + WS_H); T.OUT = nullptr;
            T.modg = modl; T.gc = 2; T.mods = modl; T.sc = 3; T.YP = YPp; T.ctx_mode = lastl ? 0 : 2;
            if (NREP(7) > 1) { Thin T2 = T; T2.Xout = (bf16*)(ws + WS_Z); thin_rows(T2, wave, lane_id()); }
            thin_rows(T, wave, lane_id()); SEAM(pb + 6);
        }
        if (IN(pb + 7)) {
            pg8::Gemm g{(const bf16*)(ws + WS_H), (const bf16*)(wl + W_GU), M, 2 * FF, DM}; pg8::RowOrder S{2 * FF / 256, G, (int)blockIdx.x, lastl ? 0 : 1, 0};
            pg8::EpiSwiGlu E{(bf16*)(ws + WS_ACT), FF};
            for (int rep = 0; rep < NREP(8); ++rep) pg8::gemm_phase<pg8::EpiSwiGlu, pg8::RowOrder, true, true>(lds + RING_OFF, g, S, E, wave);
            SEAM(pb + 7);
        }
        if (IN(pb + 8)) {
            pg8::Gemm g{(const bf16*)(ws + WS_ACT), (const bf16*)(wl + W_DOWN), M, DM, FF}; pg8::RowOrder S{DM / 256, G, (int)blockIdx.x, lastl ? 0 : 2, FF / 256};
            pg8::EpiBf16 E{(bf16*)(ws + WS_Y), DM, YPp, FF / 64};
            for (int rep = 0; rep < NREP(9); ++rep) pg8::gemm_phase<pg8::EpiBf16, pg8::RowOrder, true, true>(lds + RING_OFF, g, S, E, wave);
            SEAM(pb + 8);
        }
        if (IN(pb + 9)) {
            const bool last = (l == DEPTH - 1); const int l2 = last ? l : l + 1;
            Thin T{}; T.init = 0; T.fin = last ? 1 : 0; T.x_lat = nullptr; T.x_ctx = nullptr; T.X = (const bf16*)(ws + WS_X); T.Xout = (bf16*)(ws + WS_X); T.Y = (const bf16*)(ws + WS_Y); T.H = (bf16*)(ws + WS_H); T.OUT = P->out;
            T.modg = modl; T.gc = 5; T.mods = (const float*)(ws + WS_MOD) + (size_t)l2 * 9 * NMOD; T.sc = 0; T.YP = YPp; T.ctx_mode = lastl ? 0 : 2;
            if (NREP(7) > 1) { Thin T2 = T; T2.Xout = (bf16*)(ws + WS_Z); thin_rows(T2, wave, lane_id()); }
            thin_rows(T, wave, lane_id()); SEAM(pb + 9);
        }
    }
#undef IN
#undef SEAM
}

extern "C" void kernel_launch(void* const* d_in, const int* in_sizes, int n_in, void* d_out, int out_size, void* d_ws, size_t ws_size, hipStream_t stream) {
    static int grid = 0;
    if (grid == 0) {
        if (n_in != 28 || in_sizes[0] != NB * SEQ * DM || out_size != NB * SEQ * DM || ws_size < WS_END) {
            fprintf(stderr, "kernel_launch: built for 28 inputs, x/out of %d floats, >= %zu bytes of workspace; got n_in %d, in0 %d, out %d, ws %zu; nothing launched\n", NB * SEQ * DM, (size_t)WS_END, n_in, n_in > 0 ? in_sizes[0] : -1, out_size, ws_size);
            grid = -1; return; }
        int dev = 0, cus = 0;
        if (hipGetDevice(&dev) != hipSuccess || hipDeviceGetAttribute(&cus, hipDeviceAttributeMultiprocessorCount, dev) != hipSuccess) { fprintf(stderr, "kernel_launch: device query failed\n"); grid = -1; return; }
        if (hipFuncSetAttribute((const void*)trunk_fwd, hipFuncAttributeMaxDynamicSharedMemorySize, LDS_BYTES) != hipSuccess) { fprintf(stderr, "kernel_launch: hipFuncSetAttribute failed\n"); grid = -1; return; }
        int per_cu = 0;
        if (hipOccupancyMaxActiveBlocksPerMultiprocessor(&per_cu, (const void*)trunk_fwd, NWAVES * 64, LDS_BYTES) != hipSuccess || per_cu < 1)
            fprintf(stderr, "kernel_launch: note: occupancy query reports %d workgroups per CU\n", per_cu);
        (void)hipGetLastError();
        grid = cus;
    }
    if (grid < 0) return;
    if (hipMemsetAsync((char*)d_ws + WS_CTL, 0, CTL_ZERO_BYTES, stream) != hipSuccess) { fprintf(stderr, "kernel_launch: memset failed\n"); return; }
    Params p{};
    for (int i = 0; i < 28; ++i) p.in[i] = (const float*)d_in[i];
    p.out = (float*)d_out; p.ws = (unsigned char*)d_ws;
#if MK_ONE_LAUNCH
    p.ph_lo = 0; p.ph_hi = PH_TOTAL;
    hipLaunchKernelGGL(trunk_fwd, dim3(grid), dim3(NWAVES * 64), LDS_BYTES, stream, p);
#else
    for (int k = 0; k < PH_TOTAL; ++k) { p.ph_lo = k; p.ph_hi = k + 1; hipLaunchKernelGGL(trunk_fwd, dim3(grid), dim3(NWAVES * 64), LDS_BYTES, stream, p); }
#endif
    const hipError_t le = hipPeekAtLastError();
    if (le != hipSuccess) fprintf(stderr, "kernel_launch: launch failed: %s\n", hipGetErrorName(le));
}
```

```cpp
#include <hip/hip_runtime.h>
#include <cstdio>
#include <cstdint>
#include <cmath>

#ifndef MK_ONE_LAUNCH
#define MK_ONE_LAUNCH 1
#endif

constexpr int SSM_L = 32, SSM_CPB = 136, SSM_RPG = 1280, UH_LD = 768;
__host__ __device__ __forceinline__ int ssm_rg(int b, int c) { return c >= 8 ? b * 128 + (c - 8) : 1024 + b * 8 + c; }

#ifndef REP_MASK
#define REP_MASK 0
#endif
#define NREP(b) (1 + ((REP_MASK >> (b)) & 1))
__device__ __forceinline__ int lane_id() { int l; asm volatile("v_mbcnt_lo_u32_b32 %0, -1, 0\n\tv_mbcnt_hi_u32_b32 %0, -1, %0" : "=v"(l)); return l; }
namespace pg8 {
#define PG8_LAS __attribute__((address_space(3)))
typedef unsigned short bf16_t;
typedef short bf16x8 __attribute__((ext_vector_type(8)));
typedef float f32x4 __attribute__((ext_vector_type(4)));
typedef unsigned u32x4 __attribute__((ext_vector_type(4)));
constexpr int BM = 256, BK = 64, HALF = 128, HTB = HALF * BK * 2  , STAGE_BYTES = 8 * HTB, NXCD = 8, WGM = 8;

__host__ __device__ __forceinline__ int lds_byte(int r, int c) { const int st = (r >> 4) * 2 + (c >> 5), rr = r & 15, cc = c & 31, ob = rr * 64 + cc * 2; return st * 1024 + (ob ^ (((ob >> 9) & 1) << 5)); }
__host__ __device__ __forceinline__ void stage_rc(int b, int& R, int& C) { const int st = b / 1024, sb = b % 1024, swz = sb ^ (((sb >> 9) & 1) << 5); R = (st >> 1) * 16 + swz / 64; C = (st & 1) * 32 + (swz % 64) / 2; }
__host__ __device__ __forceinline__ int perm32(int rho) { const int n = rho >> 4, i = rho & 15; return 8 * (i >> 2) + 4 * n + (i & 3); }

struct Unit { int pm, pn, ko, nt; };
struct Gemm { const bf16_t* A; const bf16_t* Bt; int M, N, K, lda, ldb; };

struct StaticOrder {
    int nM, nN, nwg, G, c;
    __host__ __device__ void init(int M, int N, int G_, int c_) { nM = M / BM; nN = N / BM; nwg = nM * nN; G = G_; c = c_; }
    __host__ __device__ bool next(int i, Unit& u) const {
        const long L = (long)i * G + c; if (L >= nwg) return false;
        int wgid = (int)L; { const int q = nwg / NXCD, r = nwg % NXCD, xcd = wgid % NXCD, off = wgid / NXCD; wgid = (xcd < r ? xcd * (q + 1) : r * (q + 1) + (xcd - r) * q) + off; }
        const int nig = WGM * nN, gid = wgid / nig, fm = gid * WGM, gsz = (nM - fm) < WGM ? (nM - fm) : WGM;
        u.pm = fm + ((wgid % nig) % gsz); u.pn = (wgid % nig) / gsz; return true;
    }
    __device__ __forceinline__ void a_ready(const Unit&) const {}
    __device__ __forceinline__ void done(const Unit&) const {}
};

__device__ __forceinline__ unsigned cvt_pk_bf16(float lo, float hi) { unsigned r; asm volatile("v_cvt_pk_bf16_f32 %0, %1, %2" : "=v"(r) : "v"(lo), "v"(hi)); return r; }
typedef float f32x2 __attribute__((ext_vector_type(2)));
struct EpiBf16 {
    static constexpr bool PERM = true, AFTER_DRAIN = false; static constexpr int NST = 0;
    bf16_t* O; int ldc; float* YP; int nt_full;
    __device__ __forceinline__ void operator()(const f32x4 (&acc)[2][2][4][2], const Unit& u, int wr, int wc, int fr, int fq) const {
        const int col0 = u.pn * BM + wc * 32 + 8 * fq;
        if (u.nt != nt_full) {
            const int q = u.ko / (u.nt * BK), b = u.pm / 17; float* base = YP + ((size_t)q * 2048 + b * 256 + wr * 64 + fr) * ldc + col0;
#pragma unroll
            for (int ai = 0; ai < 2; ++ai)
#pragma unroll
                for (int m = 0; m < 4; ++m) { float* rowp = base + (size_t)(ai * HALF + m * 16) * ldc;
#pragma unroll
                    for (int bj = 0; bj < 2; ++bj) { *(f32x4*)(rowp + bj * HALF) = acc[ai][bj][m][0]; *(f32x4*)(rowp + bj * HALF + 4) = acc[ai][bj][m][1]; } }
            return;
        }
        const int row0 = u.pm * BM + wr * 64 + fr;
#pragma unroll
        for (int ai = 0; ai < 2; ++ai)
#pragma unroll
            for (int m = 0; m < 4; ++m) { bf16_t* rowp = O + (size_t)(row0 + ai * HALF + m * 16) * ldc + col0;
#pragma unroll
                for (int bj = 0; bj < 2; ++bj) { const f32x4 v0 = acc[ai][bj][m][0], v1 = acc[ai][bj][m][1];
                    u32x4 w; w.x = cvt_pk_bf16(v0[0], v0[1]); w.y = cvt_pk_bf16(v0[2], v0[3]); w.z = cvt_pk_bf16(v1[0], v1[1]); w.w = cvt_pk_bf16(v1[2], v1[3]);
                    *(u32x4*)(rowp + bj * HALF) = w; } }
    }
};
struct RowOrder {
    int nN, G, c, ctx, ntq;
    __device__ bool next(int i, Unit& u) const {
        const int nlat = 128 * nN, L = i * G + c;
        if (L < nlat) {
            const int q = nlat / NXCD, wgid = (L % NXCD) * q + L / NXCD;
            const int nig = WGM * nN, gid = wgid / nig, rem = wgid - gid * nig, pml = gid * WGM + (rem % WGM);
            u.pn = rem / WGM; u.pm = (pml >> 4) * 17 + 1 + (pml & 15); return true;
        }
        const int Lc = L - nlat;
        if (ctx == 1) { if (Lc >= 8 * nN) return false; u.pm = (Lc / nN) * 17; u.pn = Lc % nN; return true; }
        if (ctx == 2) { if (Lc >= 32 * nN) return false; const int t = Lc >> 2; u.pm = (t / nN) * 17; u.pn = t % nN; u.ko = (Lc & 3) * ntq * BK; u.nt = ntq; return true; }
        return false;
    }
    __device__ __forceinline__ void a_ready(const Unit&) const {}
    __device__ __forceinline__ void done(const Unit&) const {}
};
__device__ __forceinline__ float bflo(unsigned w) { return __uint_as_float(w << 16); }
__device__ __forceinline__ float bfhi(unsigned w) { return __uint_as_float(w & 0xffff0000u); }
__device__ __forceinline__ float sigmoidf_(float x) { return __builtin_amdgcn_rcpf(1.0f + __expf(-x)); }
struct EpiGlu {
    static constexpr bool PERM = true, AFTER_DRAIN = false; static constexpr int NST = 0;
    const bf16_t* G; int ldg; bf16_t* O; int ldo; const float* bias;
    __device__ __forceinline__ void operator()(const f32x4 (&acc)[2][2][4][2], const Unit& u, int wr, int wc, int fr, int fq) const {
        const int row0 = u.pm * BM + wr * 64 + fr; const int col0 = u.pn * BM + wc * 32 + 8 * fq;
        f32x4 bv[2][2];
#pragma unroll
        for (int bj = 0; bj < 2; ++bj)
#pragma unroll
            for (int n = 0; n < 2; ++n) bv[bj][n] = *(const f32x4*)(bias + col0 + bj * HALF + 4 * n);
#pragma unroll
        for (int ai = 0; ai < 2; ++ai) {
            u32x4 gv[4][2];
#pragma unroll
            for (int m = 0; m < 4; ++m)
#pragma unroll
                for (int bj = 0; bj < 2; ++bj) gv[m][bj] = *(const u32x4*)(G + (size_t)(row0 + ai * HALF + m * 16) * ldg + col0 + bj * HALF);
            asm volatile("" ::: "memory");
#pragma unroll
            for (int m = 0; m < 4; ++m) { const size_t row = (size_t)(row0 + ai * HALF + m * 16);
#pragma unroll
                for (int bj = 0; bj < 2; ++bj) { const f32x4 v0 = acc[ai][bj][m][0] + bv[bj][0], v1 = acc[ai][bj][m][1] + bv[bj][1];
                    const u32x4 g = gv[m][bj];
                    const float o0 = bflo(g.x) * sigmoidf_(v0[0]), o1 = bfhi(g.x) * sigmoidf_(v0[1]), o2 = bflo(g.y) * sigmoidf_(v0[2]), o3 = bfhi(g.y) * sigmoidf_(v0[3]);
                    const float o4 = bflo(g.z) * sigmoidf_(v1[0]), o5 = bfhi(g.z) * sigmoidf_(v1[1]), o6 = bflo(g.w) * sigmoidf_(v1[2]), o7 = bfhi(g.w) * sigmoidf_(v1[3]);
                    u32x4 w; w.x = cvt_pk_bf16(o0, o1); w.y = cvt_pk_bf16(o2, o3); w.z = cvt_pk_bf16(o4, o5); w.w = cvt_pk_bf16(o6, o7);
                    *(u32x4*)(O + row * ldo + col0 + bj * HALF) = w; } }
            asm volatile("" ::: "memory");
        }
    }
};
struct EpiSwiGlu {
    static constexpr bool PERM = true, AFTER_DRAIN = false; static constexpr int NST = 8;
    bf16_t* O; int ldo;
    __device__ __forceinline__ void operator()(const f32x4 (&acc)[2][2][4][2], const Unit& u, int wr, int wc, int fr, int fq) const {
        const int row0 = u.pm * BM + wr * 64 + fr; const int col0 = u.pn * HALF + wc * 32 + 8 * fq;
#pragma unroll
        for (int ai = 0; ai < 2; ++ai)
#pragma unroll
            for (int m = 0; m < 4; ++m) { const size_t row = (size_t)(row0 + ai * HALF + m * 16);
                float o[8];
#pragma unroll
                for (int n = 0; n < 2; ++n)
#pragma unroll
                    for (int j = 0; j < 4; ++j) { const float g = acc[ai][0][m][n][j], up = acc[ai][1][m][n][j]; o[n * 4 + j] = g * sigmoidf_(g) * up; }
                u32x4 w; w.x = cvt_pk_bf16(o[0], o[1]); w.y = cvt_pk_bf16(o[2], o[3]); w.z = cvt_pk_bf16(o[4], o[5]); w.w = cvt_pk_bf16(o[6], o[7]);
                *(u32x4*)(O + row * ldo + col0) = w; }
    }
};
struct EpiInProj {
    static constexpr bool PERM = true, AFTER_DRAIN = false; static constexpr int NST = 0;
    bf16_t* Z; bf16_t* UH;
    __device__ __forceinline__ void operator()(const f32x4 (&acc)[2][2][4][2], const Unit& u, int wr, int wc, int fr, int fq) const {
        const int row0 = u.pm * BM + wr * 64 + fr; const int col0 = u.pn * BM + wc * 32 + 8 * fq;
        const bool ssm = (u.pn == 6 || u.pn == 7);
#pragma unroll
        for (int ai = 0; ai < 2; ++ai)
#pragma unroll
            for (int m = 0; m < 4; ++m) { const int row = row0 + ai * HALF + m * 16;
                int b = 0, pos = 0; if (ssm) { b = row / 4352; pos = row - b * 4352; }
#pragma unroll
                for (int bj = 0; bj < 2; ++bj) { const f32x4 v0 = acc[ai][bj][m][0], v1 = acc[ai][bj][m][1];
                    u32x4 w; w.x = cvt_pk_bf16(v0[0], v0[1]); w.y = cvt_pk_bf16(v0[2], v0[3]); w.z = cvt_pk_bf16(v1[0], v1[1]); w.w = cvt_pk_bf16(v1[2], v1[3]);
                    const int col = col0 + bj * HALF;
                    if (ssm) { const int sc = col - 1536, g = sc >> 4, n0 = sc & 15; *(u32x4*)(UH + ((size_t)(g * SSM_RPG + ssm_rg(b, pos >> 5)) * UH_LD + (pos & 31) * 16 + n0)) = w; }
                    else *(u32x4*)(Z + (size_t)row * 3584 + col) = w; } }
    }
};
struct EpiS5State {
    static constexpr bool PERM = true, AFTER_DRAIN = false; static constexpr int NST = 0;
    float* S;
    __device__ __forceinline__ void operator()(const f32x4 (&acc)[2][2][4][2], const Unit& u, int wr, int wc, int fr, int fq) const {
        const int row0 = u.pm * BM + wr * 64 + fr; const int col0 = wc * 32 + 8 * fq;
#pragma unroll
        for (int ai = 0; ai < 2; ++ai)
#pragma unroll
            for (int m = 0; m < 4; ++m) { float* rowp = S + (size_t)(row0 + ai * HALF + m * 16) * 256 + col0;
#pragma unroll
                for (int bj = 0; bj < 2; ++bj) { *(f32x4*)(rowp + bj * HALF) = acc[ai][bj][m][0]; *(f32x4*)(rowp + bj * HALF + 4) = acc[ai][bj][m][1]; } }
    }
};
__device__ __forceinline__ float gelu_tanh_(float y) {
    const float z = 0.7978845608028654f * (y + 0.044715f * y * y * y);
    const float t = 1.0f - 2.0f * __builtin_amdgcn_rcpf(__expf(2.0f * z) + 1.0f);
    return 0.5f * y * (1.0f + t);
}
struct EpiS5Out {
    static constexpr bool PERM = true, AFTER_DRAIN = false; static constexpr int NST = 0;
    bf16_t* G;
    __device__ __forceinline__ void operator()(const f32x4 (&acc)[2][2][4][2], const Unit& u, int wr, int wc, int fr, int fq) const {
        const int g = u.pn >> 1, j = u.pn & 1, i = u.pm - 5 * g;
        const int rg0 = i * BM + wr * 64 + fr; const int col0 = j * BM + wc * 32 + 8 * fq;
#pragma unroll
        for (int ai = 0; ai < 2; ++ai)
#pragma unroll
            for (int m = 0; m < 4; ++m) { const int rg = rg0 + ai * HALF + m * 16;
                if (rg < 1088) {
                    int b, c; if (rg < 1024) { b = rg >> 7; c = 8 + (rg & 127); } else { b = (rg - 1024) >> 3; c = (rg - 1024) & 7; }
                    const size_t grow0 = (size_t)b * 4352 + c * 32;
#pragma unroll
                    for (int bj = 0; bj < 2; ++bj) { const f32x4 v0 = acc[ai][bj][m][0], v1 = acc[ai][bj][m][1];
                        const int col = col0 + bj * HALF, t = col >> 4, n0 = col & 15;
                        u32x4 w; w.x = cvt_pk_bf16(gelu_tanh_(v0[0]), gelu_tanh_(v0[1])); w.y = cvt_pk_bf16(gelu_tanh_(v0[2]), gelu_tanh_(v0[3]));
                        w.z = cvt_pk_bf16(gelu_tanh_(v1[0]), gelu_tanh_(v1[1])); w.w = cvt_pk_bf16(gelu_tanh_(v1[2]), gelu_tanh_(v1[3]));
                        *(u32x4*)(G + (grow0 + t) * 512 + g * 16 + n0) = w; } } }
    }
};
struct S5Order1 { int G, c;
    __device__ bool next(int i, Unit& u) const { const int L = i * G + c; if (L >= 160) return false; u.pm = L; u.pn = L / 5; return true; }
    __device__ __forceinline__ void a_ready(const Unit&) const {}
    __device__ __forceinline__ void done(const Unit&) const {} };
struct S5Order2 { int G, c, nt;
    __device__ bool next(int i, Unit& u) const { const int L = i * G + c; if (L >= 32 * nt * 2) return false; const int g = L / (2 * nt), r = L - g * 2 * nt; u.pm = g * 5 + (r >> 1); u.pn = g * 2 + (r & 1); return true; }
    __device__ __forceinline__ void a_ready(const Unit&) const {}
    __device__ __forceinline__ void done(const Unit&) const {} };
template <class Epi, class Sched, bool ALIGN_EPI = false, bool SP2 = false>
__device__ __forceinline__ void gemm_phase(PG8_LAS unsigned char* lds, const Gemm g, const Sched& S, const Epi& E, int wave_s) {
    int tid_ = wave_s * 64 + lane_id(); asm volatile("" : "+v"(tid_));
    const int tid = tid_, wid = __builtin_amdgcn_readfirstlane(tid >> 6), lane = tid & 63, wr = wid >> 2, wc = wid & 3, fr = lane & 15, fq = lane >> 4;
    const int K = g.K, lda = g.lda ? g.lda : K, ldb = g.ldb ? g.ldb : K;
    unsigned voffA[2], voffB[2];
#pragma unroll
    for (int i = 0; i < 2; ++i) { int R, C; stage_rc(tid * 16 + i * 8192, R, C); const int Rb = Epi::PERM ? ((R & ~31) + perm32(R & 31)) : R;
        voffA[i] = (unsigned)(R * lda + C) * 2u; voffB[i] = (unsigned)(Rb * ldb + C) * 2u; }
    const size_t kstep = (size_t)(BK * 2);
    const size_t hstepA = (size_t)HALF * lda * 2, hstepB = (size_t)HALF * ldb * 2;
    const size_t tstepA = 2 * hstepA, tstepB = 2 * hstepB;
    const unsigned ldsw = (unsigned)wid * 1024u;
    const int aoff = lds_byte(wr * 64 + fr, fq * 8), boff = lds_byte(wc * 32 + fr, fq * 8);
#define PG8_SA(b, h) (((b) * 2 + (h)) * HTB)
#define PG8_SB(b, h) ((4 + (b) * 2 + (h)) * HTB)
#define PG8_STAGE(bufoff, gbase, voff) do { _Pragma("unroll") for (int _i = 0; _i < 2; ++_i) \
        __builtin_amdgcn_global_load_lds((const unsigned*)((const char*)(gbase) + (voff)[_i]), (PG8_LAS unsigned*)(lds + (bufoff) + ldsw + _i * 8192), 16, 0, 0); } while (0)
#define PG8_LDA(dst, b, h) do { _Pragma("unroll") for (int m = 0; m < 4; ++m) _Pragma("unroll") for (int k = 0; k < 2; ++k) dst[m][k] = *(const PG8_LAS bf16x8*)(lds + PG8_SA(b, h) + aoff + m * 2048 + k * 1024); } while (0)
#define PG8_LDB(dst, b, h) do { _Pragma("unroll") for (int n = 0; n < 2; ++n) _Pragma("unroll") for (int k = 0; k < 2; ++k) dst[n][k] = *(const PG8_LAS bf16x8*)(lds + PG8_SB(b, h) + boff + n * 2048 + k * 1024); } while (0)
#define PG8_MMA(ai, bj, At, Bt) do { __builtin_amdgcn_s_setprio(1); _Pragma("unroll") for (int m = 0; m < 4; ++m) _Pragma("unroll") for (int n = 0; n < 2; ++n) _Pragma("unroll") for (int k = 0; k < 2; ++k) \
        acc[ai][bj][m][n] = __builtin_amdgcn_mfma_f32_16x16x32_bf16(Bt[n][k], At[m][k], acc[ai][bj][m][n], 0, 0, 0); __builtin_amdgcn_s_setprio(0); } while (0)
#define PG8_WAIT_V(n) asm volatile("s_waitcnt vmcnt(" #n ")" ::: "memory")
#define PG8_WAIT_L(n) asm volatile("s_waitcnt lgkmcnt(" #n ")" ::: "memory")
#define PG8_BAR __builtin_amdgcn_s_barrier()
#define PG8_SCHED __builtin_amdgcn_sched_barrier(0)
    Unit cur, nxt; int ui = 0;
    cur.ko = 0; cur.nt = K / BK; nxt.ko = 0; nxt.nt = K / BK;
    if (!S.next(0, cur)) return;
    f32x4 acc[2][2][4][2];
#pragma unroll
    for (int a = 0; a < 2; ++a)
#pragma unroll
        for (int b = 0; b < 2; ++b)
#pragma unroll
            for (int m = 0; m < 4; ++m)
#pragma unroll
                for (int n = 0; n < 2; ++n) acc[a][b][m][n] = (f32x4){0.f, 0.f, 0.f, 0.f};
    bf16x8 At[4][2], B0[2][2], B1[2][2];
    const char* cA = (const char*)g.A + (size_t)cur.pm * tstepA + (size_t)cur.ko * 2; const char* cB = (const char*)g.Bt + (size_t)cur.pn * tstepB + (size_t)cur.ko * 2;
    S.a_ready(cur);
    if constexpr (SP2) {
        PG8_STAGE(PG8_SB(0, 0), cB, voffB); PG8_STAGE(PG8_SB(0, 1), cB + hstepB, voffB); PG8_STAGE(PG8_SA(0, 0), cA, voffA); PG8_STAGE(PG8_SA(0, 1), cA + hstepA, voffA);
        if (wr == 1) PG8_BAR;
        PG8_WAIT_V(2); PG8_BAR;
        PG8_STAGE(PG8_SB(1, 0), cB + kstep, voffB); PG8_STAGE(PG8_SA(1, 0), cA + kstep, voffA); PG8_STAGE(PG8_SB(1, 1), cB + hstepB + kstep, voffB);
        PG8_WAIT_V(6); PG8_BAR;
    } else {
        PG8_STAGE(PG8_SB(0, 0), cB, voffB); PG8_STAGE(PG8_SA(0, 0), cA, voffA); PG8_STAGE(PG8_SB(0, 1), cB + hstepB, voffB); PG8_STAGE(PG8_SA(0, 1), cA + hstepA, voffA);
        if (wr == 1) PG8_BAR;
        PG8_WAIT_V(4); PG8_BAR;
        PG8_STAGE(PG8_SB(1, 0), cB + kstep, voffB); PG8_STAGE(PG8_SA(1, 0), cA + kstep, voffA); PG8_STAGE(PG8_SB(1, 1), cB + hstepB + kstep, voffB);
        PG8_WAIT_V(6); PG8_BAR;
    }
    for (;;) {
        nxt.ko = 0; nxt.nt = K / BK;
        const bool has_next = S.next(ui + 1, nxt);
        const int nt = cur.nt;
        const char* nA = has_next ? (const char*)g.A + (size_t)nxt.pm * tstepA + (size_t)nxt.ko * 2 : cA; const char* nB = has_next ? (const char*)g.Bt + (size_t)nxt.pn * tstepB + (size_t)nxt.ko * 2 : cB;
        static_assert(SP2, "this build keeps only the two-super-phase K-loop");
#define PG8_TRIP(WV12) { \
            const bool last = (t == nt - 2); \
            const char* a1 = cA + (size_t)(t + 1) * kstep; \
            const char* a2 = last ? nA : cA + (size_t)(t + 2) * kstep; const char* b2 = last ? nB : cB + (size_t)(t + 2) * kstep; \
            const char* a3 = a2 + kstep; const char* b3 = b2 + kstep; \
            if (last && has_next) S.a_ready(nxt); \
              \
            PG8_LDB(B0, 0, 0); PG8_LDB(B1, 0, 1); PG8_SCHED; PG8_LDA(At, 0, 0); PG8_STAGE(PG8_SA(1, 1), a1 + hstepA, voffA); \
            WV12; PG8_WAIT_L(0); PG8_BAR; PG8_MMA(0, 0, At, B0); PG8_MMA(0, 1, At, B1); PG8_BAR; PG8_SCHED; \
              \
            PG8_LDA(At, 0, 1); PG8_STAGE(PG8_SB(0, 0), b2, voffB); PG8_STAGE(PG8_SB(0, 1), b2 + hstepB, voffB); PG8_STAGE(PG8_SA(0, 0), a2, voffA); \
            WV12; PG8_WAIT_L(0); PG8_BAR; PG8_MMA(1, 0, At, B0); PG8_MMA(1, 1, At, B1); PG8_BAR; PG8_SCHED; \
              \
            PG8_LDB(B0, 1, 0); PG8_LDB(B1, 1, 1); PG8_SCHED; PG8_LDA(At, 1, 0); PG8_STAGE(PG8_SA(0, 1), a2 + hstepA, voffA); \
            PG8_WAIT_V(8); PG8_WAIT_L(0); PG8_BAR; PG8_MMA(0, 0, At, B0); PG8_MMA(0, 1, At, B1); PG8_BAR; PG8_SCHED; \
              \
            PG8_LDA(At, 1, 1); PG8_STAGE(PG8_SB(1, 0), b3, voffB); PG8_STAGE(PG8_SB(1, 1), b3 + hstepB, voffB); PG8_STAGE(PG8_SA(1, 0), a3, voffA); \
            PG8_WAIT_V(8); PG8_WAIT_L(0); PG8_BAR; PG8_MMA(1, 0, At, B0); PG8_MMA(1, 1, At, B1); PG8_BAR; PG8_SCHED; }
        int t = 0;
        if constexpr (Epi::NST == 16) { if (ui > 0) { PG8_TRIP(PG8_WAIT_V(24)) t = 2; } }
        if constexpr (Epi::NST == 8) { if (ui > 0) { PG8_TRIP(PG8_WAIT_V(16)) t = 2; } }
        for (; t < nt; t += 2) PG8_TRIP(PG8_WAIT_V(8))
#undef PG8_TRIP
        if constexpr (ALIGN_EPI) { if (wr == 0) PG8_BAR; }
        if constexpr (!Epi::AFTER_DRAIN) { E(acc, cur, wr, wc, fr, fq); S.done(cur); }
        if (!has_next) break;
#pragma unroll
        for (int a = 0; a < 2; ++a)
#pragma unroll
            for (int b = 0; b < 2; ++b)
#pragma unroll
                for (int m = 0; m < 4; ++m)
#pragma unroll
                    for (int n = 0; n < 2; ++n) acc[a][b][m][n] = (f32x4){0.f, 0.f, 0.f, 0.f};
        cur = nxt; cA = nA; cB = nB; ++ui;
        if constexpr (ALIGN_EPI) { if (wr == 1) PG8_BAR; }
    }
    PG8_WAIT_V(0);
    if constexpr (!ALIGN_EPI) { if (wr == 0) PG8_BAR; }
    PG8_BAR;
    if constexpr (Epi::AFTER_DRAIN) { E.fused(acc, cur, wr, wc, fr, fq, lds, wid, lane); S.done(cur); }
#undef PG8_SA
#undef PG8_SB
#undef PG8_STAGE
#undef PG8_LDA
#undef PG8_LDB
#undef PG8_MMA
#undef PG8_WAIT_V
#undef PG8_WAIT_L
#undef PG8_BAR
#undef PG8_SCHED
}
}
namespace attn {
typedef unsigned short bf16;
using bf16x8 = __attribute__((ext_vector_type(8))) short;
using s16x4  = __attribute__((ext_vector_type(4))) short;
using f32x16 = __attribute__((ext_vector_type(16))) float;
using u32x4  = __attribute__((ext_vector_type(4))) unsigned;
constexpr int   D = 128, NW = 8, QBLK = 32, KVBLK = 64;
constexpr float SCALE = 0.088388347648318440f;
constexpr float THR = 8.f;
constexpr int LDQ = 3584, LDK = 3584, LDO = 2048;
constexpr size_t SHM_V = KVBLK * D * 2, SHM_K = KVBLK * D * 2, SHM_ATTN = 2 * SHM_V + 2 * SHM_K + NW * 64 * 4;
#define KSWZ(row, colB) ((row) * 256 + ((colB) ^ (((row) & 7) << 4)))
#define SBAR() __builtin_amdgcn_sched_barrier(0)
__device__ __forceinline__ int crow(int r, int hi) { return (r & 3) + 8 * (r >> 2) + 4 * hi; }
__device__ __forceinline__ unsigned cvtpk(float lo, float hi) { unsigned r; asm volatile("v_cvt_pk_bf16_f32 %0, %1, %2" : "=v"(r) : "v"(lo), "v"(hi)); return r; }
__device__ __forceinline__ bf16x8 ld8(const bf16* p) { return *reinterpret_cast<const bf16x8*>(p); }
__device__ __forceinline__ void partialSM(f32x16& p0, f32x16& p1, float& m_reg, float& mn, float& alpha) {
  constexpr float C = SCALE * 1.4426950408889634f;
  float pmax = p0[0]; for (int r = 1; r < 16; ++r) pmax = fmaxf(pmax, p0[r]); for (int r = 0; r < 16; ++r) pmax = fmaxf(pmax, p1[r]);
  { auto rr = __builtin_amdgcn_permlane32_swap(__float_as_uint(pmax), __float_as_uint(pmax), false, false);
    pmax = fmaxf(__uint_as_float(rr[0]), __uint_as_float(rr[1])); }
  if (__builtin_expect(__all(pmax - m_reg <= THR / SCALE), 1)) { mn = m_reg; alpha = 1.f; }
  else { mn = fmaxf(m_reg, pmax); alpha = __builtin_amdgcn_exp2f((m_reg - mn) * C); m_reg = mn; }
  float mnC = -mn * C;
  for (int r = 0; r < 16; ++r) p0[r] = fmaf(p0[r], C, mnC); for (int r = 0; r < 16; ++r) p1[r] = fmaf(p1[r], C, mnC);
  for (int r = 0; r < 16; ++r) p0[r] = __builtin_amdgcn_exp2f(p0[r]);
}
__device__ __forceinline__ void finishSM(f32x16& p0, f32x16& p1, float alpha, float& l_reg, bf16x8& pa0, bf16x8& pa1, bf16x8& pa2, bf16x8& pa3) {
  for (int r = 0; r < 16; ++r) p1[r] = __builtin_amdgcn_exp2f(p1[r]);
  float ps = 0; for (int r = 0; r < 16; ++r) ps += p0[r]; for (int r = 0; r < 16; ++r) ps += p1[r];
  { auto rr = __builtin_amdgcn_permlane32_swap(__float_as_uint(ps), __float_as_uint(ps), false, false);
    ps = __uint_as_float(rr[0]) + __uint_as_float(rr[1]); }
  l_reg = l_reg * alpha + ps;
#define PK4(P, BASE, OUT) do { unsigned a0 = cvtpk(P[BASE + 0], P[BASE + 1]), a1 = cvtpk(P[BASE + 2], P[BASE + 3]);   \
    unsigned b0 = cvtpk(P[BASE + 4], P[BASE + 5]), b1 = cvtpk(P[BASE + 6], P[BASE + 7]);                              \
    auto r0 = __builtin_amdgcn_permlane32_swap(a0, b0, false, false); auto r1 = __builtin_amdgcn_permlane32_swap(a1, b1, false, false); \
    u32x4 w = {r0[0], r1[0], r0[1], r1[1]}; OUT = *reinterpret_cast<bf16x8*>(&w); } while (0)
  PK4(p0, 0, pa0); PK4(p0, 8, pa1); PK4(p1, 0, pa2); PK4(p1, 8, pa3);
#undef PK4
}
__device__ __forceinline__ void qkt(f32x16& p0, f32x16& p1, const bf16* Ks, const bf16x8* qr, int r32, int hi) {
  p0 = f32x16{}; p1 = f32x16{};
  for (int d0 = 0; d0 < 8; ++d0) { int cb = (d0 * 16 + hi * 8) * 2;
    bf16x8 b0 = *reinterpret_cast<const bf16x8*>((const char*)Ks + KSWZ(r32, cb));
    bf16x8 b1 = *reinterpret_cast<const bf16x8*>((const char*)Ks + KSWZ(32 + r32, cb));
    p0 = __builtin_amdgcn_mfma_f32_32x32x16_bf16(b0, qr[d0], p0, 0, 0, 0);
    p1 = __builtin_amdgcn_mfma_f32_32x32x16_bf16(b1, qr[d0], p1, 0, 0, 0); }
}
__device__ __forceinline__ int v_st(int k, int c) { const int kk = (k & ~0xC) | ((k & 4) << 1) | ((k & 8) >> 1); return ((kk >> 3) * 4 + (c >> 5)) * 512 + ((kk & 7) * 32 + (c & 31)) * 2; }
__device__ __forceinline__ int v_rd_base(int lane) { return ((lane & 3) << 3) | (((lane >> 2) & 3) << 6) | (((lane >> 4) & 1) << 5) | (((lane >> 5) & 1) << 8); }
constexpr int v_rd_off(int d0, int ks, int half) { return d0 * 512 + ks * 4096 + half * 2048; }
template <int OFF> __device__ __forceinline__ s16x4 tr_read(int vb) {
  s16x4 r; asm volatile("ds_read_b64_tr_b16 %0, %1 offset:%2" : "=&v"(r) : "v"(vb), "i"(OFF) : "memory"); return r;
}
template <int D0> __device__ __forceinline__ void pv_one(f32x16& od, int vb, bf16x8 pa0, bf16x8 pa1, bf16x8 pa2, bf16x8 pa3) {
  const s16x4 l0 = tr_read<v_rd_off(D0, 0, 0)>(vb), h0 = tr_read<v_rd_off(D0, 0, 1)>(vb), l1 = tr_read<v_rd_off(D0, 1, 0)>(vb), h1 = tr_read<v_rd_off(D0, 1, 1)>(vb);
  const s16x4 l2 = tr_read<v_rd_off(D0, 2, 0)>(vb), h2 = tr_read<v_rd_off(D0, 2, 1)>(vb), l3 = tr_read<v_rd_off(D0, 3, 0)>(vb), h3 = tr_read<v_rd_off(D0, 3, 1)>(vb);
  asm volatile("s_waitcnt lgkmcnt(0)" ::: "memory"); SBAR();
#define PK(L, H) (bf16x8){L[0], L[1], L[2], L[3], H[0], H[1], H[2], H[3]}
  od = __builtin_amdgcn_mfma_f32_32x32x16_bf16(pa0, PK(l0, h0), od, 0, 0, 0);
  od = __builtin_amdgcn_mfma_f32_32x32x16_bf16(pa1, PK(l1, h1), od, 0, 0, 0);
  od = __builtin_amdgcn_mfma_f32_32x32x16_bf16(pa2, PK(l2, h2), od, 0, 0, 0);
  od = __builtin_amdgcn_mfma_f32_32x32x16_bf16(pa3, PK(l3, h3), od, 0, 0, 0);
#undef PK
}
__device__ __forceinline__ void pv_d0(f32x16* o, int vb, bf16x8 pa0, bf16x8 pa1, bf16x8 pa2, bf16x8 pa3) {
  pv_one<0>(o[0], vb, pa0, pa1, pa2, pa3); pv_one<1>(o[1], vb, pa0, pa1, pa2, pa3); pv_one<2>(o[2], vb, pa0, pa1, pa2, pa3); pv_one<3>(o[3], vb, pa0, pa1, pa2, pa3);
}
__device__ __forceinline__ void attn_unit(const bf16* __restrict__ Qb, const bf16* __restrict__ Kh, const bf16* __restrict__ Vh, bf16* __restrict__ Ob, int seq, char* lds, int wave_s,
                                          const float* __restrict__ qg, const float* __restrict__ rope, int t0) {
  constexpr int SDEPTH = 2;
  int tid_ = wave_s * 64 + lane_id(); asm volatile("" : "+v"(tid_));
  const int tid = tid_, wid = tid >> 6, lane = tid & 63, r32 = lane & 31, hi = lane >> 5;
  bf16* V_lds = (bf16*)lds; bf16* K_lds = (bf16*)(lds + 2 * SHM_V);
  float* ws = (float*)(lds + 2 * SHM_V + 2 * SHM_K) + wid * 64; float* li_l = ws; float* al_l = ws + 32;
  float m_reg = -1e30f, l_reg = 0; f32x16 o[4] = {}; bf16x8 qr[8];
  const bf16* Qw = Qb + (long)(wid * QBLK + r32) * LDQ + hi * 8;
  {
    float qf[8][8]; float ss = 0.f;
#pragma unroll
    for (int d0 = 0; d0 < 8; ++d0) { const bf16x8 raw = ld8(Qw + d0 * 16);
#pragma unroll
      for (int e = 0; e < 8; ++e) { qf[d0][e] = __uint_as_float(((unsigned)(unsigned short)raw[e]) << 16); ss += qf[d0][e] * qf[d0][e]; } }
    ss += __shfl_xor(ss, 32);
    const float rr = 1.0f / sqrtf(ss * (1.0f / 128.0f) + 1e-6f);
#pragma unroll
    for (int d0 = 0; d0 < 8; ++d0) { const float* gp = qg + d0 * 16 + hi * 8;
#pragma unroll
      for (int e = 0; e < 8; ++e) qf[d0][e] = qf[d0][e] * rr * gp[e]; }
    if (rope != nullptr) {
      const int t = t0 + wid * QBLK + r32, rowc = t >> 6, colc = t & 63;
#pragma unroll
      for (int pr = 0; pr < 4; ++pr) { const int d0 = (pr & 1) + (pr >> 1) * 4;
        const float* cs = rope + ((pr >> 1) ? colc : rowc) * 32 + (d0 & 1) * 16 + hi * 8; const float* sn = cs + 2048;
#pragma unroll
        for (int e = 0; e < 8; ++e) { const float c = cs[e], s = sn[e], x1 = qf[d0][e], x2 = qf[d0 + 2][e]; qf[d0][e] = x1 * c - x2 * s; qf[d0 + 2][e] = x1 * s + x2 * c; } }
    }
#pragma unroll
    for (int d0 = 0; d0 < 8; ++d0) { u32x4 w = {cvtpk(qf[d0][0], qf[d0][1]), cvtpk(qf[d0][2], qf[d0][3]), cvtpk(qf[d0][4], qf[d0][5]), cvtpk(qf[d0][6], qf[d0][7])}; qr[d0] = *reinterpret_cast<bf16x8*>(&w); }
  }
  const int sr = tid >> 4, sc = (tid & 15) * 8, vst0 = v_st(sr, sc), vst1 = v_st(32 + sr, sc);
  const int vb0 = (int)(uintptr_t)V_lds + v_rd_base(lane);
  struct { bf16x8 vs0, vs1, ks0, ks1; } sr_[SDEPTH];
#define SLOAD(i, k0) do { sr_[i].vs0 = ld8(&Vh[(long)((k0) + sr) * LDK + sc]); sr_[i].vs1 = ld8(&Vh[(long)((k0) + 32 + sr) * LDK + sc]); \
    sr_[i].ks0 = ld8(&Kh[(long)((k0) + sr) * LDK + sc]); sr_[i].ks1 = ld8(&Kh[(long)((k0) + 32 + sr) * LDK + sc]); } while (0)
#define SWRITE(b, i) do { *(bf16x8*)((char*)V_lds + (b) * SHM_V + vst0) = sr_[i].vs0;          \
    *(bf16x8*)((char*)V_lds + (b) * SHM_V + vst1) = sr_[i].vs1; int kc = sc * 2;               \
    *(bf16x8*)((char*)K_lds + (b) * SHM_K + KSWZ(sr, kc)) = sr_[i].ks0;                       \
    *(bf16x8*)((char*)K_lds + (b) * SHM_K + KSWZ(32 + sr, kc)) = sr_[i].ks1; } while (0)
#define SWAIT() asm volatile("s_waitcnt vmcnt(4)" ::: "memory")
#define RESC(a) do { if (__any((a) < 1.f)) { if (hi == 0) al_l[r32] = (a); asm volatile("s_waitcnt lgkmcnt(0)" ::: "memory"); \
    for (int d = 0; d < 4; ++d) for (int r = 0; r < 16; ++r) o[d][r] *= al_l[crow(r, hi)]; } } while (0)
  f32x16 pA0, pA1, pB0, pB1; float mnA, mnB, alA, alB; bf16x8 pa0, pa1, pa2, pa3; const int NT = seq / KVBLK;
  constexpr int SE = 0, SO = SDEPTH - 1;
  SLOAD(SE, 0); asm volatile("s_waitcnt vmcnt(0)" ::: "memory"); SWRITE(0, SE); __syncthreads();
  qkt(pA0, pA1, K_lds, qr, r32, hi); partialSM(pA0, pA1, m_reg, mnA, alA);
  SLOAD(SO, KVBLK); if (2 < NT) SLOAD(SE, 2 * KVBLK);
  SWAIT(); SWRITE(1, SO); __syncthreads();
  for (int j = 1; j + 1 < NT; j += 2) {
    SBAR(); qkt(pB0, pB1, (bf16*)((char*)K_lds + SHM_K), qr, r32, hi);
    finishSM(pA0, pA1, alA, l_reg, pa0, pa1, pa2, pa3); SBAR();
    SLOAD(SO, (j + SDEPTH) * KVBLK); SBAR();
    pv_d0(o, vb0, pa0, pa1, pa2, pa3); partialSM(pB0, pB1, m_reg, mnB, alB);
    __syncthreads(); SWAIT(); SWRITE(0, SE);
    RESC(alB); __syncthreads();
    SBAR(); qkt(pA0, pA1, K_lds, qr, r32, hi);
    finishSM(pB0, pB1, alB, l_reg, pa0, pa1, pa2, pa3); SBAR();
    if (j + 3 < NT) SLOAD(SE, (j + 1 + SDEPTH) * KVBLK); SBAR();
    pv_d0(o, vb0 + (int)SHM_V, pa0, pa1, pa2, pa3); partialSM(pA0, pA1, m_reg, mnA, alA);
    __syncthreads(); SWAIT(); SWRITE(1, SO);
    RESC(alA); __syncthreads();
  }
  SBAR(); qkt(pB0, pB1, (bf16*)((char*)K_lds + SHM_K), qr, r32, hi);
  finishSM(pA0, pA1, alA, l_reg, pa0, pa1, pa2, pa3); SBAR();
  pv_d0(o, vb0, pa0, pa1, pa2, pa3); partialSM(pB0, pB1, m_reg, mnB, alB);
  __syncthreads(); RESC(alB);
  finishSM(pB0, pB1, alB, l_reg, pa0, pa1, pa2, pa3); SBAR();
  pv_d0(o, vb0 + (int)SHM_V, pa0, pa1, pa2, pa3);
  if (hi == 0) li_l[r32] = l_reg; asm volatile("s_waitcnt lgkmcnt(0)" ::: "memory");
  float rli[16];
#pragma unroll
  for (int r = 0; r < 16; ++r) rli[r] = __builtin_amdgcn_rcpf(li_l[crow(r, hi)]);
  bf16* Ow = Ob + (long)(wid * QBLK) * LDO;
#pragma unroll
  for (int r = 0; r < 16; ++r) { int orow = crow(r, hi);
    for (int d0 = 0; d0 < 4; ++d0) { const float v = o[d0][r] * rli[r]; unsigned u = __float_as_uint(v); u = (u + 0x7fffu + ((u >> 16) & 1u)) >> 16;
      Ow[(long)orow * LDO + d0 * 32 + r32] = (bf16)u; } }
  __syncthreads();
#undef SLOAD
#undef SWRITE
#undef SWAIT
#undef RESC
}
#undef KSWZ
#undef SBAR
}
constexpr int DM = 2048, NB = 8, SEQ = 4096, CTXL = 256, DEPTH = 4;
constexpr int TPB = SEQ + CTXL;
constexpr int M = NB * TPB;
constexpr int ZW = 3584, FF = 5632, NMOD = 6 * DM;
constexpr int CONVW = 512, SSMW = 512, ATTW = 1024, NG = 32, NP = 64, NSG = 16;
constexpr int Z_CV = 0, Z_CB = 512, Z_CC = 1024, Z_SSM = 1536, Z_Q = 2048, Z_K = 3072, Z_V = 3328;
constexpr int MIX_CONV = 0, MIX_SSM = 512, MIX_ATT = 1024;
constexpr float RMS_EPS = 1e-6f;
constexpr int NWAVES = 8;
#ifndef REP_MASK
#define REP_MASK 0
#endif
#define NREP(b) (1 + ((REP_MASK >> (b)) & 1))

constexpr size_t MiB = 1u << 20;
constexpr size_t WS_CTL = 0, CTL_ZERO_BYTES = 1 * MiB;
constexpr size_t WS_MODP = 1 * MiB;
constexpr size_t WS_MOD  = 15 * MiB;
constexpr size_t WS_ROPE = 17 * MiB;
constexpr size_t WS_BBAR = 18 * MiB;
constexpr size_t WS_POW  = 20 * MiB;
constexpr size_t WS_KT   = 25 * MiB;
constexpr size_t WS_W    = 33 * MiB, W_LAYER = 89 * MiB;
constexpr size_t W_IN = 0, W_OUT = 14 * MiB, W_GU = 22 * MiB, W_DOWN = 66 * MiB, W_GLU = 88 * MiB;
constexpr size_t WS_TW   = WS_W + 4 * W_LAYER;
constexpr size_t WS_W1   = WS_TW + 96 * MiB;
constexpr size_t WS_X    = WS_W1 + 32 * MiB;
constexpr size_t WS_H    = WS_X + 272 * MiB;
constexpr size_t WS_Y    = WS_H + 136 * MiB;
constexpr size_t WS_UH   = WS_Y, WS_SB = WS_Y + 60 * MiB;
constexpr size_t WS_Z    = WS_Y + 136 * MiB;
constexpr size_t WS_MIX  = WS_Z + 238 * MiB;
constexpr size_t WS_ACT  = WS_Z;
constexpr size_t WS_G    = WS_MIX + 136 * MiB;
constexpr size_t WS_YP   = WS_G + 34 * MiB;
constexpr size_t WS_END  = WS_YP + 64 * MiB;
static_assert((size_t)M * DM * 4 == 272 * MiB && (size_t)M * ZW * 2 == 238 * MiB && (size_t)M * FF * 2 == 374 * MiB && (size_t)32 * SSM_RPG * UH_LD * 2 == 60 * MiB && (size_t)32 * SSM_RPG * 256 * 4 == 40 * MiB, "ws map");
static_assert(WS_END <= 1536 * MiB, "ws budget");
constexpr int CW_BAR = 4096;

constexpr int RING_OFF = 0, RING_BYTES = 131072;
constexpr int LDSCTL_OFF = RING_BYTES, MISC_OFF = LDSCTL_OFF + 320;
constexpr int LDS_BYTES = 147456;

#define GAS __attribute__((address_space(1)))
#define LAS __attribute__((address_space(3)))
typedef unsigned short bf16;
typedef unsigned v4u __attribute__((ext_vector_type(4)));
typedef unsigned v2u __attribute__((ext_vector_type(2)));
typedef float f32x4 __attribute__((ext_vector_type(4)));
typedef float f32x2 __attribute__((ext_vector_type(2)));
#define LDS_WAIT() asm volatile("s_waitcnt lgkmcnt(0)" ::: "memory")
#define VM_WAIT() asm volatile("s_waitcnt vmcnt(0)" ::: "memory")
__device__ __forceinline__ unsigned f2bf(float f) { unsigned u = __builtin_bit_cast(unsigned, f); return (u + 0x7fffu + ((u >> 16) & 1u)) >> 16; }
__device__ __forceinline__ unsigned pk2(float lo, float hi) { return f2bf(lo) | (f2bf(hi) << 16); }
__device__ __forceinline__ float blo(unsigned w) { return __uint_as_float(w << 16); }
__device__ __forceinline__ float bhi(unsigned w) { return __uint_as_float(w & 0xffff0000u); }
__device__ __forceinline__ float wave_sum(float v) {
#pragma unroll
    for (int o = 1; o < 64; o <<= 1) v += __shfl_xor(v, o);
    return v;
}

#define XB_TMO      128
#define XB_XCNT(j)  (256  + 64 * (j))
#define XB_XSUB(j)  (1280 + 64 * (j))
#define XB_XGEN(j)  (2304 + 64 * (j))
#define XB_TOP      3328
#define XB_TOPGEN   3392
#define XCD_BAR_WORDS 3456
#define XB_SPIN_CAP (1u << 18)

__device__ __forceinline__ unsigned xb_ld(unsigned* p)              { return __hip_atomic_load(p, __ATOMIC_RELAXED, __HIP_MEMORY_SCOPE_AGENT); }
__device__ __forceinline__ unsigned xb_add(unsigned* p, unsigned v) { return __hip_atomic_fetch_add(p, v, __ATOMIC_RELAXED, __HIP_MEMORY_SCOPE_AGENT); }
__device__ __forceinline__ unsigned xb_xcc_id() { return (unsigned)__builtin_amdgcn_s_getreg((3 << 11) | 20) & 0xFu; }
#define XB_SPIN(cond, bar) do { unsigned _sp = 0; while (cond) { __builtin_amdgcn_s_sleep(1); \
    if ((++_sp & 255u) == 0u) { if (xb_ld(&(bar)[XB_TMO])) break; if (_sp > XB_SPIN_CAP) { atomicAdd(&(bar)[XB_TMO], 1u); break; } } } } while (0)

struct XcdBarrier {
    unsigned* bar; unsigned x;
    volatile LAS unsigned* st;
};

__device__ __forceinline__ XcdBarrier xcd_barrier_post(unsigned* bar, volatile LAS unsigned* st, bool leader  ) {
    XcdBarrier b; b.bar = bar; b.x = xb_xcc_id(); b.st = st;
    if (leader) (void)xb_add(&bar[XB_XCNT(b.x)], 1u);
    return b;
}
__device__ __forceinline__ void xcd_barrier_complete(unsigned* bar, unsigned x, unsigned& nloc, unsigned& nx) {
    const unsigned G = gridDim.x * gridDim.y * gridDim.z;
    unsigned sum, cnt, mine, sp = 0u;
    for (;;) {
        sum = 0u; cnt = 0u; mine = 0u;
#pragma unroll
        for (unsigned j = 0; j < 16; ++j) { const unsigned c = xb_ld(&bar[XB_XCNT(j)]); sum += c; cnt += (c > 0u) ? 1u : 0u; mine = (j == x) ? c : mine; }
        if (sum == G) break;
        __builtin_amdgcn_s_sleep(1);
        if ((++sp & 255u) == 0u) { if (xb_ld(&bar[XB_TMO])) break; if (sp > XB_SPIN_CAP) { atomicAdd(&bar[XB_TMO], 1u); break; } }
    }
    nloc = mine > 0u ? mine : 1u; nx = cnt > 0u ? cnt : 1u;
}

__device__ __forceinline__ void xcd_barrier(const XcdBarrier& b, bool leader  ) {
    asm volatile("s_waitcnt vmcnt(0)" ::: "memory");
    __syncthreads();
    if (leader) {
        unsigned* bar = b.bar;
        __builtin_amdgcn_s_waitcnt(0);
        unsigned nloc = b.st[0], nx = b.st[1];
        if (nloc == 0u) { xcd_barrier_complete(bar, b.x, nloc, nx); b.st[0] = nloc; b.st[1] = nx; }
        const unsigned old = xb_add(&bar[XB_XSUB(b.x)], 1u);
        const unsigned gen = old / nloc;
        if (old + 1u == (gen + 1u) * nloc) {
            __builtin_amdgcn_fence(__ATOMIC_RELEASE, "agent");
            asm volatile("s_waitcnt vmcnt(0)" ::: "memory");
            const unsigned og = xb_add(&bar[XB_TOP], 1u);
            const unsigned tg = og / nx;
            if (og + 1u == (tg + 1u) * nx) xb_add(&bar[XB_TOPGEN], 1u);
            else XB_SPIN(xb_ld(&bar[XB_TOPGEN]) == tg, bar);
            __builtin_amdgcn_fence(__ATOMIC_ACQUIRE, "agent");
            xb_add(&bar[XB_XGEN(b.x)], 1u);
            asm volatile("s_waitcnt vmcnt(0)" ::: "memory");
        } else {
            XB_SPIN(xb_ld(&bar[XB_XGEN(b.x)]) == gen, bar);
            __builtin_amdgcn_fence(__ATOMIC_ACQUIRE, "agent");
            asm volatile("s_waitcnt vmcnt(0)" ::: "memory");
        }
    }
    __syncthreads();
}

struct Params { const float* in[28]; float* out; unsigned char* ws; int ph_lo, ph_hi; };
typedef const __attribute__((address_space(4))) Params* KP;
__device__ __forceinline__ KP kparams() { KP kp = (KP)__builtin_amdgcn_kernarg_segment_ptr(); asm volatile("" : "+s"(kp)); return kp; }
enum { I_X = 0, I_C, I_CTX, I_CCTX, I_WMOD, I_BMOD, I_GPREMIX, I_GPOSTMIX, I_GPREFFN, I_GPOSTFFN, I_WIN, I_CONVW, I_LAMRE, I_LAMIM, I_LOGDT, I_BRE, I_BIM, I_CRE, I_CIM,
       I_SSMD, I_WGLU, I_BGLU, I_QNORM, I_KNORM, I_WOUT, I_WGATE, I_WUP, I_WDOWN };

__device__ __forceinline__ void transpose_item(const float* __restrict__ W, int K, int N, bf16* WT, int k0, int n0, int dst_row0, LAS float* scr, int lane) {
#pragma unroll 8
    for (int i = 0; i < 32; ++i) { const int kk = 2 * i + (lane >> 5); scr[kk * 33 + (lane & 31)] = W[(size_t)(k0 + kk) * N + n0 + (lane & 31)]; }
    LDS_WAIT(); asm volatile("" ::: "memory");
    const int c = lane & 7;
#pragma unroll
    for (int j = 0; j < 4; ++j) { const int n = (lane >> 3) + 8 * j; const LAS float* s = scr + (8 * c) * 33 + n;
        v4u o; o.x = pk2(s[0 * 33], s[1 * 33]); o.y = pk2(s[2 * 33], s[3 * 33]); o.z = pk2(s[4 * 33], s[5 * 33]); o.w = pk2(s[6 * 33], s[7 * 33]);
        *(GAS v4u*)(WT + (size_t)(dst_row0 + n) * K + k0 + 8 * c) = o; }
    LDS_WAIT(); asm volatile("" ::: "memory");
}
constexpr int IT_MOD = DEPTH * 8 * 48;
constexpr int IT_ROPE = 32, IT_SSM = 256;
constexpr int TPL_IN = 32 * 112, TPL_OUT = 32 * 64, TPL_G = 32 * 176, TPL_D = 88 * 64, TPL_GLU = 8 * 16;
constexpr int TPL = TPL_IN + TPL_OUT + 2 * TPL_G + TPL_D + TPL_GLU;
constexpr int IT_TOTAL = IT_MOD + IT_ROPE + IT_SSM + DEPTH * TPL;

__device__ __forceinline__ void prologue_a(KP P, LAS unsigned char* lds, int wave, int lane) {
    LAS float* scr = (LAS float*)(lds + RING_OFF + wave * 16384);
    const int G = gridDim.x, gw = wave * G + (int)blockIdx.x, NGW = NWAVES * G;
    unsigned char* ws = P->ws;
    for (int it = gw; it < IT_TOTAL; it += NGW) {
        int r = it;
        if (r < IT_MOD) {
            const int l = r / 384, kc = (r % 384) / 48, nc = r % 48;
#pragma unroll
            for (int j = 0; j < 9; ++j)
#pragma unroll
                for (int q = 0; q < 4; ++q) { const int kk = q * 64 + lane, k = kc * 256 + kk;
                    const float cv = (j < 8) ? P->in[I_C][j * DM + k] : P->in[I_CCTX][k];
                    scr[j * 256 + kk] = cv / (1.0f + __expf(-cv)); }
            LDS_WAIT(); asm volatile("" ::: "memory");
            f32x4 acc[9];
#pragma unroll
            for (int j = 0; j < 9; ++j) acc[j] = (f32x4){0.f, 0.f, 0.f, 0.f};
            const float* wp = P->in[I_WMOD] + ((size_t)l * DM + kc * 256) * NMOD + nc * 256 + lane * 4;
#pragma unroll 8
            for (int kk = 0; kk < 256; ++kk) { const f32x4 w = *(const f32x4*)(wp + (size_t)kk * NMOD);
#pragma unroll
                for (int j = 0; j < 9; ++j) { const float s = scr[j * 256 + kk]; acc[j] += w * s; } }
            float* mp = (float*)(ws + WS_MODP) + ((size_t)(kc * DEPTH + l) * 9) * NMOD + nc * 256 + lane * 4;
#pragma unroll
            for (int j = 0; j < 9; ++j) *(f32x4*)(mp + (size_t)j * NMOD) = acc[j];
            LDS_WAIT(); asm volatile("" ::: "memory");
            continue;
        }
        r -= IT_MOD;
        if (r < IT_ROPE) {
            const int e = r * 64 + lane, coord = e >> 5, i = e & 31;
            const double inv = exp(-(double)i * (9.210340371976184 / 32.0));
            const double ang = (double)coord * inv;
            float* rp = (float*)(ws + WS_ROPE);
            rp[e] = (float)cos(ang); rp[2048 + e] = (float)sin(ang);
            continue;
        }
        r -= IT_ROPE;
        if (r < IT_SSM) {
            const int idx = r * 64 + lane;
            const int p = idx & 63, ldg = idx >> 6;
            const double lre = (double)P->in[I_LAMRE][idx], lim = (double)P->in[I_LAMIM][idx];
            const double dt = exp((double)P->in[I_LOGDT][ldg]);
            const double ea = exp(lre * dt), th = lim * dt;
            const double lbre = ea * cos(th), lbim = ea * sin(th);
            const double nr = lbre - 1.0, ni = lbim, dd = lre * lre + lim * lim;
            const double qre = (nr * lre + ni * lim) / dd, qim = (ni * lre - nr * lim) / dd;
            f32x2* bb = (f32x2*)(ws + WS_BBAR) + (size_t)idx * 16;
#pragma unroll
            for (int n = 0; n < 16; ++n) {
                const double bre = (double)P->in[I_BRE][(size_t)idx * 16 + n], bim = (double)P->in[I_BIM][(size_t)idx * 16 + n];
                bb[n] = (f32x2){(float)(qre * bre - qim * bim), (float)(qre * bim + qim * bre)};
            }
            f32x2* pw = (f32x2*)(ws + WS_POW) + (size_t)ldg * 33 * 64 + p;
            for (int e = 0; e <= 32; ++e) { const double m = exp(lre * dt * (double)e), a = th * (double)e; pw[e * 64] = (f32x2){(float)(m * cos(a)), (float)(m * sin(a))}; }
            continue;
        }
        r -= IT_SSM;
        const int l = r / TPL; r -= l * TPL;
        bf16* wl = (bf16*)(ws + WS_W + (size_t)l * W_LAYER);
        if (r < TPL_IN) { const int kb = r / 112, nb = r % 112; transpose_item(P->in[I_WIN] + (size_t)l * DM * ZW, DM, ZW, (bf16*)((unsigned char*)wl + W_IN), 64 * kb, 32 * nb, 32 * nb, scr, lane); continue; }
        r -= TPL_IN;
        if (r < TPL_OUT) { const int kb = r / 64, nb = r % 64; transpose_item(P->in[I_WOUT] + (size_t)l * DM * DM, DM, DM, (bf16*)((unsigned char*)wl + W_OUT), 64 * kb, 32 * nb, 32 * nb, scr, lane); continue; }
        r -= TPL_OUT;
        if (r < 2 * TPL_G) { const int up = r >= TPL_G; if (up) r -= TPL_G; const int kb = r / 176, nb = r % 176, n0 = 32 * nb;
            transpose_item(P->in[up ? I_WUP : I_WGATE] + (size_t)l * DM * FF, DM, FF, (bf16*)((unsigned char*)wl + W_GU), 64 * kb, n0, (n0 >> 7) * 256 + (n0 & 127) + (up ? 128 : 0), scr, lane); continue; }
        r -= 2 * TPL_G;
        if (r < TPL_D) { const int kb = r / 64, nb = r % 64; transpose_item(P->in[I_WDOWN] + (size_t)l * FF * DM, FF, DM, (bf16*)((unsigned char*)wl + W_DOWN), 64 * kb, 32 * nb, 32 * nb, scr, lane); continue; }
        r -= TPL_D;
        { const int kb = r / 16, nb = r % 16; transpose_item(P->in[I_WGLU] + (size_t)l * 512 * 512, 512, 512, (bf16*)((unsigned char*)wl + W_GLU), 64 * kb, 32 * nb, 32 * nb, scr, lane); }
    }
}
__device__ __forceinline__ void prologue_b(KP P, int tid) {
    const int total = DEPTH * 9 * NMOD;
    const float* mp = (const float*)(P->ws + WS_MODP); float* mo = (float*)(P->ws + WS_MOD);
    for (int idx = (int)blockIdx.x * 512 + tid; idx < total; idx += (int)gridDim.x * 512) {
        const int l = idx / (9 * NMOD), n = idx % NMOD;
        float s = P->in[I_BMOD][l * NMOD + n];
#pragma unroll
        for (int kc = 0; kc < 8; ++kc) s += mp[(size_t)kc * total + idx];
        const int ch = n / DM, col = n - ch * DM;
        if (ch == 1) s = P->in[I_GPREMIX][l * DM + col] * (1.0f + s);
        else if (ch == 2) s = s * P->in[I_GPOSTMIX][l * DM + col];
        else if (ch == 4) s = P->in[I_GPREFFN][l * DM + col] * (1.0f + s);
        else if (ch == 5) s = s * P->in[I_GPOSTFFN][l * DM + col];
        mo[idx] = s;
    }
}

__device__ __forceinline__ void prologue_kt(KP P, int tid) {
    const f32x2* pw = (const f32x2*)(P->ws + WS_POW); const f32x2* bbar = (const f32x2*)(P->ws + WS_BBAR); float* kt = (float*)(P->ws + WS_KT);
    for (int idx = (int)blockIdx.x * 512 + tid; idx < DEPTH * 32 * 2 * 32 * 16; idx += (int)gridDim.x * 512) {
        const int no = idx & 15, tau = (idx >> 4) & 31, dir = (idx >> 9) & 1, g = (idx >> 10) & 31, l = idx >> 15;
        const int ldg = (l * 2 + dir) * 32 + g;
        float acc[16];
#pragma unroll
        for (int n = 0; n < 16; ++n) acc[n] = 0.f;
        for (int p = 0; p < 64; ++p) {
            const float cre = P->in[I_CRE][((size_t)ldg * 16 + no) * 64 + p], cim = P->in[I_CIM][((size_t)ldg * 16 + no) * 64 + p];
            const f32x2 w = pw[((size_t)ldg * 33 + tau) * 64 + p];
            const float are = cre * w[0] - cim * w[1], aim = cre * w[1] + cim * w[0];
            const f32x4* bp = (const f32x4*)(bbar + ((size_t)ldg * 64 + p) * 16);
#pragma unroll
            for (int q = 0; q < 8; ++q) { const f32x4 b2 = bp[q]; acc[2 * q] += are * b2[0] - aim * b2[1]; acc[2 * q + 1] += are * b2[2] - aim * b2[3]; }
        }
#pragma unroll
        for (int q = 0; q < 4; ++q) *(f32x4*)(kt + (size_t)idx * 16 + q * 4) = (f32x4){acc[q * 4], acc[q * 4 + 1], acc[q * 4 + 2], acc[q * 4 + 3]};
    }
}
__device__ __forceinline__ void prologue_s5w(KP P, int tid) {
    const f32x2* pw = (const f32x2*)(P->ws + WS_POW); const f32x2* bbar = (const f32x2*)(P->ws + WS_BBAR); const float* kt = (const float*)(P->ws + WS_KT);
    bf16* TW = (bf16*)(P->ws + WS_TW); bf16* W1 = (bf16*)(P->ws + WS_W1);
    for (int it = (int)blockIdx.x * 512 + tid; it < DEPTH * 32 * 65536; it += (int)gridDim.x * 512) {
        const int lg = it >> 16, l = lg >> 5, g = lg & 31; int r = it & 65535; float v[8];
        if (r < 49152) {
            const int row = r / 96, ch = r - row * 96, t = row >> 4, no = row & 15, k0 = ch * 8;
            if (k0 < 512) {
                const int s = k0 >> 4, ni0 = k0 & 15;
#pragma unroll
                for (int e = 0; e < 8; ++e) v[e] = 0.f;
                if (t >= s) { const float* kp = kt + ((((size_t)(l * 32 + g) * 2 + 0) * 32 + (t - s)) * 16 + no) * 16 + ni0;
#pragma unroll
                    for (int e = 0; e < 8; ++e) v[e] += kp[e]; }
                if (s >= t) { const float* kp = kt + ((((size_t)(l * 32 + g) * 2 + 1) * 32 + (s - t)) * 16 + no) * 16 + ni0;
#pragma unroll
                    for (int e = 0; e < 8; ++e) v[e] += kp[e]; }
                if (t == s) { const float dv = P->in[I_SSMD][l * SSMW + g * NSG + no];
#pragma unroll
                    for (int e = 0; e < 8; ++e) if (ni0 + e == no) v[e] += dv; }
            } else {
                const int kk = k0 - 512, dir = kk >> 7, part = (kk >> 6) & 1, p0 = kk & 63, ep = dir == 0 ? t + 1 : 32 - t, ldg = (l * 2 + dir) * 32 + g;
#pragma unroll
                for (int e = 0; e < 8; ++e) { const int p = p0 + e; const f32x2 w = pw[((size_t)ldg * 33 + ep) * 64 + p];
                    const float cre = P->in[I_CRE][((size_t)ldg * 16 + no) * 64 + p], cim = P->in[I_CIM][((size_t)ldg * 16 + no) * 64 + p];
                    v[e] = part == 0 ? (cre * w[0] - cim * w[1]) : -(cre * w[1] + cim * w[0]); }
            }
            v4u o; o.x = pk2(v[0], v[1]); o.y = pk2(v[2], v[3]); o.z = pk2(v[4], v[5]); o.w = pk2(v[6], v[7]);
            *(v4u*)(TW + ((size_t)lg * 512 + row) * 768 + k0) = o;
        } else {
            r -= 49152;
            const int r1 = r >> 6, ch = r & 63, dir = r1 >> 7, part = (r1 >> 6) & 1, p = r1 & 63, k0 = ch * 8, s = k0 >> 4, n0 = k0 & 15, ep = dir == 0 ? 31 - s : s, ldg = (l * 2 + dir) * 32 + g;
            const f32x2 w = pw[((size_t)ldg * 33 + ep) * 64 + p]; const f32x2* bp = bbar + ((size_t)ldg * 64 + p) * 16 + n0;
#pragma unroll
            for (int e = 0; e < 8; ++e) { const f32x2 b2 = bp[e]; v[e] = part == 0 ? (w[0] * b2[0] - w[1] * b2[1]) : (w[0] * b2[1] + w[1] * b2[0]); }
            v4u o; o.x = pk2(v[0], v[1]); o.y = pk2(v[2], v[3]); o.z = pk2(v[4], v[5]); o.w = pk2(v[6], v[7]);
            *(v4u*)(W1 + ((size_t)lg * 256 + r1) * 512 + k0) = o;
        }
    }
}

struct Thin {
    int init, fin;
    const float* x_lat; const float* x_ctx; const bf16* X; bf16* Xout; const bf16* Y; bf16* H; float* OUT;
    const float* modg; int gc;
    const float* mods; int sc;
    const float* YP; int ctx_mode;
};
__device__ __forceinline__ void thin_rows(const Thin& T, int wave, int lane) {
    const int G = gridDim.x;
    for (int r = (int)blockIdx.x * NWAVES + wave; r < M; r += G * NWAVES) {
        const int b = r / TPB, p = r - b * TPB, j = (p < CTXL) ? 8 : b;
        if ((T.fin || T.ctx_mode == 0) && p < CTXL) continue;
        float x[32], y[32];
        f32x4 ga[8], mu[8], sh[8];
        const float* gate = T.init ? nullptr : T.modg + (size_t)(j * 6 + T.gc) * DM;
        const float* shift = T.mods + (size_t)(j * 6 + T.sc) * DM; const float* mul = shift + DM;
        if (T.init) {
            const float* xsrc = (p < CTXL) ? T.x_ctx + ((size_t)b * CTXL + p) * DM : T.x_lat + ((size_t)b * SEQ + (p - CTXL)) * DM;
#pragma unroll
            for (int c = 0; c < 4; ++c) { const f32x4 a = *(const f32x4*)(xsrc + c * 512 + lane * 8), d = *(const f32x4*)(xsrc + c * 512 + lane * 8 + 4);
                x[c * 8 + 0] = a[0]; x[c * 8 + 1] = a[1]; x[c * 8 + 2] = a[2]; x[c * 8 + 3] = a[3]; x[c * 8 + 4] = d[0]; x[c * 8 + 5] = d[1]; x[c * 8 + 6] = d[2]; x[c * 8 + 7] = d[3]; }
        } else {
            v4u xw[4], yw[4];
#pragma unroll
            for (int c = 0; c < 4; ++c) xw[c] = *(const v4u*)(T.X + (size_t)r * DM + c * 512 + lane * 8);
            if (p < CTXL && T.ctx_mode == 2) {
#pragma unroll
                for (int e = 0; e < 32; ++e) y[e] = 0.f;
#pragma unroll
                for (int q = 0; q < 4; ++q) { const float* yp = T.YP + ((size_t)q * 2048 + b * CTXL + p) * DM;
#pragma unroll
                    for (int c = 0; c < 4; ++c) { const f32x4 a = *(const f32x4*)(yp + c * 512 + lane * 8), d = *(const f32x4*)(yp + c * 512 + lane * 8 + 4);
                        y[c * 8 + 0] += a[0]; y[c * 8 + 1] += a[1]; y[c * 8 + 2] += a[2]; y[c * 8 + 3] += a[3]; y[c * 8 + 4] += d[0]; y[c * 8 + 5] += d[1]; y[c * 8 + 6] += d[2]; y[c * 8 + 7] += d[3]; } }
            } else {
#pragma unroll
                for (int c = 0; c < 4; ++c) yw[c] = *(const v4u*)(T.Y + (size_t)r * DM + c * 512 + lane * 8);
#pragma unroll
                for (int c = 0; c < 4; ++c) { const v4u w = yw[c];
                    y[c * 8 + 0] = blo(w.x); y[c * 8 + 1] = bhi(w.x); y[c * 8 + 2] = blo(w.y); y[c * 8 + 3] = bhi(w.y); y[c * 8 + 4] = blo(w.z); y[c * 8 + 5] = bhi(w.z); y[c * 8 + 6] = blo(w.w); y[c * 8 + 7] = bhi(w.w); }
            }
#pragma unroll
            for (int c = 0; c < 4; ++c) { ga[2 * c] = *(const f32x4*)(gate + c * 512 + lane * 8); ga[2 * c + 1] = *(const f32x4*)(gate + c * 512 + lane * 8 + 4); }
#pragma unroll
            for (int c = 0; c < 4; ++c) { const v4u w = xw[c];
                x[c * 8 + 0] = blo(w.x); x[c * 8 + 1] = bhi(w.x); x[c * 8 + 2] = blo(w.y); x[c * 8 + 3] = bhi(w.y); x[c * 8 + 4] = blo(w.z); x[c * 8 + 5] = bhi(w.z); x[c * 8 + 6] = blo(w.w); x[c * 8 + 7] = bhi(w.w); }
        }
        if (!T.fin) {
#pragma unroll
            for (int c = 0; c < 4; ++c) { mu[2 * c] = *(const f32x4*)(mul + c * 512 + lane * 8); mu[2 * c + 1] = *(const f32x4*)(mul + c * 512 + lane * 8 + 4);
                sh[2 * c] = *(const f32x4*)(shift + c * 512 + lane * 8); sh[2 * c + 1] = *(const f32x4*)(shift + c * 512 + lane * 8 + 4); }
        }
        if (!T.init) {
            float ss = 0.f;
#pragma unroll
            for (int e = 0; e < 32; ++e) ss += y[e] * y[e];
            ss = wave_sum(ss);
            const float r1 = 1.0f / sqrtf(ss * (1.0f / DM) + RMS_EPS);
#pragma unroll
            for (int e = 0; e < 32; ++e) x[e] += ga[e >> 2][e & 3] * (y[e] * r1);
        }
        if (T.fin) {
            float* o = T.OUT + ((size_t)b * SEQ + (p - CTXL)) * DM;
#pragma unroll
            for (int c = 0; c < 4; ++c) { *(f32x4*)(o + c * 512 + lane * 8) = (f32x4){x[c * 8 + 0], x[c * 8 + 1], x[c * 8 + 2], x[c * 8 + 3]}; *(f32x4*)(o + c * 512 + lane * 8 + 4) = (f32x4){x[c * 8 + 4], x[c * 8 + 5], x[c * 8 + 6], x[c * 8 + 7]}; }
            continue;
        }
        float ss2 = 0.f;
#pragma unroll
        for (int e = 0; e < 32; ++e) ss2 += x[e] * x[e];
        ss2 = wave_sum(ss2);
        const float r2 = 1.0f / sqrtf(ss2 * (1.0f / DM) + RMS_EPS);
        bf16* xo = T.Xout + (size_t)r * DM; bf16* ho = T.H + (size_t)r * DM;
#pragma unroll
        for (int c = 0; c < 4; ++c) {
            v4u w; w.x = pk2(x[c * 8 + 0], x[c * 8 + 1]); w.y = pk2(x[c * 8 + 2], x[c * 8 + 3]); w.z = pk2(x[c * 8 + 4], x[c * 8 + 5]); w.w = pk2(x[c * 8 + 6], x[c * 8 + 7]); *(v4u*)(xo + c * 512 + lane * 8) = w;
            float hv[8];
#pragma unroll
            for (int e = 0; e < 8; ++e) hv[e] = (x[c * 8 + e] * r2) * mu[2 * c + (e >> 2)][e & 3] + sh[2 * c + (e >> 2)][e & 3];
            v4u hw; hw.x = pk2(hv[0], hv[1]); hw.y = pk2(hv[2], hv[3]); hw.z = pk2(hv[4], hv[5]); hw.w = pk2(hv[6], hv[7]); *(v4u*)(ho + c * 512 + lane * 8) = hw; }
    }
}
__device__ __forceinline__ void unpack8(const v4u w, float* f) { f[0] = blo(w.x); f[1] = bhi(w.x); f[2] = blo(w.y); f[3] = bhi(w.y); f[4] = blo(w.z); f[5] = bhi(w.z); f[6] = blo(w.w); f[7] = bhi(w.w); }
__device__ __forceinline__ void prep_row(KP P, int l, int r, int lane) {
    bf16* Z = (bf16*)(P->ws + WS_Z); bf16* MIX = (bf16*)(P->ws + WS_MIX); const float* rope = (const float*)(P->ws + WS_ROPE);
    const int b = r / TPB, p = r - b * TPB; const bool lat = p >= CTXL;
    const int seg_lo = lat ? CTXL : 0, seg_hi = lat ? TPB : CTXL;
    bf16* zr = Z + (size_t)r * ZW;
    const int ch = lane * 8, sub = lane & 31, t = p - CTXL, rowc = t >> 6, colc = t & 63;
    const bool hasp = p > seg_lo, hasn = p + 1 < seg_hi;
    const v4u zv = *(const v4u*)(zr + Z_CV + ch), zb = *(const v4u*)(zr + Z_CB + ch), zc = *(const v4u*)(zr + Z_CC + ch);
    const v4u zero4 = {0u, 0u, 0u, 0u};
    const v4u pv = hasp ? *(const v4u*)(zr - ZW + Z_CV + ch) : zero4, pc = hasp ? *(const v4u*)(zr - ZW + Z_CC + ch) : zero4;
    const v4u nv = hasn ? *(const v4u*)(zr + ZW + Z_CV + ch) : zero4, nc = hasn ? *(const v4u*)(zr + ZW + Z_CC + ch) : zero4;
    bf16* kp = zr + Z_K + lane * 4;
    const v2u kw = *(const v2u*)kp;
    const float* cw = P->in[I_CONVW] + (size_t)l * 3 * CONVW + ch;
    f32x4 w0[2], w1[2], w2[2];
#pragma unroll
    for (int h = 0; h < 2; ++h) { w0[h] = *(const f32x4*)(cw + h * 4); w1[h] = *(const f32x4*)(cw + CONVW + h * 4); w2[h] = *(const f32x4*)(cw + 2 * CONVW + h * 4); }
    const f32x4 kg = *(const f32x4*)(P->in[I_KNORM] + l * 128 + sub * 4);
    f32x4 cs = {1.f, 1.f, 1.f, 1.f}, sn = {0.f, 0.f, 0.f, 0.f};
    if (lat) { const float* cp = rope + ((sub < 16) ? rowc : colc) * 32 + (sub & 7) * 4; cs = *(const f32x4*)cp; sn = *(const f32x4*)(cp + 2048); }
    asm volatile("" ::: "memory");
    {
        float v[8], gb[8], gc[8], a[8], c[8], o[8];
        unpack8(zv, v); unpack8(zb, gb); unpack8(zc, gc);
        float uc[8], up[8], un[8];
#pragma unroll
        for (int e = 0; e < 8; ++e) uc[e] = gc[e] * v[e];
        unpack8(pv, a); unpack8(pc, c);
#pragma unroll
        for (int e = 0; e < 8; ++e) up[e] = a[e] * c[e];
        unpack8(nv, a); unpack8(nc, c);
#pragma unroll
        for (int e = 0; e < 8; ++e) un[e] = a[e] * c[e];
#pragma unroll
        for (int h = 0; h < 2; ++h)
#pragma unroll
            for (int e = 0; e < 4; ++e) { const int k = h * 4 + e; o[k] = gb[k] * (w0[h][e] * up[k] + w1[h][e] * uc[k] + w2[h][e] * un[k]); }
        v4u w; w.x = pk2(o[0], o[1]); w.y = pk2(o[2], o[3]); w.z = pk2(o[4], o[5]); w.w = pk2(o[6], o[7]);
        *(v4u*)(MIX + (size_t)r * DM + MIX_CONV + ch) = w;
    }
    {
        float k[4]; k[0] = blo(kw.x); k[1] = bhi(kw.x); k[2] = blo(kw.y); k[3] = bhi(kw.y);
        float ss = k[0] * k[0] + k[1] * k[1] + k[2] * k[2] + k[3] * k[3];
        ss += __shfl_xor(ss, 1); ss += __shfl_xor(ss, 2); ss += __shfl_xor(ss, 4); ss += __shfl_xor(ss, 8); ss += __shfl_xor(ss, 16);
        const float rr = 1.0f / sqrtf(ss * (1.0f / 128.0f) + RMS_EPS);
#pragma unroll
        for (int e = 0; e < 4; ++e) k[e] = k[e] * rr * kg[e];
        if (lat) {
#pragma unroll
            for (int e = 0; e < 4; ++e) { const float other = __shfl_xor(k[e], 8);
                k[e] = ((sub & 8) == 0) ? (k[e] * cs[e] - other * sn[e]) : (other * sn[e] + k[e] * cs[e]); }
        }
        v2u w; w.x = pk2(k[0], k[1]); w.y = pk2(k[2], k[3]); *(v2u*)kp = w;
    }
}

__device__ __forceinline__ void s5_carry_phase(KP P, int l, int wave, int lane) {
    const int G = gridDim.x;
    bf16* UH = (bf16*)(P->ws + WS_UH); const float* SB = (const float*)(P->ws + WS_SB);
    for (int it = wave * G + (int)blockIdx.x; it < 32 * NB * 2; it += NWAVES * G) {
        const int dir = it & 1, b = (it >> 1) & 7, g = it >> 4;
        const f32x2 l32 = ((const f32x2*)(P->ws + WS_POW))[((size_t)((l * 2 + dir) * 32 + g) * 33 + 32) * 64 + lane];
        float hre = 0.f, him = 0.f;
        for (int k0 = 0; k0 < SSM_CPB; k0 += 8) {
            float sre[8], sim[8]; size_t rowi[8];
#pragma unroll
            for (int q = 0; q < 8; ++q) { const int k = k0 + q, c = dir == 0 ? k : (k < 8 ? 7 - k : 143 - k);
                rowi[q] = (size_t)g * SSM_RPG + ssm_rg(b, c);
                const float* sp = SB + rowi[q] * 256 + dir * 128 + lane; sre[q] = sp[0]; sim[q] = sp[64]; }
            asm volatile("" ::: "memory");
#pragma unroll
            for (int q = 0; q < 8; ++q) {
                bf16* up = UH + rowi[q] * UH_LD + 512 + dir * 128 + lane;
                up[0] = (bf16)f2bf(hre); up[64] = (bf16)f2bf(him);
                const float nre = l32[0] * hre - l32[1] * him + sre[q], nim = l32[0] * him + l32[1] * hre + sim[q];
                hre = nre; him = nim;
            }
        }
    }
}

__device__ __forceinline__ void attention_phase(KP P, int l, unsigned char* lds_generic, int wave_s) {
    const bf16* Z = (const bf16*)(P->ws + WS_Z); bf16* MIX = (bf16*)(P->ws + WS_MIX);
    const int G = gridDim.x;
    for (int i = 0; ; ++i) {
        int b, h, qb;
        if (G == 256) { if (i >= 4) break; const int xcd = blockIdx.x & 7, slot = blockIdx.x >> 3; const int pair = 2 * xcd + (i >> 1), uip = (i & 1) * 32 + slot; b = pair >> 1; h = (pair & 1) * 4 + (uip >> 4); qb = uip & 15; }
        else { const int u = i * G + blockIdx.x; if (u >= 1024) break; b = u >> 7; h = (u >> 4) & 7; qb = u & 15; }
        const int kvh = h >> 2; const size_t row0 = (size_t)b * TPB;
        attn::attn_unit(Z + (row0 + CTXL + qb * 256) * ZW + Z_Q + h * 128, Z + row0 * ZW + Z_K + kvh * 128, Z + row0 * ZW + Z_V + kvh * 128,
                        MIX + (row0 + CTXL + qb * 256) * DM + MIX_ATT + h * 128, TPB, (char*)lds_generic, wave_s, P->in[I_QNORM] + l * 128, (const float*)(P->ws + WS_ROPE), qb * 256);
    }
    if (l < DEPTH - 1) {
        for (int u = blockIdx.x; u < NB * 8; u += G) { const int b = u >> 3, h = u & 7, kvh = h >> 2; const size_t row0 = (size_t)b * TPB;
            attn::attn_unit(Z + row0 * ZW + Z_Q + h * 128, Z + row0 * ZW + Z_K + kvh * 128, Z + row0 * ZW + Z_V + kvh * 128, MIX + row0 * DM + MIX_ATT + h * 128, CTXL, (char*)lds_generic, wave_s, P->in[I_QNORM] + l * 128, nullptr, 0); }
    }
}
constexpr int PH_PRO = 3, PH_PER_LAYER = 10, PH_TOTAL = PH_PRO + DEPTH * PH_PER_LAYER;
__global__ void __launch_bounds__(NWAVES * 64, 2) trunk_fwd(Params Pval) {
    extern __shared__ __attribute__((aligned(16))) unsigned char lds_raw[];
    LAS unsigned char* lds = (LAS unsigned char*)lds_raw;
    const int wave = __builtin_amdgcn_readfirstlane((int)threadIdx.x >> 6);

    const int G = gridDim.x;
    for (int u = wave * 64 + lane_id(); u < (LDS_BYTES - LDSCTL_OFF) / 4; u += NWAVES * 64) ((LAS unsigned*)(lds + LDSCTL_OFF))[u] = 0u;
    __syncthreads();
    (void)Pval;
    KP P = kparams();
    const int lo = P->ph_lo, hi = P->ph_hi;
    unsigned char* ws = P->ws;
    XcdBarrier bar; bar.bar = (unsigned*)(ws + WS_CTL) + CW_BAR; bar.x = 0; bar.st = nullptr;
    if (hi - lo > 1) bar = xcd_barrier_post((unsigned*)(ws + WS_CTL) + CW_BAR, (volatile LAS unsigned*)(lds + MISC_OFF) + 8, wave == 0 && lane_id() == 0);
#define IN(k) (lo <= (k) && (k) < hi)
#define SEAM(k) do { if (IN((k) + 1)) { const bool ldr_ = (wave == 0) && (lane_id() == 0); xcd_barrier(bar, ldr_); if (NREP(17) > 1) xcd_barrier(bar, ldr_); } } while (0)

    if (IN(0)) { for (int rep = 0; rep < NREP(0); ++rep) prologue_a(P, lds, wave, lane_id()); SEAM(0); }
    if (IN(1)) { for (int rep = 0; rep < NREP(0); ++rep) { prologue_b(P, wave * 64 + lane_id()); prologue_kt(P, wave * 64 + lane_id()); } SEAM(1); }
    if (IN(2)) {
        for (int rep = 0; rep < NREP(0); ++rep) prologue_s5w(P, wave * 64 + lane_id());
        Thin T{}; T.init = 1; T.fin = 0; T.x_lat = P->in[I_X]; T.x_ctx = P->in[I_CTX]; T.X = (const bf16*)(ws + WS_X); T.Xout = (bf16*)(ws + WS_X); T.Y = nullptr; T.H = (bf16*)(ws + WS_H); T.OUT = nullptr;
        T.modg = nullptr; T.gc = 0; T.mods = (const float*)(ws + WS_MOD); T.sc = 0; T.YP = nullptr; T.ctx_mode = 1;
        for (int rep = 0; rep < NREP(0); ++rep) thin_rows(T, wave, lane_id()); SEAM(2);
    }
    for (int l = 0; l < DEPTH; ++l) {
        const int pb = PH_PRO + l * PH_PER_LAYER;
        if (pb + PH_PER_LAYER <= lo || pb >= hi) continue;
        P = kparams(); ws = P->ws;
        const unsigned char* wl = ws + WS_W + (size_t)l * W_LAYER;
        const float* modl = (const float*)(ws + WS_MOD) + (size_t)l * 9 * NMOD;
        const bool lastl = (l == DEPTH - 1);
        float* YPp = (float*)(ws + WS_YP);
        if (IN(pb + 0)) {
            pg8::Gemm g{(const bf16*)(ws + WS_H), (const bf16*)(wl + W_IN), M, ZW, DM}; pg8::RowOrder S{ZW / 256, G, (int)blockIdx.x, 1, 0};
            pg8::EpiInProj E{(bf16*)(ws + WS_Z), (bf16*)(ws + WS_UH)};
            for (int rep = 0; rep < NREP(3); ++rep) pg8::gemm_phase<pg8::EpiInProj, pg8::RowOrder, true, true>(lds + RING_OFF, g, S, E, wave);
            SEAM(pb + 0);
        }
        if (IN(pb + 1)) {
            for (int r = (int)blockIdx.x * NWAVES + wave; r < M; r += NWAVES * G) prep_row(P, l, r, lane_id());
            pg8::Gemm g{(const bf16*)(ws + WS_UH), (const bf16*)(ws + WS_W1) + (size_t)l * 32 * 256 * 512, 0, 0, 512, UH_LD, 512}; pg8::S5Order1 S{G, (int)blockIdx.x};
            pg8::EpiS5State E{(float*)(ws + WS_SB)};
            for (int rep = 0; rep < NREP(13); ++rep) pg8::gemm_phase<pg8::EpiS5State, pg8::S5Order1, true, true>(lds + RING_OFF, g, S, E, wave);
            SEAM(pb + 1);
        }
        if (IN(pb + 2)) { for (int rep = 0; rep < NREP(14); ++rep) s5_carry_phase(P, l, wave, lane_id()); SEAM(pb + 2); }
        if (IN(pb + 3)) {
            { pg8::Gemm g{(const bf16*)(ws + WS_UH), (const bf16*)(ws + WS_TW) + (size_t)l * 32 * 512 * 768, 0, 0, 768, UH_LD, 768}; pg8::S5Order2 S{G, (int)blockIdx.x, l < DEPTH - 1 ? 5 : 4};
              pg8::EpiS5Out E{(bf16*)(ws + WS_G)};
              for (int rep = 0; rep < NREP(15); ++rep) pg8::gemm_phase<pg8::EpiS5Out, pg8::S5Order2, true, true>(lds + RING_OFF, g, S, E, wave); }
            __syncthreads();
            for (int rep = 0; rep < NREP(12); ++rep) attention_phase(P, l, lds_raw, wave);
            SEAM(pb + 3);
        }
        if (IN(pb + 4)) {
            pg8::Gemm g{(const bf16*)(ws + WS_G), (const bf16*)(wl + W_GLU), M, SSMW, SSMW}; pg8::RowOrder S{SSMW / 256, G, (int)blockIdx.x, lastl ? 0 : 1, 0};
            pg8::EpiGlu E{(const bf16*)(ws + WS_G), SSMW, (bf16*)(ws + WS_MIX) + MIX_SSM, DM, P->in[I_BGLU] + l * SSMW};
            for (int rep = 0; rep < NREP(11); ++rep) pg8::gemm_phase<pg8::EpiGlu, pg8::RowOrder, true, true>(lds + RING_OFF, g, S, E, wave);
            SEAM(pb + 4);
        }
        if (IN(pb + 5)) {
            pg8::Gemm g{(const bf16*)(ws + WS_MIX), (const bf16*)(wl + W_OUT), M, DM, DM}; pg8::RowOrder S{DM / 256, G, (int)blockIdx.x, lastl ? 0 : 2, DM / 256};
            pg8::EpiBf16 E{(bf16*)(ws + WS_Y), DM, YPp, DM / 64};
            for (int rep = 0; rep < NREP(6); ++rep) pg8::gemm_phase<pg8::EpiBf16, pg8::RowOrder, true, true>(lds + RING_OFF, g, S, E, wave);
            SEAM(pb + 5);
        }
        if (IN(pb + 6)) {
            Thin T{}; T.init = 0; T.fin = 0; T.x_lat = nullptr; T.x_ctx = nullptr; T.X = (const bf16*)(ws + WS_X); T.Xout = (bf16*)(ws + WS_X); T.Y = (const bf16*)(ws + WS_Y); T.H = (bf16*)(ws + WS_H); T.OUT = nullptr;
            T.modg = modl; T.gc = 2; T.mods = modl; T.sc = 3; T.YP = YPp; T.ctx_mode = lastl ? 0 : 2;
            if (NREP(7) > 1) { Thin T2 = T; T2.Xout = (bf16*)(ws + WS_Z); thin_rows(T2, wave, lane_id()); }
            thin_rows(T, wave, lane_id()); SEAM(pb + 6);
        }
        if (IN(pb + 7)) {
            pg8::Gemm g{(const bf16*)(ws + WS_H), (const bf16*)(wl + W_GU), M, 2 * FF, DM}; pg8::RowOrder S{2 * FF / 256, G, (int)blockIdx.x, lastl ? 0 : 1, 0};
            pg8::EpiSwiGlu E{(bf16*)(ws + WS_ACT), FF};
            for (int rep = 0; rep < NREP(8); ++rep) pg8::gemm_phase<pg8::EpiSwiGlu, pg8::RowOrder, true, true>(lds + RING_OFF, g, S, E, wave);
            SEAM(pb + 7);
        }
        if (IN(pb + 8)) {
            pg8::Gemm g{(const bf16*)(ws + WS_ACT), (const bf16*)(wl + W_DOWN), M, DM, FF}; pg8::RowOrder S{DM / 256, G, (int)blockIdx.x, lastl ? 0 : 2, FF / 256};
            pg8::EpiBf16 E{(bf16*)(ws + WS_Y), DM, YPp, FF / 64};
            for (int rep = 0; rep < NREP(9); ++rep) pg8::gemm_phase<pg8::EpiBf16, pg8::RowOrder, true, true>(lds + RING_OFF, g, S, E, wave);
            SEAM(pb + 8);
        }
        if (IN(pb + 9)) {
            const bool last = (l == DEPTH - 1); const int l2 = last ? l : l + 1;
            Thin T{}; T.init = 0; T.fin = last ? 1 : 0; T.x_lat = nullptr; T.x_ctx = nullptr; T.X = (const bf16*)(ws + WS_X); T.Xout = (bf16*)(ws + WS_X); T.Y = (const bf16*)(ws + WS_Y); T.H = (bf16*)(ws + WS_H); T.OUT = P->out;
            T.modg = modl; T.gc = 5; T.mods = (const float*)(ws + WS_MOD) + (size_t)l2 * 9 * NMOD; T.sc = 0; T.YP = YPp; T.ctx_mode = lastl ? 0 : 2;
            if (NREP(7) > 1) { Thin T2 = T; T2.Xout = (bf16*)(ws + WS_Z); thin_rows(T2, wave, lane_id()); }
            thin_rows(T, wave, lane_id()); SEAM(pb + 9);
        }
    }
#undef IN
#undef SEAM
}

extern "C" void kernel_launch(void* const* d_in, const int* in_sizes, int n_in, void* d_out, int out_size, void* d_ws, size_t ws_size, hipStream_t stream) {
    static int grid = 0;
    if (grid == 0) {
        if (n_in != 28 || in_sizes[0] != NB * SEQ * DM || out_size != NB * SEQ * DM || ws_size < WS_END) {
            fprintf(stderr, "kernel_launch: built for 28 inputs, x/out of %d floats, >= %zu bytes of workspace; got n_in %d, in0 %d, out %d, ws %zu; nothing launched\n", NB * SEQ * DM, (size_t)WS_END, n_in, n_in > 0 ? in_sizes[0] : -1, out_size, ws_size);
            grid = -1; return; }
        int dev = 0, cus = 0;
        if (hipGetDevice(&dev) != hipSuccess || hipDeviceGetAttribute(&cus, hipDeviceAttributeMultiprocessorCount, dev) != hipSuccess) { fprintf(stderr, "kernel_launch: device query failed\n"); grid = -1; return; }
        if (hipFuncSetAttribute((const void*)trunk_fwd, hipFuncAttributeMaxDynamicSharedMemorySize, LDS_BYTES) != hipSuccess) { fprintf(stderr, "kernel_launch: hipFuncSetAttribute failed\n"); grid = -1; return; }
        int per_cu = 0;
        if (hipOccupancyMaxActiveBlocksPerMultiprocessor(&per_cu, (const void*)trunk_fwd, NWAVES * 64, LDS_BYTES) != hipSuccess || per_cu < 1)
            fprintf(stderr, "kernel_launch: note: occupancy query reports %d workgroups per CU\n", per_cu);
        (void)hipGetLastError();
        grid = cus;
    }
    if (grid < 0) return;
    if (hipMemsetAsync((char*)d_ws + WS_CTL, 0, CTL_ZERO_BYTES, stream) != hipSuccess) { fprintf(stderr, "kernel_launch: memset failed\n"); return; }
    Params p{};
    for (int i = 0; i < 28; ++i) p.in[i] = (const float*)d_in[i];
    p.out = (float*)d_out; p.ws = (unsigned char*)d_ws;
#if MK_ONE_LAUNCH
    p.ph_lo = 0; p.ph_hi = PH_TOTAL;
    hipLaunchKernelGGL(trunk_fwd, dim3(grid), dim3(NWAVES * 64), LDS_BYTES, stream, p);
#else
    for (int k = 0; k < PH_TOTAL; ++k) { p.ph_lo = k; p.ph_hi = k + 1; hipLaunchKernelGGL(trunk_fwd, dim3(grid), dim3(NWAVES * 64), LDS_BYTES, stream, p); }
#endif
    const hipError_t le = hipPeekAtLastError();
    if (le != hipSuccess) fprintf(stderr, "kernel_launch: launch failed: %s\n", hipGetErrorName(le));
}
```

```cpp
#include <hip/hip_runtime.h>
#include <cstdio>
#include <cstdint>
#include <cmath>

#ifndef MK_ONE_LAUNCH
#define MK_ONE_LAUNCH 1
#endif

constexpr int SSM_L = 32, SSM_CPB = 136, SSM_RPG = 1280, UH_LD = 768;
__host__ __device__ __forceinline__ int ssm_rg(int b, int c) { return c >= 8 ? b * 128 + (c - 8) : 1024 + b * 8 + c; }

#ifndef REP_MASK
#define REP_MASK 0
#endif
#define NREP(b) (1 + ((REP_MASK >> (b)) & 1))
__device__ __forceinline__ int lane_id() { int l; asm volatile("v_mbcnt_lo_u32_b32 %0, -1, 0\n\tv_mbcnt_hi_u32_b32 %0, -1, %0" : "=v"(l)); return l; }
namespace pg8 {
#define PG8_LAS __attribute__((address_space(3)))
typedef unsigned short bf16_t;
typedef short bf16x8 __attribute__((ext_vector_type(8)));
typedef float f32x4 __attribute__((ext_vector_type(4)));
typedef unsigned u32x4 __attribute__((ext_vector_type(4)));
constexpr int BM = 256, BK = 64, HALF = 128, HTB = HALF * BK * 2  , STAGE_BYTES = 8 * HTB, NXCD = 8, WGM = 8;

__host__ __device__ __forceinline__ int lds_byte(int r, int c) { const int st = (r >> 4) * 2 + (c >> 5), rr = r & 15, cc = c & 31, ob = rr * 64 + cc * 2; return st * 1024 + (ob ^ (((ob >> 9) & 1) << 5)); }
__host__ __device__ __forceinline__ void stage_rc(int b, int& R, int& C) { const int st = b / 1024, sb = b % 1024, swz = sb ^ (((sb >> 9) & 1) << 5); R = (st >> 1) * 16 + swz / 64; C = (st & 1) * 32 + (swz % 64) / 2; }
__host__ __device__ __forceinline__ int perm32(int rho) { const int n = rho >> 4, i = rho & 15; return 8 * (i >> 2) + 4 * n + (i & 3); }

struct Unit { int pm, pn, ko, nt; };
struct Gemm { const bf16_t* A; const bf16_t* Bt; int M, N, K, lda, ldb; };

struct StaticOrder {
    int nM, nN, nwg, G, c;
    __host__ __device__ void init(int M, int N, int G_, int c_) { nM = M / BM; nN = N / BM; nwg = nM * nN; G = G_; c = c_; }
    __host__ __device__ bool next(int i, Unit& u) const {
        const long L = (long)i * G + c; if (L >= nwg) return false;
        int wgid = (int)L; { const int q = nwg / NXCD, r = nwg % NXCD, xcd = wgid % NXCD, off = wgid / NXCD; wgid = (xcd < r ? xcd * (q + 1) : r * (q + 1) + (xcd - r) * q) + off; }
        const int nig = WGM * nN, gid = wgid / nig, fm = gid * WGM, gsz = (nM - fm) < WGM ? (nM - fm) : WGM;
        u.pm = fm + ((wgid % nig) % gsz); u.pn = (wgid % nig) / gsz; return true;
    }
    __device__ __forceinline__ void a_ready(const Unit&) const {}
    __device__ __forceinline__ void done(const Unit&) const {}
};

__device__ __forceinline__ unsigned cvt_pk_bf16(float lo, float hi) { unsigned r; asm volatile("v_cvt_pk_bf16_f32 %0, %1, %2" : "=v"(r) : "v"(lo), "v"(hi)); return r; }
typedef float f32x2 __attribute__((ext_vector_type(2)));
struct EpiBf16 {
    static constexpr bool PERM = true, AFTER_DRAIN = false; static constexpr int NST = 0;
    bf16_t* O; int ldc; float* YP; int nt_full;
    __device__ __forceinline__ void operator()(const f32x4 (&acc)[2][2][4][2], const Unit& u, int wr, int wc, int fr, int fq) const {
        const int col0 = u.pn * BM + wc * 32 + 8 * fq;
        if (u.nt != nt_full) {
            const int q = u.ko / (u.nt * BK), b = u.pm / 17; float* base = YP + ((size_t)q * 2048 + b * 256 + wr * 64 + fr) * ldc + col0;
#pragma unroll
            for (int ai = 0; ai < 2; ++ai)
#pragma unroll
                for (int m = 0; m < 4; ++m) { float* rowp = base + (size_t)(ai * HALF + m * 16) * ldc;
#pragma unroll
                    for (int bj = 0; bj < 2; ++bj) { *(f32x4*)(rowp + bj * HALF) = acc[ai][bj][m][0]; *(f32x4*)(rowp + bj * HALF + 4) = acc[ai][bj][m][1]; } }
            return;
        }
        const int row0 = u.pm * BM + wr * 64 + fr;
#pragma unroll
        for (int ai = 0; ai < 2; ++ai)
#pragma unroll
            for (int m = 0; m < 4; ++m) { bf16_t* rowp = O + (size_t)(row0 + ai * HALF + m * 16) * ldc + col0;
#pragma unroll
                for (int bj = 0; bj < 2; ++bj) { const f32x4 v0 = acc[ai][bj][m][0], v1 = acc[ai][bj][m][1];
                    u32x4 w; w.x = cvt_pk_bf16(v0[0], v0[1]); w.y = cvt_pk_bf16(v0[2], v0[3]); w.z = cvt_pk_bf16(v1[0], v1[1]); w.w = cvt_pk_bf16(v1[2], v1[3]);
                    *(u32x4*)(rowp + bj * HALF) = w; } }
    }
};
struct RowOrder {
    int nN, G, c, ctx, ntq;
    __device__ bool next(int i, Unit& u) const {
        const int nlat = 128 * nN, L = i * G + c;
        if (L < nlat) {
            const int q = nlat / NXCD, wgid = (L % NXCD) * q + L / NXCD;
            const int nig = WGM * nN, gid = wgid / nig, rem = wgid - gid * nig, pml = gid * WGM + (rem % WGM);
            u.pn = rem / WGM; u.pm = (pml >> 4) * 17 + 1 + (pml & 15); return true;
        }
        const int Lc = L - nlat;
        if (ctx == 1) { if (Lc >= 8 * nN) return false; u.pm = (Lc / nN) * 17; u.pn = Lc % nN; return true; }
        if (ctx == 2) { if (Lc >= 32 * nN) return false; const int t = Lc >> 2; u.pm = (t / nN) * 17; u.pn = t % nN; u.ko = (Lc & 3) * ntq * BK; u.nt = ntq; return true; }
        return false;
    }
    __device__ __forceinline__ void a_ready(const Unit&) const {}
    __device__ __forceinline__ void done(const Unit&) const {}
};
__device__ __forceinline__ float bflo(unsigned w) { return __uint_as_float(w << 16); }
__device__ __forceinline__ float bfhi(unsigned w) { return __uint_as_float(w & 0xffff0000u); }
__device__ __forceinline__ float sigmoidf_(float x) { return __builtin_amdgcn_rcpf(1.0f + __expf(-x)); }
struct EpiGlu {
    static constexpr bool PERM = true, AFTER_DRAIN = false; static constexpr int NST = 0;
    const bf16_t* G; int ldg; bf16_t* O; int ldo; const float* bias;
    __device__ __forceinline__ void operator()(const f32x4 (&acc)[2][2][4][2], const Unit& u, int wr, int wc, int fr, int fq) const {
        const int row0 = u.pm * BM + wr * 64 + fr; const int col0 = u.pn * BM + wc * 32 + 8 * fq;
        f32x4 bv[2][2];
#pragma unroll
        for (int bj = 0; bj < 2; ++bj)
#pragma unroll
            for (int n = 0; n < 2; ++n) bv[bj][n] = *(const f32x4*)(bias + col0 + bj * HALF + 4 * n);
#pragma unroll
        for (int ai = 0; ai < 2; ++ai) {
            u32x4 gv[4][2];
#pragma unroll
            for (int m = 0; m < 4; ++m)
#pragma unroll
                for (int bj = 0; bj < 2; ++bj) gv[m][bj] = *(const u32x4*)(G + (size_t)(row0 + ai * HALF + m * 16) * ldg + col0 + bj * HALF);
            asm volatile("" ::: "memory");
#pragma unroll
            for (int m = 0; m < 4; ++m) { const size_t row = (size_t)(row0 + ai * HALF + m * 16);
#pragma unroll
                for (int bj = 0; bj < 2; ++bj) { const f32x4 v0 = acc[ai][bj][m][0] + bv[bj][0], v1 = acc[ai][bj][m][1] + bv[bj][1];
                    const u32x4 g = gv[m][bj];
                    const float o0 = bflo(g.x) * sigmoidf_(v0[0]), o1 = bfhi(g.x) * sigmoidf_(v0[1]), o2 = bflo(g.y) * sigmoidf_(v0[2]), o3 = bfhi(g.y) * sigmoidf_(v0[3]);
                    const float o4 = bflo(g.z) * sigmoidf_(v1[0]), o5 = bfhi(g.z) * sigmoidf_(v1[1]), o6 = bflo(g.w) * sigmoidf_(v1[2]), o7 = bfhi(g.w) * sigmoidf_(v1[3]);
                    u32x4 w; w.x = cvt_pk_bf16(o0, o1); w.y = cvt_pk_bf16(o2, o3); w.z = cvt_pk_bf16(o4, o5); w.w = cvt_pk_bf16(o6, o7);
                    *(u32x4*)(O + row * ldo + col0 + bj * HALF) = w; } }
            asm volatile("" ::: "memory");
        }
    }
};
struct EpiSwiGlu {
    static constexpr bool PERM = true, AFTER_DRAIN = false; static constexpr int NST = 8;
    bf16_t* O; int ldo;
    __device__ __forceinline__ void operator()(const f32x4 (&acc)[2][2][4][2], const Unit& u, int wr, int wc, int fr, int fq) const {
        const int row0 = u.pm * BM + wr * 64 + fr; const int col0 = u.pn * HALF + wc * 32 + 8 * fq;
#pragma unroll
        for (int ai = 0; ai < 2; ++ai)
#pragma unroll
            for (int m = 0; m < 4; ++m) { const size_t row = (size_t)(row0 + ai * HALF + m * 16);
                float o[8];
#pragma unroll
                for (int n = 0; n < 2; ++n)
#pragma unroll
                    for (int j = 0; j < 4; ++j) { const float g = acc[ai][0][m][n][j], up = acc[ai][1][m][n][j]; o[n * 4 + j] = g * sigmoidf_(g) * up; }
                u32x4 w; w.x = cvt_pk_bf16(o[0], o[1]); w.y = cvt_pk_bf16(o[2], o[3]); w.z = cvt_pk_bf16(o[4], o[5]); w.w = cvt_pk_bf16(o[6], o[7]);
                *(u32x4*)(O + row * ldo + col0) = w; }
    }
};
struct EpiInProj {
    static constexpr bool PERM = true, AFTER_DRAIN = false; static constexpr int NST = 0;
    bf16_t* Z; bf16_t* UH;
    __device__ __forceinline__ void operator()(const f32x4 (&acc)[2][2][4][2], const Unit& u, int wr, int wc, int fr, int fq) const {
        const int row0 = u.pm * BM + wr * 64 + fr; const int col0 = u.pn * BM + wc * 32 + 8 * fq;
        const bool ssm = (u.pn == 6 || u.pn == 7);
#pragma unroll
        for (int ai = 0; ai < 2; ++ai)
#pragma unroll
            for (int m = 0; m < 4; ++m) { const int row = row0 + ai * HALF + m * 16;
                int b = 0, pos = 0; if (ssm) { b = row / 4352; pos = row - b * 4352; }
#pragma unroll
                for (int bj = 0; bj < 2; ++bj) { const f32x4 v0 = acc[ai][bj][m][0], v1 = acc[ai][bj][m][1];
                    u32x4 w; w.x = cvt_pk_bf16(v0[0], v0[1]); w.y = cvt_pk_bf16(v0[2], v0[3]); w.z = cvt_pk_bf16(v1[0], v1[1]); w.w = cvt_pk_bf16(v1[2], v1[3]);
                    const int col = col0 + bj * HALF;
                    if (ssm) { const int sc = col - 1536, g = sc >> 4, n0 = sc & 15; *(u32x4*)(UH + ((size_t)(g * SSM_RPG + ssm_rg(b, pos >> 5)) * UH_LD + (pos & 31) * 16 + n0)) = w; }
                    else *(u32x4*)(Z + (size_t)row * 3584 + col) = w; } }
    }
};
struct EpiS5State {
    static constexpr bool PERM = true, AFTER_DRAIN = false; static constexpr int NST = 0;
    float* S;
    __device__ __forceinline__ void operator()(const f32x4 (&acc)[2][2][4][2], const Unit& u, int wr, int wc, int fr, int fq) const {
        const int row0 = u.pm * BM + wr * 64 + fr; const int col0 = wc * 32 + 8 * fq;
#pragma unroll
        for (int ai = 0; ai < 2; ++ai)
#pragma unroll
            for (int m = 0; m < 4; ++m) { float* rowp = S + (size_t)(row0 + ai * HALF + m * 16) * 256 + col0;
#pragma unroll
                for (int bj = 0; bj < 2; ++bj) { *(f32x4*)(rowp + bj * HALF) = acc[ai][bj][m][0]; *(f32x4*)(rowp + bj * HALF + 4) = acc[ai][bj][m][1]; } }
    }
};
__device__ __forceinline__ float gelu_tanh_(float y) {
    const float z = 0.7978845608028654f * (y + 0.044715f * y * y * y);
    const float t = 1.0f - 2.0f * __builtin_amdgcn_rcpf(__expf(2.0f * z) + 1.0f);
    return 0.5f * y * (1.0f + t);
}
struct EpiS5Out {
    static constexpr bool PERM = true, AFTER_DRAIN = false; static constexpr int NST = 0;
    bf16_t* G;
    __device__ __forceinline__ void operator()(const f32x4 (&acc)[2][2][4][2], const Unit& u, int wr, int wc, int fr, int fq) const {
        const int g = u.pn >> 1, j = u.pn & 1, i = u.pm - 5 * g;
        const int rg0 = i * BM + wr * 64 + fr; const int col0 = j * BM + wc * 32 + 8 * fq;
#pragma unroll
        for (int ai = 0; ai < 2; ++ai)
#pragma unroll
            for (int m = 0; m < 4; ++m) { const int rg = rg0 + ai * HALF + m * 16;
                if (rg < 1088) {
                    int b, c; if (rg < 1024) { b = rg >> 7; c = 8 + (rg & 127); } else { b = (rg - 1024) >> 3; c = (rg - 1024) & 7; }
                    const size_t grow0 = (size_t)b * 4352 + c * 32;
#pragma unroll
                    for (int bj = 0; bj < 2; ++bj) { const f32x4 v0 = acc[ai][bj][m][0], v1 = acc[ai][bj][m][1];
                        const int col = col0 + bj * HALF, t = col >> 4, n0 = col & 15;
                        u32x4 w; w.x = cvt_pk_bf16(gelu_tanh_(v0[0]), gelu_tanh_(v0[1])); w.y = cvt_pk_bf16(gelu_tanh_(v0[2]), gelu_tanh_(v0[3]));
                        w.z = cvt_pk_bf16(gelu_tanh_(v1[0]), gelu_tanh_(v1[1])); w.w = cvt_pk_bf16(gelu_tanh_(v1[2]), gelu_tanh_(v1[3]));
                        *(u32x4*)(G + (grow0 + t) * 512 + g * 16 + n0) = w; } } }
    }
};
struct S5Order1 { int G, c;
    __device__ bool next(int i, Unit& u) const { const int L = i * G + c; if (L >= 160) return false; u.pm = L; u.pn = L / 5; return true; }
    __device__ __forceinline__ void a_ready(const Unit&) const {}
    __device__ __forceinline__ void done(const Unit&) const {} };
struct S5Order2 { int G, c, nt;
    __device__ bool next(int i, Unit& u) const { const int L = i * G + c; if (L >= 32 * nt * 2) return false; const int g = L / (2 * nt), r = L - g * 2 * nt; u.pm = g * 5 + (r >> 1); u.pn = g * 2 + (r & 1); return true; }
    __device__ __forceinline__ void a_ready(const Unit&) const {}
    __device__ __forceinline__ void done(const Unit&) const {} };
template <class Epi, class Sched, bool ALIGN_EPI = false, bool SP2 = false>
__device__ __forceinline__ void gemm_phase(PG8_LAS unsigned char* lds, const Gemm g, const Sched& S, const Epi& E, int wave_s) {
    int tid_ = wave_s * 64 + lane_id(); asm volatile("" : "+v"(tid_));
    const int tid = tid_, wid = __builtin_amdgcn_readfirstlane(tid >> 6), lane = tid & 63, wr = wid >> 2, wc = wid & 3, fr = lane & 15, fq = lane >> 4;
    const int K = g.K, lda = g.lda ? g.lda : K, ldb = g.ldb ? g.ldb : K;
    unsigned voffA[2], voffB[2];
#pragma unroll
    for (int i = 0; i < 2; ++i) { int R, C; stage_rc(tid * 16 + i * 8192, R, C); const int Rb = Epi::PERM ? ((R & ~31) + perm32(R & 31)) : R;
        voffA[i] = (unsigned)(R * lda + C) * 2u; voffB[i] = (unsigned)(Rb * ldb + C) * 2u; }
    const size_t kstep = (size_t)(BK * 2);
    const size_t hstepA = (size_t)HALF * lda * 2, hstepB = (size_t)HALF * ldb * 2;
    const size_t tstepA = 2 * hstepA, tstepB = 2 * hstepB;
    const unsigned ldsw = (unsigned)wid * 1024u;
    const int aoff = lds_byte(wr * 64 + fr, fq * 8), boff = lds_byte(wc * 32 + fr, fq * 8);
#define PG8_SA(b, h) (((b) * 2 + (h)) * HTB)
#define PG8_SB(b, h) ((4 + (b) * 2 + (h)) * HTB)
#define PG8_STAGE(bufoff, gbase, voff) do { _Pragma("unroll") for (int _i = 0; _i < 2; ++_i) \
        __builtin_amdgcn_global_load_lds((const unsigned*)((const char*)(gbase) + (voff)[_i]), (PG8_LAS unsigned*)(lds + (bufoff) + ldsw + _i * 8192), 16, 0, 0); } while (0)
#define PG8_LDA(dst, b, h) do { _Pragma("unroll") for (int m = 0; m < 4; ++m) _Pragma("unroll") for (int k = 0; k < 2; ++k) dst[m][k] = *(const PG8_LAS bf16x8*)(lds + PG8_SA(b, h) + aoff + m * 2048 + k * 1024); } while (0)
#define PG8_LDB(dst, b, h) do { _Pragma("unroll") for (int n = 0; n < 2; ++n) _Pragma("unroll") for (int k = 0; k < 2; ++k) dst[n][k] = *(const PG8_LAS bf16x8*)(lds + PG8_SB(b, h) + boff + n * 2048 + k * 1024); } while (0)
#define PG8_MMA(ai, bj, At, Bt) do { __builtin_amdgcn_s_setprio(1); _Pragma("unroll") for (int m = 0; m < 4; ++m) _Pragma("unroll") for (int n = 0; n < 2; ++n) _Pragma("unroll") for (int k = 0; k < 2; ++k) \
        acc[ai][bj][m][n] = __builtin_amdgcn_mfma_f32_16x16x32_bf16(Bt[n][k], At[m][k], acc[ai][bj][m][n], 0, 0, 0); __builtin_amdgcn_s_setprio(0); } while (0)
#define PG8_WAIT_V(n) asm volatile("s_waitcnt vmcnt(" #n ")" ::: "memory")
#define PG8_WAIT_L(n) asm volatile("s_waitcnt lgkmcnt(" #n ")" ::: "memory")
#define PG8_BAR __builtin_amdgcn_s_barrier()
#define PG8_SCHED __builtin_amdgcn_sched_barrier(0)
    Unit cur, nxt; int ui = 0;
    cur.ko = 0; cur.nt = K / BK; nxt.ko = 0; nxt.nt = K / BK;
    if (!S.next(0, cur)) return;
    f32x4 acc[2][2][4][2];
#pragma unroll
    for (int a = 0; a < 2; ++a)
#pragma unroll
        for (int b = 0; b < 2; ++b)
#pragma unroll
            for (int m = 0; m < 4; ++m)
#pragma unroll
                for (int n = 0; n < 2; ++n) acc[a][b][m][n] = (f32x4){0.f, 0.f, 0.f, 0.f};
    bf16x8 At[4][2], B0[2][2], B1[2][2];
    const char* cA = (const char*)g.A + (size_t)cur.pm * tstepA + (size_t)cur.ko * 2; const char* cB = (const char*)g.Bt + (size_t)cur.pn * tstepB + (size_t)cur.ko * 2;
    S.a_ready(cur);
    if constexpr (SP2) {
        PG8_STAGE(PG8_SB(0, 0), cB, voffB); PG8_STAGE(PG8_SB(0, 1), cB + hstepB, voffB); PG8_STAGE(PG8_SA(0, 0), cA, voffA); PG8_STAGE(PG8_SA(0, 1), cA + hstepA, voffA);
        if (wr == 1) PG8_BAR;
        PG8_WAIT_V(2); PG8_BAR;
        PG8_STAGE(PG8_SB(1, 0), cB + kstep, voffB); PG8_STAGE(PG8_SA(1, 0), cA + kstep, voffA); PG8_STAGE(PG8_SB(1, 1), cB + hstepB + kstep, voffB);
        PG8_WAIT_V(6); PG8_BAR;
    } else {
        PG8_STAGE(PG8_SB(0, 0), cB, voffB); PG8_STAGE(PG8_SA(0, 0), cA, voffA); PG8_STAGE(PG8_SB(0, 1), cB + hstepB, voffB); PG8_STAGE(PG8_SA(0, 1), cA + hstepA, voffA);
        if (wr == 1) PG8_BAR;
        PG8_WAIT_V(4); PG8_BAR;
        PG8_STAGE(PG8_SB(1, 0), cB + kstep, voffB); PG8_STAGE(PG8_SA(1, 0), cA + kstep, voffA); PG8_STAGE(PG8_SB(1, 1), cB + hstepB + kstep, voffB);
        PG8_WAIT_V(6); PG8_BAR;
    }
    for (;;) {
        nxt.ko = 0; nxt.nt = K / BK;
        const bool has_next = S.next(ui + 1, nxt);
        const int nt = cur.nt;
        const char* nA = has_next ? (const char*)g.A + (size_t)nxt.pm * tstepA + (size_t)nxt.ko * 2 : cA; const char* nB = has_next ? (const char*)g.Bt + (size_t)nxt.pn * tstepB + (size_t)nxt.ko * 2 : cB;
        static_assert(SP2, "this build keeps only the two-super-phase K-loop");
#define PG8_TRIP(WV12) { \
            const bool last = (t == nt - 2); \
            const char* a1 = cA + (size_t)(t + 1) * kstep; \
            const char* a2 = last ? nA : cA + (size_t)(t + 2) * kstep; const char* b2 = last ? nB : cB + (size_t)(t + 2) * kstep; \
            const char* a3 = a2 + kstep; const char* b3 = b2 + kstep; \
            if (last && has_next) S.a_ready(nxt); \
              \
            PG8_LDB(B0, 0, 0); PG8_LDB(B1, 0, 1); PG8_SCHED; PG8_LDA(At, 0, 0); PG8_STAGE(PG8_SA(1, 1), a1 + hstepA, voffA); \
            WV12; PG8_WAIT_L(0); PG8_BAR; PG8_MMA(0, 0, At, B0); PG8_MMA(0, 1, At, B1); PG8_BAR; PG8_SCHED; \
              \
            PG8_LDA(At, 0, 1); PG8_STAGE(PG8_SB(0, 0), b2, voffB); PG8_STAGE(PG8_SB(0, 1), b2 + hstepB, voffB); PG8_STAGE(PG8_SA(0, 0), a2, voffA); \
            WV12; PG8_WAIT_L(0); PG8_BAR; PG8_MMA(1, 0, At, B0); PG8_MMA(1, 1, At, B1); PG8_BAR; PG8_SCHED; \
              \
            PG8_LDB(B0, 1, 0); PG8_LDB(B1, 1, 1); PG8_SCHED; PG8_LDA(At, 1, 0); PG8_STAGE(PG8_SA(0, 1), a2 + hstepA, voffA); \
            PG8_WAIT_V(8); PG8_WAIT_L(0); PG8_BAR; PG8_MMA(0, 0, At, B0); PG8_MMA(0, 1, At, B1); PG8_BAR; PG8_SCHED; \
              \
            PG8_LDA(At, 1, 1); PG8_STAGE(PG8_SB(1, 0), b3, voffB); PG8_STAGE(PG8_SB(1, 1), b3 + hstepB, voffB); PG8_STAGE(PG8_SA(1, 0), a3, voffA); \
            PG8_WAIT_V(8); PG8_WAIT_L(0); PG8_BAR; PG8_MMA(1, 0, At, B0); PG8_MMA(1, 1, At, B1); PG8_BAR; PG8_SCHED; }
        int t = 0;
        if constexpr (Epi::NST == 16) { if (ui > 0) { PG8_TRIP(PG8_WAIT_V(24)) t = 2; } }
        if constexpr (Epi::NST == 8) { if (ui > 0) { PG8_TRIP(PG8_WAIT_V(16)) t = 2; } }
        for (; t < nt; t += 2) PG8_TRIP(PG8_WAIT_V(8))
#undef PG8_TRIP
        if constexpr (ALIGN_EPI) { if (wr == 0) PG8_BAR; }
        if constexpr (!Epi::AFTER_DRAIN) { E(acc, cur, wr, wc, fr, fq); S.done(cur); }
        if (!has_next) break;
#pragma unroll
        for (int a = 0; a < 2; ++a)
#pragma unroll
            for (int b = 0; b < 2; ++b)
#pragma unroll
                for (int m = 0; m < 4; ++m)
#pragma unroll
                    for (int n = 0; n < 2; ++n) acc[a][b][m][n] = (f32x4){0.f, 0.f, 0.f, 0.f};
        cur = nxt; cA = nA; cB = nB; ++ui;
        if constexpr (ALIGN_EPI) { if (wr == 1) PG8_BAR; }
    }
    PG8_WAIT_V(0);
    if constexpr (!ALIGN_EPI) { if (wr == 0) PG8_BAR; }
    PG8_BAR;
    if constexpr (Epi::AFTER_DRAIN) { E.fused(acc, cur, wr, wc, fr, fq, lds, wid, lane); S.done(cur); }
#undef PG8_SA
#undef PG8_SB
#undef PG8_STAGE
#undef PG8_LDA
#undef PG8_LDB
#undef PG8_MMA
#undef PG8_WAIT_V
#undef PG8_WAIT_L
#undef PG8_BAR
#undef PG8_SCHED
}
}
namespace attn {
typedef unsigned short bf16;
using bf16x8 = __attribute__((ext_vector_type(8))) short;
using s16x4  = __attribute__((ext_vector_type(4))) short;
using f32x16 = __attribute__((ext_vector_type(16))) float;
using u32x4  = __attribute__((ext_vector_type(4))) unsigned;
constexpr int   D = 128, NW = 8, QBLK = 32, KVBLK = 64;
constexpr float SCALE = 0.088388347648318440f;
constexpr float THR = 8.f;
constexpr int LDQ = 3584, LDK = 3584, LDO = 2048;
constexpr size_t SHM_V = KVBLK * D * 2, SHM_K = KVBLK * D * 2, SHM_ATTN = 2 * SHM_V + 2 * SHM_K + NW * 64 * 4;
#define KSWZ(row, colB) ((row) * 256 + ((colB) ^ (((row) & 7) << 4)))
#define SBAR() __builtin_amdgcn_sched_barrier(0)
__device__ __forceinline__ int crow(int r, int hi) { return (r & 3) + 8 * (r >> 2) + 4 * hi; }
__device__ __forceinline__ unsigned cvtpk(float lo, float hi) { unsigned r; asm volatile("v_cvt_pk_bf16_f32 %0, %1, %2" : "=v"(r) : "v"(lo), "v"(hi)); return r; }
__device__ __forceinline__ bf16x8 ld8(const bf16* p) { return *reinterpret_cast<const bf16x8*>(p); }
__device__ __forceinline__ void partialSM(f32x16& p0, f32x16& p1, float& m_reg, float& mn, float& alpha) {
  constexpr float C = SCALE * 1.4426950408889634f;
  float pmax = p0[0]; for (int r = 1; r < 16; ++r) pmax = fmaxf(pmax, p0[r]); for (int r = 0; r < 16; ++r) pmax = fmaxf(pmax, p1[r]);
  { auto rr = __builtin_amdgcn_permlane32_swap(__float_as_uint(pmax), __float_as_uint(pmax), false, false);
    pmax = fmaxf(__uint_as_float(rr[0]), __uint_as_float(rr[1])); }
  if (__builtin_expect(__all(pmax - m_reg <= THR / SCALE), 1)) { mn = m_reg; alpha = 1.f; }
  else { mn = fmaxf(m_reg, pmax); alpha = __builtin_amdgcn_exp2f((m_reg - mn) * C); m_reg = mn; }
  float mnC = -mn * C;
  for (int r = 0; r < 16; ++r) p0[r] = fmaf(p0[r], C, mnC); for (int r = 0; r < 16; ++r) p1[r] = fmaf(p1[r], C, mnC);
  for (int r = 0; r < 16; ++r) p0[r] = __builtin_amdgcn_exp2f(p0[r]);
}
__device__ __forceinline__ void finishSM(f32x16& p0, f32x16& p1, float alpha, float& l_reg, bf16x8& pa0, bf16x8& pa1, bf16x8& pa2, bf16x8& pa3) {
  for (int r = 0; r < 16; ++r) p1[r] = __builtin_amdgcn_exp2f(p1[r]);
  float ps = 0; for (int r = 0; r < 16; ++r) ps += p0[r]; for (int r = 0; r < 16; ++r) ps += p1[r];
  { auto rr = __builtin_amdgcn_permlane32_swap(__float_as_uint(ps), __float_as_uint(ps), false, false);
    ps = __uint_as_float(rr[0]) + __uint_as_float(rr[1]); }
  l_reg = l_reg * alpha + ps;
#define PK4(P, BASE, OUT) do { unsigned a0 = cvtpk(P[BASE + 0], P[BASE + 1]), a1 = cvtpk(P[BASE + 2], P[BASE + 3]);   \
    unsigned b0 = cvtpk(P[BASE + 4], P[BASE + 5]), b1 = cvtpk(P[BASE + 6], P[BASE + 7]);                              \
    auto r0 = __builtin_amdgcn_permlane32_swap(a0, b0, false, false); auto r1 = __builtin_amdgcn_permlane32_swap(a1, b1, false, false); \
    u32x4 w = {r0[0], r1[0], r0[1], r1[1]}; OUT = *reinterpret_cast<bf16x8*>(&w); } while (0)
  PK4(p0, 0, pa0); PK4(p0, 8, pa1); PK4(p1, 0, pa2); PK4(p1, 8, pa3);
#undef PK4
}
__device__ __forceinline__ void qkt(f32x16& p0, f32x16& p1, const bf16* Ks, const bf16x8* qr, int r32, int hi) {
  p0 = f32x16{}; p1 = f32x16{};
  for (int d0 = 0; d0 < 8; ++d0) { int cb = (d0 * 16 + hi * 8) * 2;
    bf16x8 b0 = *reinterpret_cast<const bf16x8*>((const char*)Ks + KSWZ(r32, cb));
    bf16x8 b1 = *reinterpret_cast<const bf16x8*>((const char*)Ks + KSWZ(32 + r32, cb));
    p0 = __builtin_amdgcn_mfma_f32_32x32x16_bf16(b0, qr[d0], p0, 0, 0, 0);
    p1 = __builtin_amdgcn_mfma_f32_32x32x16_bf16(b1, qr[d0], p1, 0, 0, 0); }
}
__device__ __forceinline__ int v_st(int k, int c) { const int kk = (k & ~0xC) | ((k & 4) << 1) | ((k & 8) >> 1); return ((kk >> 3) * 4 + (c >> 5)) * 512 + ((kk & 7) * 32 + (c & 31)) * 2; }
__device__ __forceinline__ int v_rd_base(int lane) { return ((lane & 3) << 3) | (((lane >> 2) & 3) << 6) | (((lane >> 4) & 1) << 5) | (((lane >> 5) & 1) << 8); }
constexpr int v_rd_off(int d0, int ks, int half) { return d0 * 512 + ks * 4096 + half * 2048; }
template <int OFF> __device__ __forceinline__ s16x4 tr_read(int vb) {
  s16x4 r; asm volatile("ds_read_b64_tr_b16 %0, %1 offset:%2" : "=&v"(r) : "v"(vb), "i"(OFF) : "memory"); return r;
}
template <int D0> __device__ __forceinline__ void pv_one(f32x16& od, int vb, bf16x8 pa0, bf16x8 pa1, bf16x8 pa2, bf16x8 pa3) {
  const s16x4 l0 = tr_read<v_rd_off(D0, 0, 0)>(vb), h0 = tr_read<v_rd_off(D0, 0, 1)>(vb), l1 = tr_read<v_rd_off(D0, 1, 0)>(vb), h1 = tr_read<v_rd_off(D0, 1, 1)>(vb);
  const s16x4 l2 = tr_read<v_rd_off(D0, 2, 0)>(vb), h2 = tr_read<v_rd_off(D0, 2, 1)>(vb), l3 = tr_read<v_rd_off(D0, 3, 0)>(vb), h3 = tr_read<v_rd_off(D0, 3, 1)>(vb);
  asm volatile("s_waitcnt lgkmcnt(0)" ::: "memory"); SBAR();
#define PK(L, H) (bf16x8){L[0], L[1], L[2], L[3], H[0], H[1], H[2], H[3]}
  od = __builtin_amdgcn_mfma_f32_32x32x16_bf16(pa0, PK(l0, h0), od, 0, 0, 0);
  od = __builtin_amdgcn_mfma_f32_32x32x16_bf16(pa1, PK(l1, h1), od, 0, 0, 0);
  od = __builtin_amdgcn_mfma_f32_32x32x16_bf16(pa2, PK(l2, h2), od, 0, 0, 0);
  od = __builtin_amdgcn_mfma_f32_32x32x16_bf16(pa3, PK(l3, h3), od, 0, 0, 0);
#undef PK
}
__device__ __forceinline__ void pv_d0(f32x16* o, int vb, bf16x8 pa0, bf16x8 pa1, bf16x8 pa2, bf16x8 pa3) {
  pv_one<0>(o[0], vb, pa0, pa1, pa2, pa3); pv_one<1>(o[1], vb, pa0, pa1, pa2, pa3); pv_one<2>(o[2], vb, pa0, pa1, pa2, pa3); pv_one<3>(o[3], vb, pa0, pa1, pa2, pa3);
}
__device__ __forceinline__ void attn_unit(const bf16* __restrict__ Qb, const bf16* __restrict__ Kh, const bf16* __restrict__ Vh, bf16* __restrict__ Ob, int seq, char* lds, int wave_s,
                                          const float* __restrict__ qg, const float* __restrict__ rope, int t0) {
  constexpr int SDEPTH = 2;
  int tid_ = wave_s * 64 + lane_id(); asm volatile("" : "+v"(tid_));
  const int tid = tid_, wid = tid >> 6, lane = tid & 63, r32 = lane & 31, hi = lane >> 5;
  bf16* V_lds = (bf16*)lds; bf16* K_lds = (bf16*)(lds + 2 * SHM_V);
  float* ws = (float*)(lds + 2 * SHM_V + 2 * SHM_K) + wid * 64; float* li_l = ws; float* al_l = ws + 32;
  float m_reg = -1e30f, l_reg = 0; f32x16 o[4] = {}; bf16x8 qr[8];
  const bf16* Qw = Qb + (long)(wid * QBLK + r32) * LDQ + hi * 8;
  {
    float qf[8][8]; float ss = 0.f;
#pragma unroll
    for (int d0 = 0; d0 < 8; ++d0) { const bf16x8 raw = ld8(Qw + d0 * 16);
#pragma unroll
      for (int e = 0; e < 8; ++e) { qf[d0][e] = __uint_as_float(((unsigned)(unsigned short)raw[e]) << 16); ss += qf[d0][e] * qf[d0][e]; } }
    ss += __shfl_xor(ss, 32);
    const float rr = 1.0f / sqrtf(ss * (1.0f / 128.0f) + 1e-6f);
#pragma unroll
    for (int d0 = 0; d0 < 8; ++d0) { const float* gp = qg + d0 * 16 + hi * 8;
#pragma unroll
      for (int e = 0; e < 8; ++e) qf[d0][e] = qf[d0][e] * rr * gp[e]; }
    if (rope != nullptr) {
      const int t = t0 + wid * QBLK + r32, rowc = t >> 6, colc = t & 63;
#pragma unroll
      for (int pr = 0; pr < 4; ++pr) { const int d0 = (pr & 1) + (pr >> 1) * 4;
        const float* cs = rope + ((pr >> 1) ? colc : rowc) * 32 + (d0 & 1) * 16 + hi * 8; const float* sn = cs + 2048;
#pragma unroll
        for (int e = 0; e < 8; ++e) { const float c = cs[e], s = sn[e], x1 = qf[d0][e], x2 = qf[d0 + 2][e]; qf[d0][e] = x1 * c - x2 * s; qf[d0 + 2][e] = x1 * s + x2 * c; } }
    }
#pragma unroll
    for (int d0 = 0; d0 < 8; ++d0) { u32x4 w = {cvtpk(qf[d0][0], qf[d0][1]), cvtpk(qf[d0][2], qf[d0][3]), cvtpk(qf[d0][4], qf[d0][5]), cvtpk(qf[d0][6], qf[d0][7])}; qr[d0] = *reinterpret_cast<bf16x8*>(&w); }
  }
  const int sr = tid >> 4, sc = (tid & 15) * 8, vst0 = v_st(sr, sc), vst1 = v_st(32 + sr, sc);
  const int vb0 = (int)(uintptr_t)V_lds + v_rd_base(lane);
  struct { bf16x8 vs0, vs1, ks0, ks1; } sr_[SDEPTH];
#define SLOAD(i, k0) do { sr_[i].vs0 = ld8(&Vh[(long)((k0) + sr) * LDK + sc]); sr_[i].vs1 = ld8(&Vh[(long)((k0) + 32 + sr) * LDK + sc]); \
    sr_[i].ks0 = ld8(&Kh[(long)((k0) + sr) * LDK + sc]); sr_[i].ks1 = ld8(&Kh[(long)((k0) + 32 + sr) * LDK + sc]); } while (0)
#define SWRITE(b, i) do { *(bf16x8*)((char*)V_lds + (b) * SHM_V + vst0) = sr_[i].vs0;          \
    *(bf16x8*)((char*)V_lds + (b) * SHM_V + vst1) = sr_[i].vs1; int kc = sc * 2;               \
    *(bf16x8*)((char*)K_lds + (b) * SHM_K + KSWZ(sr, kc)) = sr_[i].ks0;                       \
    *(bf16x8*)((char*)K_lds + (b) * SHM_K + KSWZ(32 + sr, kc)) = sr_[i].ks1; } while (0)
#define SWAIT() asm volatile("s_waitcnt vmcnt(4)" ::: "memory")
#define RESC(a) do { if (__any((a) < 1.f)) { if (hi == 0) al_l[r32] = (a); asm volatile("s_waitcnt lgkmcnt(0)" ::: "memory"); \
    for (int d = 0; d < 4; ++d) for (int r = 0; r < 16; ++r) o[d][r] *= al_l[crow(r, hi)]; } } while (0)
  f32x16 pA0, pA1, pB0, pB1; float mnA, mnB, alA, alB; bf16x8 pa0, pa1, pa2, pa3; const int NT = seq / KVBLK;
  constexpr int SE = 0, SO = SDEPTH - 1;
  SLOAD(SE, 0); asm volatile("s_waitcnt vmcnt(0)" ::: "memory"); SWRITE(0, SE); __syncthreads();
  qkt(pA0, pA1, K_lds, qr, r32, hi); partialSM(pA0, pA1, m_reg, mnA, alA);
  SLOAD(SO, KVBLK); if (2 < NT) SLOAD(SE, 2 * KVBLK);
  SWAIT(); SWRITE(1, SO); __syncthreads();
  for (int j = 1; j + 1 < NT; j += 2) {
    SBAR(); qkt(pB0, pB1, (bf16*)((char*)K_lds + SHM_K), qr, r32, hi);
    finishSM(pA0, pA1, alA, l_reg, pa0, pa1, pa2, pa3); SBAR();
    SLOAD(SO, (j + SDEPTH) * KVBLK); SBAR();
    pv_d0(o, vb0, pa0, pa1, pa2, pa3); partialSM(pB0, pB1, m_reg, mnB, alB);
    __syncthreads(); SWAIT(); SWRITE(0, SE);
    RESC(alB); __syncthreads();
    SBAR(); qkt(pA0, pA1, K_lds, qr, r32, hi);
    finishSM(pB0, pB1, alB, l_reg, pa0, pa1, pa2, pa3); SBAR();
    if (j + 3 < NT) SLOAD(SE, (j + 1 + SDEPTH) * KVBLK); SBAR();
    pv_d0(o, vb0 + (int)SHM_V, pa0, pa1, pa2, pa3); partialSM(pA0, pA1, m_reg, mnA, alA);
    __syncthreads(); SWAIT(); SWRITE(1, SO);
    RESC(alA); __syncthreads();
  }
  SBAR(); qkt(pB0, pB1, (bf16*)((char*)K_lds + SHM_K), qr, r32, hi);
  finishSM(pA0, pA1, alA, l_reg, pa0, pa1, pa2, pa3); SBAR();
  pv_d0(o, vb0, pa0, pa1, pa2, pa3); partialSM(pB0, pB1, m_reg, mnB, alB);
  __syncthreads(); RESC(alB);
  finishSM(pB0, pB1, alB, l_reg, pa0, pa1, pa2, pa3); SBAR();
  pv_d0(o, vb0 + (int)SHM_V, pa0, pa1, pa2, pa3);
  if (hi == 0) li_l[r32] = l_reg; asm volatile("s_waitcnt lgkmcnt(0)" ::: "memory");
  float rli[16];
#pragma unroll
  for (int r = 0; r < 16; ++r) rli[r] = __builtin_amdgcn_rcpf(li_l[crow(r, hi)]);
  bf16* Ow = Ob + (long)(wid * QBLK) * LDO;
#pragma unroll
  for (int r = 0; r < 16; ++r) { int orow = crow(r, hi);
    for (int d0 = 0; d0 < 4; ++d0) { const float v = o[d0][r] * rli[r]; unsigned u = __float_as_uint(v); u = (u + 0x7fffu + ((u >> 16) & 1u)) >> 16;
      Ow[(long)orow * LDO + d0 * 32 + r32] = (bf16)u; } }
  __syncthreads();
#undef SLOAD
#undef SWRITE
#undef SWAIT
#undef RESC
}
#undef KSWZ
#undef SBAR
}
constexpr int DM = 2048, NB = 8, SEQ = 4096, CTXL = 256, DEPTH = 4;
constexpr int TPB = SEQ + CTXL;
constexpr int M = NB * TPB;
constexpr int ZW = 3584, FF = 5632, NMOD = 6 * DM;
constexpr int CONVW = 512, SSMW = 512, ATTW = 1024, NG = 32, NP = 64, NSG = 16;
constexpr int Z_CV = 0, Z_CB = 512, Z_CC = 1024, Z_SSM = 1536, Z_Q = 2048, Z_K = 3072, Z_V = 3328;
constexpr int MIX_CONV = 0, MIX_SSM = 512, MIX_ATT = 1024;
constexpr float RMS_EPS = 1e-6f;
constexpr int NWAVES = 8;
#ifndef REP_MASK
#define REP_MASK 0
#endif
#define NREP(b) (1 + ((REP_MASK >> (b)) & 1))

constexpr size_t MiB = 1u << 20;
constexpr size_t WS_CTL = 0, CTL_ZERO_BYTES = 1 * MiB;
constexpr size_t WS_MODP = 1 * MiB;
constexpr size_t WS_MOD  = 15 * MiB;
constexpr size_t WS_ROPE = 17 * MiB;
constexpr size_t WS_BBAR = 18 * MiB;
constexpr size_t WS_POW  = 20 * MiB;
constexpr size_t WS_KT   = 25 * MiB;
constexpr size_t WS_W    = 33 * MiB, W_LAYER = 89 * MiB;
constexpr size_t W_IN = 0, W_OUT = 14 * MiB, W_GU = 22 * MiB, W_DOWN = 66 * MiB, W_GLU = 88 * MiB;
constexpr size_t WS_TW   = WS_W + 4 * W_LAYER;
constexpr size_t WS_W1   = WS_TW + 96 * MiB;
constexpr size_t WS_X    = WS_W1 + 32 * MiB;
constexpr size_t WS_H    = WS_X + 272 * MiB;
constexpr size_t WS_Y    = WS_H + 136 * MiB;
constexpr size_t WS_UH   = WS_Y, WS_SB = WS_Y + 60 * MiB;
constexpr size_t WS_Z    = WS_Y + 136 * MiB;
constexpr size_t WS_MIX  = WS_Z + 238 * MiB;
constexpr size_t WS_ACT  = WS_Z;
constexpr size_t WS_G    = WS_MIX + 136 * MiB;
constexpr size_t WS_YP   = WS_G + 34 * MiB;
constexpr size_t WS_END  = WS_YP + 64 * MiB;
static_assert((size_t)M * DM * 4 == 272 * MiB && (size_t)M * ZW * 2 == 238 * MiB && (size_t)M * FF * 2 == 374 * MiB && (size_t)32 * SSM_RPG * UH_LD * 2 == 60 * MiB && (size_t)32 * SSM_RPG * 256 * 4 == 40 * MiB, "ws map");
static_assert(WS_END <= 1536 * MiB, "ws budget");
constexpr int CW_BAR = 4096;

constexpr int RING_OFF = 0, RING_BYTES = 131072;
constexpr int LDSCTL_OFF = RING_BYTES, MISC_OFF = LDSCTL_OFF + 320;
constexpr int LDS_BYTES = 147456;

#define GAS __attribute__((address_space(1)))
#define LAS __attribute__((address_space(3)))
typedef unsigned short bf16;
typedef unsigned v4u __attribute__((ext_vector_type(4)));
typedef unsigned v2u __attribute__((ext_vector_type(2)));
typedef float f32x4 __attribute__((ext_vector_type(4)));
typedef float f32x2 __attribute__((ext_vector_type(2)));
#define LDS_WAIT() asm volatile("s_waitcnt lgkmcnt(0)" ::: "memory")
#define VM_WAIT() asm volatile("s_waitcnt vmcnt(0)" ::: "memory")
__device__ __forceinline__ unsigned f2bf(float f) { unsigned u = __builtin_bit_cast(unsigned, f); return (u + 0x7fffu + ((u >> 16) & 1u)) >> 16; }
__device__ __forceinline__ unsigned pk2(float lo, float hi) { return f2bf(lo) | (f2bf(hi) << 16); }
__device__ __forceinline__ float blo(unsigned w) { return __uint_as_float(w << 16); }
__device__ __forceinline__ float bhi(unsigned w) { return __uint_as_float(w & 0xffff0000u); }
__device__ __forceinline__ float wave_sum(float v) {
#pragma unroll
    for (int o = 1; o < 64; o <<= 1) v += __shfl_xor(v, o);
    return v;
}

#define XB_TMO      128
#define XB_XCNT(j)  (256  + 64 * (j))
#define XB_XSUB(j)  (1280 + 64 * (j))
#define XB_XGEN(j)  (2304 + 64 * (j))
#define XB_TOP      3328
#define XB_TOPGEN   3392
#define XCD_BAR_WORDS 3456
#define XB_SPIN_CAP (1u << 18)

__device__ __forceinline__ unsigned xb_ld(unsigned* p)              { return __hip_atomic_load(p, __ATOMIC_RELAXED, __HIP_MEMORY_SCOPE_AGENT); }
__device__ __forceinline__ unsigned xb_add(unsigned* p, unsigned v) { return __hip_atomic_fetch_add(p, v, __ATOMIC_RELAXED, __HIP_MEMORY_SCOPE_AGENT); }
__device__ __forceinline__ unsigned xb_xcc_id() { return (unsigned)__builtin_amdgcn_s_getreg((3 << 11) | 20) & 0xFu; }
#define XB_SPIN(cond, bar) do { unsigned _sp = 0; while (cond) { __builtin_amdgcn_s_sleep(1); \
    if ((++_sp & 255u) == 0u) { if (xb_ld(&(bar)[XB_TMO])) break; if (_sp > XB_SPIN_CAP) { atomicAdd(&(bar)[XB_TMO], 1u); break; } } } } while (0)

struct XcdBarrier {
    unsigned* bar; unsigned x;
    volatile LAS unsigned* st;
};

__device__ __forceinline__ XcdBarrier xcd_barrier_post(unsigned* bar, volatile LAS unsigned* st, bool leader  ) {
    XcdBarrier b; b.bar = bar; b.x = xb_xcc_id(); b.st = st;
    if (leader) (void)xb_add(&bar[XB_XCNT(b.x)], 1u);
    return b;
}
__device__ __forceinline__ void xcd_barrier_complete(unsigned* bar, unsigned x, unsigned& nloc, unsigned& nx) {
    const unsigned G = gridDim.x * gridDim.y * gridDim.z;
    unsigned sum, cnt, mine, sp = 0u;
    for (;;) {
        sum = 0u; cnt = 0u; mine = 0u;
#pragma unroll
        for (unsigned j = 0; j < 16; ++j) { const unsigned c = xb_ld(&bar[XB_XCNT(j)]); sum += c; cnt += (c > 0u) ? 1u : 0u; mine = (j == x) ? c : mine; }
        if (sum == G) break;
        __builtin_amdgcn_s_sleep(1);
        if ((++sp & 255u) == 0u) { if (xb_ld(&bar[XB_TMO])) break; if (sp > XB_SPIN_CAP) { atomicAdd(&bar[XB_TMO], 1u); break; } }
    }
    nloc = mine > 0u ? mine : 1u; nx = cnt > 0u ? cnt : 1u;
}

__device__ __forceinline__ void xcd_barrier(const XcdBarrier& b, bool leader  ) {
    asm volatile("s_waitcnt vmcnt(0)" ::: "memory");
    __syncthreads();
    if (leader) {
        unsigned* bar = b.bar;
        __builtin_amdgcn_s_waitcnt(0);
        unsigned nloc = b.st[0], nx = b.st[1];
        if (nloc == 0u) { xcd_barrier_complete(bar, b.x, nloc, nx); b.st[0] = nloc; b.st[1] = nx; }
        const unsigned old = xb_add(&bar[XB_XSUB(b.x)], 1u);
        const unsigned gen = old / nloc;
        if (old + 1u == (gen + 1u) * nloc) {
            __builtin_amdgcn_fence(__ATOMIC_RELEASE, "agent");
            asm volatile("s_waitcnt vmcnt(0)" ::: "memory");
            const unsigned og = xb_add(&bar[XB_TOP], 1u);
            const unsigned tg = og / nx;
            if (og + 1u == (tg + 1u) * nx) xb_add(&bar[XB_TOPGEN], 1u);
            else XB_SPIN(xb_ld(&bar[XB_TOPGEN]) == tg, bar);
            __builtin_amdgcn_fence(__ATOMIC_ACQUIRE, "agent");
            xb_add(&bar[XB_XGEN(b.x)], 1u);
            asm volatile("s_waitcnt vmcnt(0)" ::: "memory");
        } else {
            XB_SPIN(xb_ld(&bar[XB_XGEN(b.x)]) == gen, bar);
            __builtin_amdgcn_fence(__ATOMIC_ACQUIRE, "agent");
            asm volatile("s_waitcnt vmcnt(0)" ::: "memory");
        }
    }
    __syncthreads();
}

struct Params { const float* in[28]; float* out; unsigned char* ws; int ph_lo, ph_hi; };
typedef const __attribute__((address_space(4))) Params* KP;
__device__ __forceinline__ KP kparams() { KP kp = (KP)__builtin_amdgcn_kernarg_segment_ptr(); asm volatile("" : "+s"(kp)); return kp; }
enum { I_X = 0, I_C, I_CTX, I_CCTX, I_WMOD, I_BMOD, I_GPREMIX, I_GPOSTMIX, I_GPREFFN, I_GPOSTFFN, I_WIN, I_CONVW, I_LAMRE, I_LAMIM, I_LOGDT, I_BRE, I_BIM, I_CRE, I_CIM,
       I_SSMD, I_WGLU, I_BGLU, I_QNORM, I_KNORM, I_WOUT, I_WGATE, I_WUP, I_WDOWN };

__device__ __forceinline__ void transpose_item(const float* __restrict__ W, int K, int N, bf16* WT, int k0, int n0, int dst_row0, LAS float* scr, int lane) {
#pragma unroll 8
    for (int i = 0; i < 32; ++i) { const int kk = 2 * i + (lane >> 5); scr[kk * 33 + (lane & 31)] = W[(size_t)(k0 + kk) * N + n0 + (lane & 31)]; }
    LDS_WAIT(); asm volatile("" ::: "memory");
    const int c = lane & 7;
#pragma unroll
    for (int j = 0; j < 4; ++j) { const int n = (lane >> 3) + 8 * j; const LAS float* s = scr + (8 * c) * 33 + n;
        v4u o; o.x = pk2(s[0 * 33], s[1 * 33]); o.y = pk2(s[2 * 33], s[3 * 33]); o.z = pk2(s[4 * 33], s[5 * 33]); o.w = pk2(s[6 * 33], s[7 * 33]);
        *(GAS v4u*)(WT + (size_t)(dst_row0 + n) * K + k0 + 8 * c) = o; }
    LDS_WAIT(); asm volatile("" ::: "memory");
}
constexpr int IT_MOD = DEPTH * 8 * 48;
constexpr int IT_ROPE = 32, IT_SSM = 256;
constexpr int TPL_IN = 32 * 112, TPL_OUT = 32 * 64, TPL_G = 32 * 176, TPL_D = 88 * 64, TPL_GLU = 8 * 16;
constexpr int TPL = TPL_IN + TPL_OUT + 2 * TPL_G + TPL_D + TPL_GLU;
constexpr int IT_TOTAL = IT_MOD + IT_ROPE + IT_SSM + DEPTH * TPL;

__device__ __forceinline__ void weight_item(KP P, int l, int r, LAS float* scr, int lane) {
    bf16* wl = (bf16*)(P->ws + WS_W + (size_t)l * W_LAYER);
    if (r < TPL_IN) { const int kb = r / 112, nb = r % 112; transpose_item(P->in[I_WIN] + (size_t)l * DM * ZW, DM, ZW, (bf16*)((unsigned char*)wl + W_IN), 64 * kb, 32 * nb, 32 * nb, scr, lane); return; }
    r -= TPL_IN;
    if (r < TPL_OUT) { const int kb = r / 64, nb = r % 64; transpose_item(P->in[I_WOUT] + (size_t)l * DM * DM, DM, DM, (bf16*)((unsigned char*)wl + W_OUT), 64 * kb, 32 * nb, 32 * nb, scr, lane); return; }
    r -= TPL_OUT;
    if (r < 2 * TPL_G) { const int up = r >= TPL_G; if (up) r -= TPL_G; const int kb = r / 176, nb = r % 176, n0 = 32 * nb;
        transpose_item(P->in[up ? I_WUP : I_WGATE] + (size_t)l * DM * FF, DM, FF, (bf16*)((unsigned char*)wl + W_GU), 64 * kb, n0, (n0 >> 7) * 256 + (n0 & 127) + (up ? 128 : 0), scr, lane); return; }
    r -= 2 * TPL_G;
    if (r < TPL_D) { const int kb = r / 64, nb = r % 64; transpose_item(P->in[I_WDOWN] + (size_t)l * FF * DM, FF, DM, (bf16*)((unsigned char*)wl + W_DOWN), 64 * kb, 32 * nb, 32 * nb, scr, lane); return; }
    r -= TPL_D;
    { const int kb = r / 16, nb = r % 16; transpose_item(P->in[I_WGLU] + (size_t)l * 512 * 512, 512, 512, (bf16*)((unsigned char*)wl + W_GLU), 64 * kb, 32 * nb, 32 * nb, scr, lane); }
}
__device__ __forceinline__ void prologue_a(KP P, LAS unsigned char* lds, int wave, int lane) {
    LAS float* scr = (LAS float*)(lds + RING_OFF + wave * 16384);
    const int G = gridDim.x, gw = wave * G + (int)blockIdx.x, NGW = NWAVES * G;
    unsigned char* ws = P->ws;
    for (int it = gw; it < IT_TOTAL; it += NGW) {
        int r = it;
        if (r < IT_MOD) {
            const int l = r / 384, kc = (r % 384) / 48, nc = r % 48;
#pragma unroll
            for (int j = 0; j < 9; ++j)
#pragma unroll
                for (int q = 0; q < 4; ++q) { const int kk = q * 64 + lane, k = kc * 256 + kk;
                    const float cv = (j < 8) ? P->in[I_C][j * DM + k] : P->in[I_CCTX][k];
                    scr[j * 256 + kk] = cv / (1.0f + __expf(-cv)); }
            LDS_WAIT(); asm volatile("" ::: "memory");
            f32x4 acc[9];
#pragma unroll
            for (int j = 0; j < 9; ++j) acc[j] = (f32x4){0.f, 0.f, 0.f, 0.f};
            const float* wp = P->in[I_WMOD] + ((size_t)l * DM + kc * 256) * NMOD + nc * 256 + lane * 4;
#pragma unroll 8
            for (int kk = 0; kk < 256; ++kk) { const f32x4 w = *(const f32x4*)(wp + (size_t)kk * NMOD);
#pragma unroll
                for (int j = 0; j < 9; ++j) { const float s = scr[j * 256 + kk]; acc[j] += w * s; } }
            float* mp = (float*)(ws + WS_MODP) + ((size_t)(kc * DEPTH + l) * 9) * NMOD + nc * 256 + lane * 4;
#pragma unroll
            for (int j = 0; j < 9; ++j) *(f32x4*)(mp + (size_t)j * NMOD) = acc[j];
            LDS_WAIT(); asm volatile("" ::: "memory");
            continue;
        }
        r -= IT_MOD;
        if (r < IT_ROPE) {
            const int e = r * 64 + lane, coord = e >> 5, i = e & 31;
            const double inv = exp(-(double)i * (9.210340371976184 / 32.0));
            const double ang = (double)coord * inv;
            float* rp = (float*)(ws + WS_ROPE);
            rp[e] = (float)cos(ang); rp[2048 + e] = (float)sin(ang);
            continue;
        }
        r -= IT_ROPE;
        if (r < IT_SSM) {
            const int idx = r * 64 + lane;
            const int p = idx & 63, ldg = idx >> 6;
            const double lre = (double)P->in[I_LAMRE][idx], lim = (double)P->in[I_LAMIM][idx];
            const double dt = exp((double)P->in[I_LOGDT][ldg]);
            const double ea = exp(lre * dt), th = lim * dt;
            const double lbre = ea * cos(th), lbim = ea * sin(th);
            const double nr = lbre - 1.0, ni = lbim, dd = lre * lre + lim * lim;
            const double qre = (nr * lre + ni * lim) / dd, qim = (ni * lre - nr * lim) / dd;
            f32x2* bb = (f32x2*)(ws + WS_BBAR) + (size_t)idx * 16;
#pragma unroll
            for (int n = 0; n < 16; ++n) {
                const double bre = (double)P->in[I_BRE][(size_t)idx * 16 + n], bim = (double)P->in[I_BIM][(size_t)idx * 16 + n];
                bb[n] = (f32x2){(float)(qre * bre - qim * bim), (float)(qre * bim + qim * bre)};
            }
            f32x2* pw = (f32x2*)(ws + WS_POW) + (size_t)ldg * 33 * 64 + p;
            for (int e = 0; e <= 32; ++e) { const double m = exp(lre * dt * (double)e), a = th * (double)e; pw[e * 64] = (f32x2){(float)(m * cos(a)), (float)(m * sin(a))}; }
            continue;
        }
        r -= IT_SSM;
        { const int l = r / TPL; weight_item(P, l, r - l * TPL, scr, lane); }
    }
}
__device__ __forceinline__ void prologue_b(KP P, int tid) {
    const int total = DEPTH * 9 * NMOD;
    const float* mp = (const float*)(P->ws + WS_MODP); float* mo = (float*)(P->ws + WS_MOD);
    for (int idx = (int)blockIdx.x * 512 + tid; idx < total; idx += (int)gridDim.x * 512) {
        const int l = idx / (9 * NMOD), n = idx % NMOD;
        float s = P->in[I_BMOD][l * NMOD + n];
#pragma unroll
        for (int kc = 0; kc < 8; ++kc) s += mp[(size_t)kc * total + idx];
        const int ch = n / DM, col = n - ch * DM;
        if (ch == 1) s = P->in[I_GPREMIX][l * DM + col] * (1.0f + s);
        else if (ch == 2) s = s * P->in[I_GPOSTMIX][l * DM + col];
        else if (ch == 4) s = P->in[I_GPREFFN][l * DM + col] * (1.0f + s);
        else if (ch == 5) s = s * P->in[I_GPOSTFFN][l * DM + col];
        mo[idx] = s;
    }
}

__device__ __forceinline__ void prologue_kt(KP P, int tid) {
    const f32x2* pw = (const f32x2*)(P->ws + WS_POW); const f32x2* bbar = (const f32x2*)(P->ws + WS_BBAR); float* kt = (float*)(P->ws + WS_KT);
    for (int idx = (int)blockIdx.x * 512 + tid; idx < DEPTH * 32 * 2 * 32 * 16; idx += (int)gridDim.x * 512) {
        const int no = idx & 15, tau = (idx >> 4) & 31, dir = (idx >> 9) & 1, g = (idx >> 10) & 31, l = idx >> 15;
        const int ldg = (l * 2 + dir) * 32 + g;
        float acc[16];
#pragma unroll
        for (int n = 0; n < 16; ++n) acc[n] = 0.f;
        for (int p = 0; p < 64; ++p) {
            const float cre = P->in[I_CRE][((size_t)ldg * 16 + no) * 64 + p], cim = P->in[I_CIM][((size_t)ldg * 16 + no) * 64 + p];
            const f32x2 w = pw[((size_t)ldg * 33 + tau) * 64 + p];
            const float are = cre * w[0] - cim * w[1], aim = cre * w[1] + cim * w[0];
            const f32x4* bp = (const f32x4*)(bbar + ((size_t)ldg * 64 + p) * 16);
#pragma unroll
            for (int q = 0; q < 8; ++q) { const f32x4 b2 = bp[q]; acc[2 * q] += are * b2[0] - aim * b2[1]; acc[2 * q + 1] += are * b2[2] - aim * b2[3]; }
        }
#pragma unroll
        for (int q = 0; q < 4; ++q) *(f32x4*)(kt + (size_t)idx * 16 + q * 4) = (f32x4){acc[q * 4], acc[q * 4 + 1], acc[q * 4 + 2], acc[q * 4 + 3]};
    }
}
__device__ __forceinline__ void prologue_s5w(KP P, int tid) {
    const f32x2* pw = (const f32x2*)(P->ws + WS_POW); const f32x2* bbar = (const f32x2*)(P->ws + WS_BBAR); const float* kt = (const float*)(P->ws + WS_KT);
    bf16* TW = (bf16*)(P->ws + WS_TW); bf16* W1 = (bf16*)(P->ws + WS_W1);
    for (int it = (int)blockIdx.x * 512 + tid; it < DEPTH * 32 * 65536; it += (int)gridDim.x * 512) {
        const int lg = it >> 16, l = lg >> 5, g = lg & 31; int r = it & 65535; float v[8];
        if (r < 49152) {
            const int row = r / 96, ch = r - row * 96, t = row >> 4, no = row & 15, k0 = ch * 8;
            if (k0 < 512) {
                const int s = k0 >> 4, ni0 = k0 & 15;
#pragma unroll
                for (int e = 0; e < 8; ++e) v[e] = 0.f;
                if (t >= s) { const float* kp = kt + ((((size_t)(l * 32 + g) * 2 + 0) * 32 + (t - s)) * 16 + no) * 16 + ni0;
#pragma unroll
                    for (int e = 0; e < 8; ++e) v[e] += kp[e]; }
                if (s >= t) { const float* kp = kt + ((((size_t)(l * 32 + g) * 2 + 1) * 32 + (s - t)) * 16 + no) * 16 + ni0;
#pragma unroll
                    for (int e = 0; e < 8; ++e) v[e] += kp[e]; }
                if (t == s) { const float dv = P->in[I_SSMD][l * SSMW + g * NSG + no];
#pragma unroll
                    for (int e = 0; e < 8; ++e) if (ni0 + e == no) v[e] += dv; }
            } else {
                const int kk = k0 - 512, dir = kk >> 7, part = (kk >> 6) & 1, p0 = kk & 63, ep = dir == 0 ? t + 1 : 32 - t, ldg = (l * 2 + dir) * 32 + g;
#pragma unroll
                for (int e = 0; e < 8; ++e) { const int p = p0 + e; const f32x2 w = pw[((size_t)ldg * 33 + ep) * 64 + p];
                    const float cre = P->in[I_CRE][((size_t)ldg * 16 + no) * 64 + p], cim = P->in[I_CIM][((size_t)ldg * 16 + no) * 64 + p];
                    v[e] = part == 0 ? (cre * w[0] - cim * w[1]) : -(cre * w[1] + cim * w[0]); }
            }
            v4u o; o.x = pk2(v[0], v[1]); o.y = pk2(v[2], v[3]); o.z = pk2(v[4], v[5]); o.w = pk2(v[6], v[7]);
            *(v4u*)(TW + ((size_t)lg * 512 + row) * 768 + k0) = o;
        } else {
            r -= 49152;
            const int r1 = r >> 6, ch = r & 63, dir = r1 >> 7, part = (r1 >> 6) & 1, p = r1 & 63, k0 = ch * 8, s = k0 >> 4, n0 = k0 & 15, ep = dir == 0 ? 31 - s : s, ldg = (l * 2 + dir) * 32 + g;
            const f32x2 w = pw[((size_t)ldg * 33 + ep) * 64 + p]; const f32x2* bp = bbar + ((size_t)ldg * 64 + p) * 16 + n0;
#pragma unroll
            for (int e = 0; e < 8; ++e) { const f32x2 b2 = bp[e]; v[e] = part == 0 ? (w[0] * b2[0] - w[1] * b2[1]) : (w[0] * b2[1] + w[1] * b2[0]); }
            v4u o; o.x = pk2(v[0], v[1]); o.y = pk2(v[2], v[3]); o.z = pk2(v[4], v[5]); o.w = pk2(v[6], v[7]);
            *(v4u*)(W1 + ((size_t)lg * 256 + r1) * 512 + k0) = o;
        }
    }
}

struct Thin {
    int init, fin;
    const float* x_lat; const float* x_ctx; const bf16* X; bf16* Xout; const bf16* Y; bf16* H; float* OUT;
    const float* modg; int gc;
    const float* mods; int sc;
    const float* YP; int ctx_mode;
};
__device__ __forceinline__ void thin_rows(const Thin& T, int wave, int lane) {
    const int G = gridDim.x;
    for (int r = (int)blockIdx.x * NWAVES + wave; r < M; r += G * NWAVES) {
        const int b = r / TPB, p = r - b * TPB, j = (p < CTXL) ? 8 : b;
        if ((T.fin || T.ctx_mode == 0) && p < CTXL) continue;
        float x[32], y[32];
        f32x4 ga[8], mu[8], sh[8];
        const float* gate = T.init ? nullptr : T.modg + (size_t)(j * 6 + T.gc) * DM;
        const float* shift = T.mods + (size_t)(j * 6 + T.sc) * DM; const float* mul = shift + DM;
        if (T.init) {
            const float* xsrc = (p < CTXL) ? T.x_ctx + ((size_t)b * CTXL + p) * DM : T.x_lat + ((size_t)b * SEQ + (p - CTXL)) * DM;
#pragma unroll
            for (int c = 0; c < 4; ++c) { const f32x4 a = *(const f32x4*)(xsrc + c * 512 + lane * 8), d = *(const f32x4*)(xsrc + c * 512 + lane * 8 + 4);
                x[c * 8 + 0] = a[0]; x[c * 8 + 1] = a[1]; x[c * 8 + 2] = a[2]; x[c * 8 + 3] = a[3]; x[c * 8 + 4] = d[0]; x[c * 8 + 5] = d[1]; x[c * 8 + 6] = d[2]; x[c * 8 + 7] = d[3]; }
        } else {
            v4u xw[4], yw[4];
#pragma unroll
            for (int c = 0; c < 4; ++c) xw[c] = *(const v4u*)(T.X + (size_t)r * DM + c * 512 + lane * 8);
            if (p < CTXL && T.ctx_mode == 2) {
#pragma unroll
                for (int e = 0; e < 32; ++e) y[e] = 0.f;
#pragma unroll
                for (int q = 0; q < 4; ++q) { const float* yp = T.YP + ((size_t)q * 2048 + b * CTXL + p) * DM;
#pragma unroll
                    for (int c = 0; c < 4; ++c) { const f32x4 a = *(const f32x4*)(yp + c * 512 + lane * 8), d = *(const f32x4*)(yp + c * 512 + lane * 8 + 4);
                        y[c * 8 + 0] += a[0]; y[c * 8 + 1] += a[1]; y[c * 8 + 2] += a[2]; y[c * 8 + 3] += a[3]; y[c * 8 + 4] += d[0]; y[c * 8 + 5] += d[1]; y[c * 8 + 6] += d[2]; y[c * 8 + 7] += d[3]; } }
            } else {
#pragma unroll
                for (int c = 0; c < 4; ++c) yw[c] = *(const v4u*)(T.Y + (size_t)r * DM + c * 512 + lane * 8);
#pragma unroll
                for (int c = 0; c < 4; ++c) { const v4u w = yw[c];
                    y[c * 8 + 0] = blo(w.x); y[c * 8 + 1] = bhi(w.x); y[c * 8 + 2] = blo(w.y); y[c * 8 + 3] = bhi(w.y); y[c * 8 + 4] = blo(w.z); y[c * 8 + 5] = bhi(w.z); y[c * 8 + 6] = blo(w.w); y[c * 8 + 7] = bhi(w.w); }
            }
#pragma unroll
            for (int c = 0; c < 4; ++c) { ga[2 * c] = *(const f32x4*)(gate + c * 512 + lane * 8); ga[2 * c + 1] = *(const f32x4*)(gate + c * 512 + lane * 8 + 4); }
#pragma unroll
            for (int c = 0; c < 4; ++c) { const v4u w = xw[c];
                x[c * 8 + 0] = blo(w.x); x[c * 8 + 1] = bhi(w.x); x[c * 8 + 2] = blo(w.y); x[c * 8 + 3] = bhi(w.y); x[c * 8 + 4] = blo(w.z); x[c * 8 + 5] = bhi(w.z); x[c * 8 + 6] = blo(w.w); x[c * 8 + 7] = bhi(w.w); }
        }
        if (!T.fin) {
#pragma unroll
            for (int c = 0; c < 4; ++c) { mu[2 * c] = *(const f32x4*)(mul + c * 512 + lane * 8); mu[2 * c + 1] = *(const f32x4*)(mul + c * 512 + lane * 8 + 4);
                sh[2 * c] = *(const f32x4*)(shift + c * 512 + lane * 8); sh[2 * c + 1] = *(const f32x4*)(shift + c * 512 + lane * 8 + 4); }
        }
        if (!T.init) {
            float ss = 0.f;
#pragma unroll
            for (int e = 0; e < 32; ++e) ss += y[e] * y[e];
            ss = wave_sum(ss);
            const float r1 = 1.0f / sqrtf(ss * (1.0f / DM) + RMS_EPS);
#pragma unroll
            for (int e = 0; e < 32; ++e) x[e] += ga[e >> 2][e & 3] * (y[e] * r1);
        }
        if (T.fin) {
            float* o = T.OUT + ((size_t)b * SEQ + (p - CTXL)) * DM;
#pragma unroll
            for (int c = 0; c < 4; ++c) { *(f32x4*)(o + c * 512 + lane * 8) = (f32x4){x[c * 8 + 0], x[c * 8 + 1], x[c * 8 + 2], x[c * 8 + 3]}; *(f32x4*)(o + c * 512 + lane * 8 + 4) = (f32x4){x[c * 8 + 4], x[c * 8 + 5], x[c * 8 + 6], x[c * 8 + 7]}; }
            continue;
        }
        float ss2 = 0.f;
#pragma unroll
        for (int e = 0; e < 32; ++e) ss2 += x[e] * x[e];
        ss2 = wave_sum(ss2);
        const float r2 = 1.0f / sqrtf(ss2 * (1.0f / DM) + RMS_EPS);
        bf16* xo = T.Xout + (size_t)r * DM; bf16* ho = T.H + (size_t)r * DM;
#pragma unroll
        for (int c = 0; c < 4; ++c) {
            v4u w; w.x = pk2(x[c * 8 + 0], x[c * 8 + 1]); w.y = pk2(x[c * 8 + 2], x[c * 8 + 3]); w.z = pk2(x[c * 8 + 4], x[c * 8 + 5]); w.w = pk2(x[c * 8 + 6], x[c * 8 + 7]); *(v4u*)(xo + c * 512 + lane * 8) = w;
            float hv[8];
#pragma unroll
            for (int e = 0; e < 8; ++e) hv[e] = (x[c * 8 + e] * r2) * mu[2 * c + (e >> 2)][e & 3] + sh[2 * c + (e >> 2)][e & 3];
            v4u hw; hw.x = pk2(hv[0], hv[1]); hw.y = pk2(hv[2], hv[3]); hw.z = pk2(hv[4], hv[5]); hw.w = pk2(hv[6], hv[7]); *(v4u*)(ho + c * 512 + lane * 8) = hw; }
    }
}
__device__ __forceinline__ void unpack8(const v4u w, float* f) { f[0] = blo(w.x); f[1] = bhi(w.x); f[2] = blo(w.y); f[3] = bhi(w.y); f[4] = blo(w.z); f[5] = bhi(w.z); f[6] = blo(w.w); f[7] = bhi(w.w); }
__device__ __forceinline__ void prep_row(KP P, int l, int r, int lane) {
    bf16* Z = (bf16*)(P->ws + WS_Z); bf16* MIX = (bf16*)(P->ws + WS_MIX); const float* rope = (const float*)(P->ws + WS_ROPE);
    const int b = r / TPB, p = r - b * TPB; const bool lat = p >= CTXL;
    const int seg_lo = lat ? CTXL : 0, seg_hi = lat ? TPB : CTXL;
    bf16* zr = Z + (size_t)r * ZW;
    const int ch = lane * 8, sub = lane & 31, t = p - CTXL, rowc = t >> 6, colc = t & 63;
    const bool hasp = p > seg_lo, hasn = p + 1 < seg_hi;
    const v4u zv = *(const v4u*)(zr + Z_CV + ch), zb = *(const v4u*)(zr + Z_CB + ch), zc = *(const v4u*)(zr + Z_CC + ch);
    const v4u zero4 = {0u, 0u, 0u, 0u};
    const v4u pv = hasp ? *(const v4u*)(zr - ZW + Z_CV + ch) : zero4, pc = hasp ? *(const v4u*)(zr - ZW + Z_CC + ch) : zero4;
    const v4u nv = hasn ? *(const v4u*)(zr + ZW + Z_CV + ch) : zero4, nc = hasn ? *(const v4u*)(zr + ZW + Z_CC + ch) : zero4;
    bf16* kp = zr + Z_K + lane * 4;
    const v2u kw = *(const v2u*)kp;
    const float* cw = P->in[I_CONVW] + (size_t)l * 3 * CONVW + ch;
    f32x4 w0[2], w1[2], w2[2];
#pragma unroll
    for (int h = 0; h < 2; ++h) { w0[h] = *(const f32x4*)(cw + h * 4); w1[h] = *(const f32x4*)(cw + CONVW + h * 4); w2[h] = *(const f32x4*)(cw + 2 * CONVW + h * 4); }
    const f32x4 kg = *(const f32x4*)(P->in[I_KNORM] + l * 128 + sub * 4);
    f32x4 cs = {1.f, 1.f, 1.f, 1.f}, sn = {0.f, 0.f, 0.f, 0.f};
    if (lat) { const float* cp = rope + ((sub < 16) ? rowc : colc) * 32 + (sub & 7) * 4; cs = *(const f32x4*)cp; sn = *(const f32x4*)(cp + 2048); }
    asm volatile("" ::: "memory");
    {
        float v[8], gb[8], gc[8], a[8], c[8], o[8];
        unpack8(zv, v); unpack8(zb, gb); unpack8(zc, gc);
        float uc[8], up[8], un[8];
#pragma unroll
        for (int e = 0; e < 8; ++e) uc[e] = gc[e] * v[e];
        unpack8(pv, a); unpack8(pc, c);
#pragma unroll
        for (int e = 0; e < 8; ++e) up[e] = a[e] * c[e];
        unpack8(nv, a); unpack8(nc, c);
#pragma unroll
        for (int e = 0; e < 8; ++e) un[e] = a[e] * c[e];
#pragma unroll
        for (int h = 0; h < 2; ++h)
#pragma unroll
            for (int e = 0; e < 4; ++e) { const int k = h * 4 + e; o[k] = gb[k] * (w0[h][e] * up[k] + w1[h][e] * uc[k] + w2[h][e] * un[k]); }
        v4u w; w.x = pk2(o[0], o[1]); w.y = pk2(o[2], o[3]); w.z = pk2(o[4], o[5]); w.w = pk2(o[6], o[7]);
        *(v4u*)(MIX + (size_t)r * DM + MIX_CONV + ch) = w;
    }
    {
        float k[4]; k[0] = blo(kw.x); k[1] = bhi(kw.x); k[2] = blo(kw.y); k[3] = bhi(kw.y);
        float ss = k[0] * k[0] + k[1] * k[1] + k[2] * k[2] + k[3] * k[3];
        ss += __shfl_xor(ss, 1); ss += __shfl_xor(ss, 2); ss += __shfl_xor(ss, 4); ss += __shfl_xor(ss, 8); ss += __shfl_xor(ss, 16);
        const float rr = 1.0f / sqrtf(ss * (1.0f / 128.0f) + RMS_EPS);
#pragma unroll
        for (int e = 0; e < 4; ++e) k[e] = k[e] * rr * kg[e];
        if (lat) {
#pragma unroll
            for (int e = 0; e < 4; ++e) { const float other = __shfl_xor(k[e], 8);
                k[e] = ((sub & 8) == 0) ? (k[e] * cs[e] - other * sn[e]) : (other * sn[e] + k[e] * cs[e]); }
        }
        v2u w; w.x = pk2(k[0], k[1]); w.y = pk2(k[2], k[3]); *(v2u*)kp = w;
    }
}

__device__ __forceinline__ void s5_carry_phase(KP P, int l, int wave, int lane) {
    const int G = gridDim.x;
    bf16* UH = (bf16*)(P->ws + WS_UH); const float* SB = (const float*)(P->ws + WS_SB);
    for (int it = wave * G + (int)blockIdx.x; it < 32 * NB * 2; it += NWAVES * G) {
        const int dir = it & 1, b = (it >> 1) & 7, g = it >> 4;
        const f32x2 l32 = ((const f32x2*)(P->ws + WS_POW))[((size_t)((l * 2 + dir) * 32 + g) * 33 + 32) * 64 + lane];
        float hre = 0.f, him = 0.f;
        for (int k0 = 0; k0 < SSM_CPB; k0 += 8) {
            float sre[8], sim[8]; size_t rowi[8];
#pragma unroll
            for (int q = 0; q < 8; ++q) { const int k = k0 + q, c = dir == 0 ? k : (k < 8 ? 7 - k : 143 - k);
                rowi[q] = (size_t)g * SSM_RPG + ssm_rg(b, c);
                const float* sp = SB + rowi[q] * 256 + dir * 128 + lane; sre[q] = sp[0]; sim[q] = sp[64]; }
            asm volatile("" ::: "memory");
#pragma unroll
            for (int q = 0; q < 8; ++q) {
                bf16* up = UH + rowi[q] * UH_LD + 512 + dir * 128 + lane;
                up[0] = (bf16)f2bf(hre); up[64] = (bf16)f2bf(him);
                const float nre = l32[0] * hre - l32[1] * him + sre[q], nim = l32[0] * him + l32[1] * hre + sim[q];
                hre = nre; him = nim;
            }
        }
    }
}

__device__ __forceinline__ void attention_phase(KP P, int l, unsigned char* lds_generic, int wave_s) {
    const bf16* Z = (const bf16*)(P->ws + WS_Z); bf16* MIX = (bf16*)(P->ws + WS_MIX);
    const int G = gridDim.x;
    for (int i = 0; ; ++i) {
        int b, h, qb;
        if (G == 256) { if (i >= 4) break; const int xcd = blockIdx.x & 7, slot = blockIdx.x >> 3; const int pair = 2 * xcd + (i >> 1), uip = (i & 1) * 32 + slot; b = pair >> 1; h = (pair & 1) * 4 + (uip >> 4); qb = uip & 15; }
        else { const int u = i * G + blockIdx.x; if (u >= 1024) break; b = u >> 7; h = (u >> 4) & 7; qb = u & 15; }
        const int kvh = h >> 2; const size_t row0 = (size_t)b * TPB;
        attn::attn_unit(Z + (row0 + CTXL + qb * 256) * ZW + Z_Q + h * 128, Z + row0 * ZW + Z_K + kvh * 128, Z + row0 * ZW + Z_V + kvh * 128,
                        MIX + (row0 + CTXL + qb * 256) * DM + MIX_ATT + h * 128, TPB, (char*)lds_generic, wave_s, P->in[I_QNORM] + l * 128, (const float*)(P->ws + WS_ROPE), qb * 256);
    }
    if (l < DEPTH - 1) {
        for (int u = blockIdx.x; u < NB * 8; u += G) { const int b = u >> 3, h = u & 7, kvh = h >> 2; const size_t row0 = (size_t)b * TPB;
            attn::attn_unit(Z + row0 * ZW + Z_Q + h * 128, Z + row0 * ZW + Z_K + kvh * 128, Z + row0 * ZW + Z_V + kvh * 128, MIX + row0 * DM + MIX_ATT + h * 128, CTXL, (char*)lds_generic, wave_s, P->in[I_QNORM] + l * 128, nullptr, 0); }
    }
}
constexpr int PH_PRO = 3, PH_PER_LAYER = 10, PH_TOTAL = PH_PRO + DEPTH * PH_PER_LAYER;
__global__ void __launch_bounds__(NWAVES * 64, 2) trunk_fwd(Params Pval) {
    extern __shared__ __attribute__((aligned(16))) unsigned char lds_raw[];
    LAS unsigned char* lds = (LAS unsigned char*)lds_raw;
    const int wave = __builtin_amdgcn_readfirstlane((int)threadIdx.x >> 6);

    const int G = gridDim.x;
    for (int u = wave * 64 + lane_id(); u < (LDS_BYTES - LDSCTL_OFF) / 4; u += NWAVES * 64) ((LAS unsigned*)(lds + LDSCTL_OFF))[u] = 0u;
    __syncthreads();
    (void)Pval;
    KP P = kparams();
    const int lo = P->ph_lo, hi = P->ph_hi;
    unsigned char* ws = P->ws;
    XcdBarrier bar; bar.bar = (unsigned*)(ws + WS_CTL) + CW_BAR; bar.x = 0; bar.st = nullptr;
    if (hi - lo > 1) bar = xcd_barrier_post((unsigned*)(ws + WS_CTL) + CW_BAR, (volatile LAS unsigned*)(lds + MISC_OFF) + 8, wave == 0 && lane_id() == 0);
#define IN(k) (lo <= (k) && (k) < hi)
#define SEAM(k) do { if (IN((k) + 1)) { const bool ldr_ = (wave == 0) && (lane_id() == 0); xcd_barrier(bar, ldr_); if (NREP(17) > 1) xcd_barrier(bar, ldr_); } } while (0)

    if (IN(0)) { for (int rep = 0; rep < NREP(0); ++rep) prologue_a(P, lds, wave, lane_id()); SEAM(0); }
    if (IN(1)) { for (int rep = 0; rep < NREP(0); ++rep) { prologue_b(P, wave * 64 + lane_id()); prologue_kt(P, wave * 64 + lane_id()); } SEAM(1); }
    if (IN(2)) {
        for (int rep = 0; rep < NREP(0); ++rep) prologue_s5w(P, wave * 64 + lane_id());
        Thin T{}; T.init = 1; T.fin = 0; T.x_lat = P->in[I_X]; T.x_ctx = P->in[I_CTX]; T.X = (const bf16*)(ws + WS_X); T.Xout = (bf16*)(ws + WS_X); T.Y = nullptr; T.H = (bf16*)(ws + WS_H); T.OUT = nullptr;
        T.modg = nullptr; T.gc = 0; T.mods = (const float*)(ws + WS_MOD); T.sc = 0; T.YP = nullptr; T.ctx_mode = 1;
        for (int rep = 0; rep < NREP(0); ++rep) thin_rows(T, wave, lane_id()); SEAM(2);
    }
    for (int l = 0; l < DEPTH; ++l) {
        const int pb = PH_PRO + l * PH_PER_LAYER;
        if (pb + PH_PER_LAYER <= lo || pb >= hi) continue;
        P = kparams(); ws = P->ws;
        const unsigned char* wl = ws + WS_W + (size_t)l * W_LAYER;
        const float* modl = (const float*)(ws + WS_MOD) + (size_t)l * 9 * NMOD;
        const bool lastl = (l == DEPTH - 1);
        float* YPp = (float*)(ws + WS_YP);
        if (IN(pb + 0)) {
            pg8::Gemm g{(const bf16*)(ws + WS_H), (const bf16*)(wl + W_IN), M, ZW, DM}; pg8::RowOrder S{ZW / 256, G, (int)blockIdx.x, 1, 0};
            pg8::EpiInProj E{(bf16*)(ws + WS_Z), (bf16*)(ws + WS_UH)};
            for (int rep = 0; rep < NREP(3); ++rep) pg8::gemm_phase<pg8::EpiInProj, pg8::RowOrder, true, true>(lds + RING_OFF, g, S, E, wave);
            SEAM(pb + 0);
        }
        if (IN(pb + 1)) {
            for (int r = (int)blockIdx.x * NWAVES + wave; r < M; r += NWAVES * G) prep_row(P, l, r, lane_id());
            pg8::Gemm g{(const bf16*)(ws + WS_UH), (const bf16*)(ws + WS_W1) + (size_t)l * 32 * 256 * 512, 0, 0, 512, UH_LD, 512}; pg8::S5Order1 S{G, (int)blockIdx.x};
            pg8::EpiS5State E{(float*)(ws + WS_SB)};
            for (int rep = 0; rep < NREP(13); ++rep) pg8::gemm_phase<pg8::EpiS5State, pg8::S5Order1, true, true>(lds + RING_OFF, g, S, E, wave);
            SEAM(pb + 1);
        }
        if (IN(pb + 2)) { for (int rep = 0; rep < NREP(14); ++rep) s5_carry_phase(P, l, wave, lane_id()); SEAM(pb + 2); }
        if (IN(pb + 3)) {
            { pg8::Gemm g{(const bf16*)(ws + WS_UH), (const bf16*)(ws + WS_TW) + (size_t)l * 32 * 512 * 768, 0, 0, 768, UH_LD, 768}; pg8::S5Order2 S{G, (int)blockIdx.x, l < DEPTH - 1 ? 5 : 4};
              pg8::EpiS5Out E{(bf16*)(ws + WS_G)};
              for (int rep = 0; rep < NREP(15); ++rep) pg8::gemm_phase<pg8::EpiS5Out, pg8::S5Order2, true, true>(lds + RING_OFF, g, S, E, wave); }
            __syncthreads();
            for (int rep = 0; rep < NREP(12); ++rep) attention_phase(P, l, lds_raw, wave);
            SEAM(pb + 3);
        }
        if (IN(pb + 4)) {
            pg8::Gemm g{(const bf16*)(ws + WS_G), (const bf16*)(wl + W_GLU), M, SSMW, SSMW}; pg8::RowOrder S{SSMW / 256, G, (int)blockIdx.x, lastl ? 0 : 1, 0};
            pg8::EpiGlu E{(const bf16*)(ws + WS_G), SSMW, (bf16*)(ws + WS_MIX) + MIX_SSM, DM, P->in[I_BGLU] + l * SSMW};
            for (int rep = 0; rep < NREP(11); ++rep) pg8::gemm_phase<pg8::EpiGlu, pg8::RowOrder, true, true>(lds + RING_OFF, g, S, E, wave);
            SEAM(pb + 4);
        }
        if (IN(pb + 5)) {
            pg8::Gemm g{(const bf16*)(ws + WS_MIX), (const bf16*)(wl + W_OUT), M, DM, DM}; pg8::RowOrder S{DM / 256, G, (int)blockIdx.x, lastl ? 0 : 2, DM / 256};
            pg8::EpiBf16 E{(bf16*)(ws + WS_Y), DM, YPp, DM / 64};
            for (int rep = 0; rep < NREP(6); ++rep) pg8::gemm_phase<pg8::EpiBf16, pg8::RowOrder, true, true>(lds + RING_OFF, g, S, E, wave);
            SEAM(pb + 5);
        }
        if (IN(pb + 6)) {
            Thin T{}; T.init = 0; T.fin = 0; T.x_lat = nullptr; T.x_ctx = nullptr; T.X = (const bf16*)(ws + WS_X); T.Xout = (bf16*)(ws + WS_X); T.Y = (const bf16*)(ws + WS_Y); T.H = (bf16*)(ws + WS_H); T.OUT = nullptr;
            T.modg = modl; T.gc = 2; T.mods = modl; T.sc = 3; T.YP = YPp; T.ctx_mode = lastl ? 0 : 2;
            if (NREP(7) > 1) { Thin T2 = T; T2.Xout = (bf16*)(ws + WS_Z); thin_rows(T2, wave, lane_id()); }
            thin_rows(T, wave, lane_id()); SEAM(pb + 6);
        }
        if (IN(pb + 7)) {
            pg8::Gemm g{(const bf16*)(ws + WS_H), (const bf16*)(wl + W_GU), M, 2 * FF, DM}; pg8::RowOrder S{2 * FF / 256, G, (int)blockIdx.x, lastl ? 0 : 1, 0};
            pg8::EpiSwiGlu E{(bf16*)(ws + WS_ACT), FF};
            for (int rep = 0; rep < NREP(8); ++rep) pg8::gemm_phase<pg8::EpiSwiGlu, pg8::RowOrder, true, true>(lds + RING_OFF, g, S, E, wave);
            SEAM(pb + 7);
        }
        if (IN(pb + 8)) {
            pg8::Gemm g{(const bf16*)(ws + WS_ACT), (const bf16*)(wl + W_DOWN), M, DM, FF}; pg8::RowOrder S{DM / 256, G, (int)blockIdx.x, lastl ? 0 : 2, FF / 256};
            pg8::EpiBf16 E{(bf16*)(ws + WS_Y), DM, YPp, FF / 64};
            for (int rep = 0; rep < NREP(9); ++rep) pg8::gemm_phase<pg8::EpiBf16, pg8::RowOrder, true, true>(lds + RING_OFF, g, S, E, wave);
            SEAM(pb + 8);
        }
        if (IN(pb + 9)) {
            const bool last = (l == DEPTH - 1); const int l2 = last ? l : l + 1;
            Thin T{}; T.init = 0; T.fin = last ? 1 : 0; T.x_lat = nullptr; T.x_ctx = nullptr; T.X = (const bf16*)(ws + WS_X); T.Xout = (bf16*)(ws + WS_X); T.Y = (const bf16*)(ws + WS_Y); T.H = (bf16*)(ws + WS_H); T.OUT = P->out;
            T.modg = modl; T.gc = 5; T.mods = (const float*)(ws + WS_MOD) + (size_t)l2 * 9 * NMOD; T.sc = 0; T.YP = YPp; T.ctx_mode = lastl ? 0 : 2;
            if (NREP(7) > 1) { Thin T2 = T; T2.Xout = (bf16*)(ws + WS_Z); thin_rows(T2, wave, lane_id()); }
            thin_rows(T, wave, lane_id()); SEAM(pb + 9);
        }
    }
#undef IN
#undef SEAM
}

extern "C" void kernel_launch(void* const* d_in, const int* in_sizes, int n_in, void* d_out, int out_size, void* d_ws, size_t ws_size, hipStream_t stream) {
    static int grid = 0;
    if (grid == 0) {
        if (n_in != 28 || in_sizes[0] != NB * SEQ * DM || out_size != NB * SEQ * DM || ws_size < WS_END) {
            fprintf(stderr, "kernel_launch: built for 28 inputs, x/out of %d floats, >= %zu bytes of workspace; got n_in %d, in0 %d, out %d, ws %zu; nothing launched\n", NB * SEQ * DM, (size_t)WS_END, n_in, n_in > 0 ? in_sizes[0] : -1, out_size, ws_size);
            grid = -1; return; }
        int dev = 0, cus = 0;
        if (hipGetDevice(&dev) != hipSuccess || hipDeviceGetAttribute(&cus, hipDeviceAttributeMultiprocessorCount, dev) != hipSuccess) { fprintf(stderr, "kernel_launch: device query failed\n"); grid = -1; return; }
        if (hipFuncSetAttribute((const void*)trunk_fwd, hipFuncAttributeMaxDynamicSharedMemorySize, LDS_BYTES) != hipSuccess) { fprintf(stderr, "kernel_launch: hipFuncSetAttribute failed\n"); grid = -1; return; }
        int per_cu = 0;
        if (hipOccupancyMaxActiveBlocksPerMultiprocessor(&per_cu, (const void*)trunk_fwd, NWAVES * 64, LDS_BYTES) != hipSuccess || per_cu < 1)
            fprintf(stderr, "kernel_launch: note: occupancy query reports %d workgroups per CU\n", per_cu);
        (void)hipGetLastError();
        grid = cus;
    }
    if (grid < 0) return;
    if (hipMemsetAsync((char*)d_ws + WS_CTL, 0, CTL_ZERO_BYTES, stream) != hipSuccess) { fprintf(stderr, "kernel_launch: memset failed\n"); return; }
    Params p{};
    for (int i = 0; i < 28; ++i) p.in[i] = (const float*)d_in[i];
    p.out = (float*)d_out; p.ws = (unsigned char*)d_ws;
#if MK_ONE_LAUNCH
    p.ph_lo = 0; p.ph_hi = PH_TOTAL;
    hipLaunchKernelGGL(trunk_fwd, dim3(grid), dim3(NWAVES * 64), LDS_BYTES, stream, p);
#else
    for (int k = 0; k < PH_TOTAL; ++k) { p.ph_lo = k; p.ph_hi = k + 1; hipLaunchKernelGGL(trunk_fwd, dim3(grid), dim3(NWAVES * 64), LDS_BYTES, stream, p); }
#endif
    const hipError_t le = hipPeekAtLastError();
    if (le != hipSuccess) fprintf(stderr, "kernel_launch: launch failed: %s\n", hipGetErrorName(le));
}
```
